# Optimizing an MI355X kernel written in HIP

```python
import jax, jax.numpy as jnp
from jax import lax
import numpy as np

D_MODEL = 1024
BATCH = 4
SEQ = 4096
DEPTH = 4
DEC_BATCH = 128
DEC_SEQ = 1
PAST_LEN = 8192
PAGE_SIZE = 128

N_META = 16
BLOCK = 128
WINDOW = 128
META_PAD = BLOCK - N_META
HEAD_DIM = 64
N_Q_HEADS = 8
N_KV_HEADS = 2
Q_PER_KV = N_Q_HEADS // N_KV_HEADS
ROT_DIM = HEAD_DIM // 4
ROPE_THETA = 500000.0
GLA_HEADS = 4
GLA_DK = 64
GLA_DV = 128
GLA_RANK = 16
GLA_TAU = 16.0
GLA_CHUNK = 64
D_FF = 4 * D_MODEL
ATT_W = N_Q_HEADS * HEAD_DIM
KV_W = N_KV_HEADS * HEAD_DIM
GK_W = GLA_HEADS * GLA_DK
GV_W = GLA_HEADS * GLA_DV
DEEPNORM_ALPHA = (2 * DEPTH) ** 0.25
DEEPNORM_BETA = (8 * DEPTH) ** -0.25
LN_EPS = 1e-5
RMS_EPS = 1e-6

kernel_name = 'hybrid_swa_sink_gla_deepnorm_decoder_step'


def _splits():
    return (ATT_W, KV_W, KV_W, GK_W, GK_W, GV_W, GLA_RANK, GV_W, D_MODEL, D_MODEL)


def layer_norm(x, g, b):
    xf = x.astype(jnp.float32)
    mu = jnp.mean(xf, -1, keepdims=True)
    var = jnp.mean(jnp.square(xf - mu), -1, keepdims=True)
    return ((xf - mu) * lax.rsqrt(var + LN_EPS) * g.astype(jnp.float32) + b.astype(jnp.float32)).astype(x.dtype)


def partial_rope(x, pos):
    half = ROT_DIM // 2
    inv = ROPE_THETA ** (-jnp.arange(half, dtype=jnp.float32) * 2.0 / ROT_DIM)
    ang = pos.astype(jnp.float32)[:, None] * inv[None, :]
    cos = jnp.cos(ang)[None, :, None, :]
    sin = jnp.sin(ang)[None, :, None, :]
    xf = x.astype(jnp.float32)
    x1, x2 = xf[..., :half], xf[..., half:ROT_DIM]
    out = jnp.concatenate([x1 * cos - x2 * sin, x2 * cos + x1 * sin, xf[..., ROT_DIM:]], -1)
    return out.astype(x.dtype)


def mixer_projections(x, pos, w_in, w_a2, b_a):
    B, T, _ = x.shape
    idx = np.cumsum(_splits())[:-1].tolist()
    q, k, v, gq, gk, gv, glr, gr, ga, gb = jnp.split(x @ w_in, idx, axis=-1)
    q = partial_rope(q.reshape(B, T, N_Q_HEADS, HEAD_DIM), pos)
    k = partial_rope(k.reshape(B, T, N_KV_HEADS, HEAD_DIM), pos)
    v = v.reshape(B, T, N_KV_HEADS, HEAD_DIM)
    def to_heads(t, d):
        return t.reshape(B, T, GLA_HEADS, d).astype(jnp.float32).transpose(0, 2, 1, 3)
    log_a = jax.nn.log_sigmoid((glr @ w_a2 + b_a).astype(jnp.float32)) / GLA_TAU
    gla_in = (to_heads(gq, GLA_DK) * GLA_DK ** -0.5, to_heads(gk, GLA_DK), to_heads(gv, GLA_DV), to_heads(log_a, GLA_DK))
    return q, k, v, gla_in, gr, ga, gb


def banded_sink_attention(q, k, v, mask, sink):
    s = jnp.einsum('bnqhgd,bnkhd->bnhgqk', q, k, preferred_element_type=jnp.float32) * HEAD_DIM ** -0.5
    s = jnp.where(mask[None, :, None, None], s, -jnp.inf)
    sk = sink.astype(jnp.float32)[None, None, :, :, None, None]
    m = jnp.maximum(jnp.max(s, -1, keepdims=True), sk)
    p = jnp.exp(s - m)
    p = p / (jnp.sum(p, -1, keepdims=True) + jnp.exp(sk - m))
    return jnp.einsum('bnhgqk,bnkhd->bnqhgd', p.astype(v.dtype), v)


def swa_prompt(q, k, v, sink):
    B, L = q.shape[:2]
    pad = ((0, 0), (META_PAD, 0), (0, 0), (0, 0))
    qp, kp, vp = jnp.pad(q, pad), jnp.pad(k, pad), jnp.pad(v, pad)
    nb = (L + META_PAD) // BLOCK
    qb = qp.reshape(B, nb, BLOCK, N_KV_HEADS, Q_PER_KV, HEAD_DIM)
    def band(t):
        tb = t.reshape(B, nb, BLOCK, N_KV_HEADS, HEAD_DIM)
        prev = jnp.pad(tb[:, :-1], ((0, 0), (1, 0), (0, 0), (0, 0), (0, 0)))
        return jnp.concatenate([prev, tb], axis=2)
    slot_q = jnp.arange(nb)[:, None] * BLOCK + jnp.arange(BLOCK)[None, :]
    slot_k = (jnp.arange(nb)[:, None] - 1) * BLOCK + jnp.arange(2 * BLOCK)[None, :]
    diff = slot_q[:, :, None] - slot_k[:, None, :]
    mask = (diff >= 0) & (diff < WINDOW) & (slot_k[:, None, :] >= META_PAD)
    o = banded_sink_attention(qb, band(kp), band(vp), mask, sink)
    return o.reshape(B, nb * BLOCK, ATT_W)[:, META_PAD:]


def swa_sample(q, k, v, k_buf, v_buf, sink):
    B, S = q.shape[:2]
    R = k_buf.shape[1]
    kk = jnp.concatenate([k_buf.astype(k.dtype), k], 1)
    vv = jnp.concatenate([v_buf.astype(v.dtype), v], 1)
    pos_q = PAST_LEN + jnp.arange(S)
    pos_k = PAST_LEN - R + jnp.arange(R + S)
    diff = pos_q[:, None] - pos_k[None, :]
    mask = ((diff >= 0) & (diff < WINDOW))[None]
    o = banded_sink_attention(q.reshape(B, 1, S, N_KV_HEADS, Q_PER_KV, HEAD_DIM), kk[:, None], vv[:, None], mask, sink)
    return o.reshape(B, S, ATT_W), kk[:, -R:], vv[:, -R:]


def gla_chunk(S0, q, k, v, log_a):
    C = q.shape[2]
    b = jnp.cumsum(log_a, axis=2)
    causal = jnp.tril(jnp.ones((C, C), dtype=bool))
    rel = jnp.where(causal[None, None, :, :, None], b[:, :, :, None, :] - b[:, :, None, :, :], -jnp.inf)
    A = jnp.einsum('bhtd,bhjd,bhtjd->bhtj', q, k, jnp.exp(rel))
    o = jnp.einsum('bhtd,bhde->bhte', q * jnp.exp(b), S0) + jnp.einsum('bhtj,bhje->bhte', A, v)
    b_last = b[:, :, -1:]
    S1 = jnp.exp(b_last[:, :, 0])[..., None] * S0 + jnp.einsum('bhjd,bhje->bhde', k * jnp.exp(b_last - b), v)
    return S1, o


def gla_prompt(q, k, v, log_a):
    B, H, L = q.shape[:3]
    nc = (L + META_PAD) // GLA_CHUNK
    def chunks(t):
        t = jnp.pad(t, ((0, 0), (0, 0), (META_PAD, 0), (0, 0)))
        return t.reshape(B, H, nc, GLA_CHUNK, t.shape[-1]).transpose(2, 0, 1, 3, 4)
    S0 = jnp.zeros((B, H, GLA_DK, GLA_DV), jnp.float32)
    S_fin, o = lax.scan(lambda S, c: gla_chunk(S, *c), S0, (chunks(q), chunks(k), chunks(v), chunks(log_a)))
    o = o.transpose(1, 2, 0, 3, 4).reshape(B, H, nc * GLA_CHUNK, GLA_DV)[:, :, META_PAD:]
    return o, S_fin


def gla_output(o, gr, g_norm):
    B, H, T, _ = o.shape
    o = o * lax.rsqrt(jnp.mean(o * o, -1, keepdims=True) + RMS_EPS) * g_norm.astype(jnp.float32)
    o = o.transpose(0, 2, 1, 3).reshape(B, T, GV_W)
    return (o * jax.nn.silu(gr.astype(jnp.float32))).astype(gr.dtype)


def finish_layer(x, att, gla, ga, gb, w_pa, w_pb, w_out, ln1_g, ln1_b, w_up, w_down, ln2_g, ln2_b):
    m = jax.nn.sigmoid(ga) * (att @ w_pa) + jax.nn.sigmoid(gb) * (gla @ w_pb)
    h = layer_norm(DEEPNORM_ALPHA * x + m @ w_out, ln1_g, ln1_b)
    f = jnp.square(jax.nn.relu(h @ w_up)) @ w_down
    return layer_norm(DEEPNORM_ALPHA * h + f, ln2_g, ln2_b)


def setup_inputs(seed: int = 0) -> dict:
    key = jax.random.key(seed)
    ks = jax.random.split(key, 22)
    def nrm(k, shape, scale):
        return jax.random.normal(k, shape, jnp.float32) * scale
    win_rows = min(WINDOW, PAST_LEN)
    d_in = sum(_splits())
    return {
        'x_prompt': nrm(ks[0], (BATCH, SEQ, D_MODEL), 1.0),
        'x_sample': nrm(ks[1], (DEC_BATCH, DEC_SEQ, D_MODEL), 1.0),
        'cache_k_win': nrm(ks[2], (DEPTH, DEC_BATCH, win_rows, N_KV_HEADS, HEAD_DIM), 1.0),
        'cache_v_win': nrm(ks[3], (DEPTH, DEC_BATCH, win_rows, N_KV_HEADS, HEAD_DIM), 1.0),
        'state_gla': nrm(ks[4], (DEPTH, DEC_BATCH, GLA_HEADS, GLA_DK, GLA_DV), 1.0),
        'meta_tokens': nrm(ks[5], (N_META, D_MODEL), 1.0),
        'w_in': nrm(ks[6], (DEPTH, D_MODEL, d_in), D_MODEL ** -0.5),
        'w_a2': nrm(ks[7], (DEPTH, GLA_RANK, GK_W), GLA_RANK ** -0.5),
        'b_a': nrm(ks[8], (DEPTH, GK_W), 0.1),
        'attn_sink': nrm(ks[9], (DEPTH, N_Q_HEADS), 0.5),
        'gla_norm_g': 1.0 + nrm(ks[10], (DEPTH, GLA_DV), 0.02),
        'w_proj_a': nrm(ks[11], (DEPTH, ATT_W, D_MODEL), ATT_W ** -0.5),
        'w_proj_b': nrm(ks[12], (DEPTH, GV_W, D_MODEL), GV_W ** -0.5),
        'w_out': nrm(ks[13], (DEPTH, D_MODEL, D_MODEL), DEEPNORM_BETA * D_MODEL ** -0.5),
        'ln1_g': 1.0 + nrm(ks[14], (DEPTH, D_MODEL), 0.02),
        'ln1_b': nrm(ks[15], (DEPTH, D_MODEL), 0.02),
        'w_up': nrm(ks[16], (DEPTH, D_MODEL, D_FF), D_MODEL ** -0.5),
        'w_down': nrm(ks[17], (DEPTH, D_FF, D_MODEL), DEEPNORM_BETA * D_FF ** -0.5),
        'ln2_g': 1.0 + nrm(ks[18], (DEPTH, D_MODEL), 0.02),
        'ln2_b': nrm(ks[19], (DEPTH, D_MODEL), 0.02),
    }


def reference(x_prompt, x_sample, cache_k_win, cache_v_win, state_gla, meta_tokens, w_in, w_a2, b_a, attn_sink,
              gla_norm_g, w_proj_a, w_proj_b, w_out, ln1_g, ln1_b, w_up, w_down, ln2_g, ln2_b):
    B = x_prompt.shape[0]
    meta = jnp.broadcast_to(meta_tokens[None].astype(x_prompt.dtype), (B, N_META, D_MODEL))
    xp = jnp.concatenate([meta, x_prompt], axis=1)
    xs = x_sample
    pos_p = jnp.arange(xp.shape[1])
    pos_s = PAST_LEN + jnp.arange(xs.shape[1])
    pk, pv, pst, sk, sv, sst = [], [], [], [], [], []
    for l in range(DEPTH):
        sink = attn_sink[l].reshape(N_KV_HEADS, Q_PER_KV)
        post = (w_proj_a[l], w_proj_b[l], w_out[l], ln1_g[l], ln1_b[l], w_up[l], w_down[l], ln2_g[l], ln2_b[l])
        q, k, v, g, gr, ga, gb = mixer_projections(xp, pos_p, w_in[l], w_a2[l], b_a[l])
        att = swa_prompt(q, k, v, sink)
        o, S = gla_prompt(*g)
        gla = gla_output(o, gr, gla_norm_g[l])
        pk.append(k[:, -WINDOW:])
        pv.append(v[:, -WINDOW:])
        pst.append(S.astype(xp.dtype))
        xp = finish_layer(xp, att, gla, ga, gb, *post)
        q, k, v, g, gr, ga, gb = mixer_projections(xs, pos_s, w_in[l], w_a2[l], b_a[l])
        att, kb, vb = swa_sample(q, k, v, cache_k_win[l], cache_v_win[l], sink)
        S, o = gla_chunk(state_gla[l].astype(jnp.float32), *g)
        gla = gla_output(o, gr, gla_norm_g[l])
        sk.append(kb)
        sv.append(vb)
        sst.append(S.astype(xs.dtype))
        xs = finish_layer(xs, att, gla, ga, gb, *post)
    y_prompt = xp[:, N_META:]
    y_sample = xs
    return (y_prompt, y_sample, jnp.stack(pk), jnp.stack(pv), jnp.stack(pst), jnp.stack(sk), jnp.stack(sv), jnp.stack(sst))
```

```cpp
#include <hip/hip_runtime.h>
#include <hip/hip_cooperative_groups.h>
#include <cstdio>
#include <cstdint>
namespace cg = cooperative_groups;

#ifndef MK_SINGLE
#define MK_SINGLE 1
#endif

namespace mk {
constexpr int NL = 4;
constexpr int D = 1024, NB = 4, LP = 4112, MP = NB * LP, NS = 128, MREAL = MP + NS, MPAD = 16640;
constexpr int NIN = 4368, NINP = 4608, FF = 4096, PST = 4368;
constexpr int C_Q = 0, C_K = 512, C_V = 640, C_GQ = 768, C_GK = 1024, C_GV = 1280, C_GR = 1792, C_GA = 2304, C_GB = 3328, C_GLR = 4352;
constexpr int NCH = 66;
constexpr float ALPHA = 1.6817928305074290f;
constexpr size_t O_YP = 0, O_YS = 16777216, O_KWP = O_YS + 131072, O_VWP = O_KWP + 262144, O_STP = O_VWP + 262144,
                 O_KWS = O_STP + 524288, O_VWS = O_KWS + 8388608, O_STS = O_VWS + 8388608, O_END = O_STS + 16777216;
constexpr size_t MiB = 1u << 20;
constexpr size_t WS_CTL = 0, CTL_BYTES = 65536, WS_ROPE = 65536, WS_DEC = 1 * MiB, WS_WT = 2 * MiB;
constexpr size_t WT_IN = 0, WT_A = (size_t)NINP * 1024, WT_B = WT_A + 1024 * 512, WT_OUT = WT_B + 1024 * 512, WT_UP = WT_OUT + 1024 * 1024,
                 WT_DOWN = WT_UP + (size_t)4096 * 1024, WT_LAYER = WT_DOWN + (size_t)4096 * 1024;
constexpr size_t WS_P = 124 * MiB, WS_X = 263 * MiB, WS_ACT = 329 * MiB, WS_MIXA = 362 * MiB, WS_MIXB = 379 * MiB, WS_END = 396 * MiB;
static_assert(WS_WT + WT_LAYER * 2 * NL <= WS_P, "wt");
static_assert(WS_P + (size_t)MPAD * PST * 2 <= WS_X && WS_X + (size_t)MPAD * D * 4 <= WS_ACT && WS_ACT + (size_t)MPAD * D * 2 <= WS_MIXA &&
              WS_MIXA + (size_t)MPAD * 512 * 2 <= WS_MIXB && WS_MIXB + (size_t)MPAD * 512 * 2 <= WS_END, "ws map");
static_assert((size_t)MPAD * FF * 2 <= (size_t)MPAD * PST * 2, "H overlays P");
constexpr int LDS_BYTES = 147456;
}
namespace pg8 {
#define PG8_LAS __attribute__((address_space(3)))
typedef unsigned short bf16_t;
typedef short bf16x8 __attribute__((ext_vector_type(8)));
typedef float f32x4 __attribute__((ext_vector_type(4)));
typedef unsigned u32x4 __attribute__((ext_vector_type(4)));
constexpr int BM = 256, BK = 64, HALF = 128, HTB = HALF * BK * 2  , STAGE_BYTES = 8 * HTB, NXCD = 8, WGM = 8;

__host__ __device__ __forceinline__ int lds_byte(int r, int c) { const int st = (r >> 4) * 2 + (c >> 5), rr = r & 15, cc = c & 31, ob = rr * 64 + cc * 2; return st * 1024 + (ob ^ (((ob >> 9) & 1) << 5)); }
__host__ __device__ __forceinline__ void stage_rc(int b, int& R, int& C) { const int st = b / 1024, sb = b % 1024, swz = sb ^ (((sb >> 9) & 1) << 5); R = (st >> 1) * 16 + swz / 64; C = (st & 1) * 32 + (swz % 64) / 2; }
__host__ __device__ __forceinline__ int perm32(int rho) { const int n = rho >> 4, i = rho & 15; return 8 * (i >> 2) + 4 * n + (i & 3); }

struct Unit { int pm, pn; };
struct Gemm { const bf16_t* A; const bf16_t* Bt; int M, N, K; };

struct StaticOrder {
    int nM, nN, nwg, G, c;
    __host__ __device__ void init(int M, int N, int G_, int c_) { nM = M / BM; nN = N / BM; nwg = nM * nN; G = G_; c = c_; }
    __host__ __device__ bool next(int i, Unit& u) const {
        const long L = (long)i * G + c; if (L >= nwg) return false;
        int wgid = (int)L; { const int q = nwg / NXCD, r = nwg % NXCD, xcd = wgid % NXCD, off = wgid / NXCD; wgid = (xcd < r ? xcd * (q + 1) : r * (q + 1) + (xcd - r) * q) + off; }
        const int nig = WGM * nN, gid = wgid / nig, fm = gid * WGM, gsz = (nM - fm) < WGM ? (nM - fm) : WGM;
        u.pm = fm + ((wgid % nig) % gsz); u.pn = (wgid % nig) / gsz; return true;
    }
    __device__ __forceinline__ void a_ready(const Unit&) const {}
    __device__ __forceinline__ void done(const Unit&) const {}
};
__device__ __forceinline__ unsigned cvt_pk_bf16(float lo, float hi) { unsigned r; asm volatile("v_cvt_pk_bf16_f32 %0, %1, %2" : "=v"(r) : "v"(lo), "v"(hi)); return r; }
__device__ __forceinline__ float bflo(unsigned w) { return __uint_as_float(w << 16); }
__device__ __forceinline__ float bfhi(unsigned w) { return __uint_as_float(w & 0xffff0000u); }
__device__ __forceinline__ float sigm(float x) { return 1.0f / (1.0f + __expf(-x)); }
__device__ __forceinline__ u32x4 pack8(const f32x4& v0, const f32x4& v1) { u32x4 w; w.x = cvt_pk_bf16(v0[0], v0[1]); w.y = cvt_pk_bf16(v0[2], v0[3]); w.z = cvt_pk_bf16(v1[0], v1[1]); w.w = cvt_pk_bf16(v1[2], v1[3]); return w; }

struct EpiInProj {
    static constexpr bool PERM = true, AFTER_DRAIN = false;
    bf16_t* P; const float* rope; float* out; int layer;
    __device__ __forceinline__ void operator()(const f32x4 (&acc)[2][2][4][2], const Unit& u, int wr, int wc, int fr, int fq) const {
        using namespace mk;
#pragma unroll
        for (int ai = 0; ai < 2; ++ai)
#pragma unroll
            for (int m = 0; m < 4; ++m) {
                const int row = u.pm * BM + ai * HALF + wr * 64 + m * 16 + fr;
                const bool samp = row >= MP;
                int b = 0, p = 0, pi = LP;
                if (!samp) { b = row / LP; p = row - b * LP; pi = p; }
#pragma unroll
                for (int bj = 0; bj < 2; ++bj) {
                    const int ct = u.pn * BM + bj * HALF + wc * 32;
                    const int c0 = ct + 8 * fq;
                    f32x4 v0 = acc[ai][bj][m][0], v1 = acc[ai][bj][m][1];
                    if (ct < C_V && (wc & 1) == 0) {
                        f32x4 p0, p1;
#pragma unroll
                        for (int j = 0; j < 4; ++j) { p0[j] = __shfl_xor(v0[j], 16); p1[j] = __shfl_xor(v1[j], 16); }
                        if (fq < 2) {
                            const f32x4* T = (const f32x4*)(rope + (size_t)pi * 16);
                            const f32x4 c0v = T[0], c1v = T[1], s0v = T[2], s1v = T[3];
                            if (fq == 0) { v0 = v0 * c0v - p0 * s0v; v1 = v1 * c1v - p1 * s1v; }
                            else         { v0 = v0 * c0v + p0 * s0v; v1 = v1 * c1v + p1 * s1v; }
                        }
                    }
                    if (u.pn == 2) {
                        const int cc = c0 - C_K;
                        float* dst = nullptr;
                        if (samp) { if (row < MREAL) dst = out + (cc < 128 ? O_KWS : O_VWS) + ((size_t)(layer * NS + (row - MP)) * 128 + 127) * 128 + (cc & 127); }
                        else if (p >= LP - 128) dst = out + (cc < 128 ? O_KWP : O_VWP) + ((size_t)(layer * NB + b) * 128 + (p - (LP - 128))) * 128 + (cc & 127);
                        if (dst) { *(f32x4*)dst = v0; *(f32x4*)(dst + 4) = v1; }
                    }
                    if (c0 < NIN) *(u32x4*)(P + (size_t)row * PST + c0) = pack8(v0, v1);
                }
            }
    }
};
struct EpiProjA {
    static constexpr bool PERM = true, AFTER_DRAIN = false;
    bf16_t* P;
    __device__ __forceinline__ void operator()(const f32x4 (&acc)[2][2][4][2], const Unit& u, int wr, int wc, int fr, int fq) const {
        using namespace mk;
#pragma unroll
        for (int ai = 0; ai < 2; ++ai)
#pragma unroll
            for (int m = 0; m < 4; ++m) {
                const int row = u.pm * BM + ai * HALF + wr * 64 + m * 16 + fr;
                bf16_t* prow = P + (size_t)row * PST;
#pragma unroll
                for (int bj = 0; bj < 2; ++bj) {
                    const int c0 = u.pn * BM + bj * HALF + wc * 32 + 8 * fq;
                    const u32x4 g = *(const u32x4*)(prow + C_GA + c0);
                    f32x4 v0 = acc[ai][bj][m][0], v1 = acc[ai][bj][m][1];
                    v0[0] *= sigm(bflo(g.x)); v0[1] *= sigm(bfhi(g.x)); v0[2] *= sigm(bflo(g.y)); v0[3] *= sigm(bfhi(g.y));
                    v1[0] *= sigm(bflo(g.z)); v1[1] *= sigm(bfhi(g.z)); v1[2] *= sigm(bflo(g.w)); v1[3] *= sigm(bfhi(g.w));
                    float* t = (float*)prow + c0;
                    *(f32x4*)t = v0; *(f32x4*)(t + 4) = v1;
                }
            }
    }
};
struct EpiProjB {
    static constexpr bool PERM = true, AFTER_DRAIN = false;
    bf16_t* P; bf16_t* O;
    __device__ __forceinline__ void operator()(const f32x4 (&acc)[2][2][4][2], const Unit& u, int wr, int wc, int fr, int fq) const {
        using namespace mk;
#pragma unroll
        for (int ai = 0; ai < 2; ++ai)
#pragma unroll
            for (int m = 0; m < 4; ++m) {
                const int row = u.pm * BM + ai * HALF + wr * 64 + m * 16 + fr;
                bf16_t* prow = P + (size_t)row * PST;
#pragma unroll
                for (int bj = 0; bj < 2; ++bj) {
                    const int c0 = u.pn * BM + bj * HALF + wc * 32 + 8 * fq;
                    const u32x4 g = *(const u32x4*)(prow + C_GB + c0);
                    const float* t = (const float*)prow + c0;
                    f32x4 v0 = *(const f32x4*)t, v1 = *(const f32x4*)(t + 4);
                    const f32x4 a0 = acc[ai][bj][m][0], a1 = acc[ai][bj][m][1];
                    v0[0] += a0[0] * sigm(bflo(g.x)); v0[1] += a0[1] * sigm(bfhi(g.x)); v0[2] += a0[2] * sigm(bflo(g.y)); v0[3] += a0[3] * sigm(bfhi(g.y));
                    v1[0] += a1[0] * sigm(bflo(g.z)); v1[1] += a1[1] * sigm(bfhi(g.z)); v1[2] += a1[2] * sigm(bflo(g.w)); v1[3] += a1[3] * sigm(bfhi(g.w));
                    *(u32x4*)(O + (size_t)row * D + c0) = pack8(v0, v1);
                }
            }
    }
};
struct EpiResid {
    static constexpr bool PERM = true, AFTER_DRAIN = false;
    float* X;
    __device__ __forceinline__ void operator()(const f32x4 (&acc)[2][2][4][2], const Unit& u, int wr, int wc, int fr, int fq) const {
        using namespace mk;
#pragma unroll
        for (int ai = 0; ai < 2; ++ai)
#pragma unroll
            for (int m = 0; m < 4; ++m) {
                const int row = u.pm * BM + ai * HALF + wr * 64 + m * 16 + fr;
#pragma unroll
                for (int bj = 0; bj < 2; ++bj) {
                    const int c0 = u.pn * BM + bj * HALF + wc * 32 + 8 * fq;
                    float* x = X + (size_t)row * D + c0;
                    const f32x4 x0 = *(const f32x4*)x, x1 = *(const f32x4*)(x + 4);
                    *(f32x4*)x = x0 * ALPHA + acc[ai][bj][m][0]; *(f32x4*)(x + 4) = x1 * ALPHA + acc[ai][bj][m][1];
                }
            }
    }
};
struct EpiUp {
    static constexpr bool PERM = true, AFTER_DRAIN = false;
    bf16_t* H;
    __device__ __forceinline__ void operator()(const f32x4 (&acc)[2][2][4][2], const Unit& u, int wr, int wc, int fr, int fq) const {
        using namespace mk;
#pragma unroll
        for (int ai = 0; ai < 2; ++ai)
#pragma unroll
            for (int m = 0; m < 4; ++m) {
                const int row = u.pm * BM + ai * HALF + wr * 64 + m * 16 + fr;
#pragma unroll
                for (int bj = 0; bj < 2; ++bj) {
                    const int c0 = u.pn * BM + bj * HALF + wc * 32 + 8 * fq;
                    f32x4 v0 = acc[ai][bj][m][0], v1 = acc[ai][bj][m][1];
#pragma unroll
                    for (int j = 0; j < 4; ++j) { const float a = fmaxf(v0[j], 0.f), b = fmaxf(v1[j], 0.f); v0[j] = a * a; v1[j] = b * b; }
                    *(u32x4*)(H + (size_t)row * FF + c0) = pack8(v0, v1);
                }
            }
    }
};
template <class Epi, class Sched, bool ALIGN_EPI = false, bool SP2 = false>
__device__ __forceinline__ void gemm_phase(PG8_LAS unsigned char* lds, const Gemm g, const Sched& S, const Epi& E) {
    int tid_ = threadIdx.x; asm volatile("" : "+v"(tid_));
    const int tid = tid_, wid = __builtin_amdgcn_readfirstlane(tid >> 6), lane = tid & 63, wr = wid >> 2, wc = wid & 3, fr = lane & 15, fq = lane >> 4;
    const int K = g.K, nt = K / BK;
    unsigned voffA[2], voffB[2];
#pragma unroll
    for (int i = 0; i < 2; ++i) { int R, C; stage_rc(tid * 16 + i * 8192, R, C); const int Rb = Epi::PERM ? ((R & ~31) + perm32(R & 31)) : R;
        voffA[i] = (unsigned)(R * K + C) * 2u; voffB[i] = (unsigned)(Rb * K + C) * 2u; }
    const size_t kstep = (size_t)(BK * 2);
    const size_t hstep = (size_t)HALF * K * 2;
    const size_t tstep = 2 * hstep;
    const unsigned ldsw = (unsigned)wid * 1024u;
    const int aoff = lds_byte(wr * 64 + fr, fq * 8), boff = lds_byte(wc * 32 + fr, fq * 8);
#define PG8_SA(b, h) (((b) * 2 + (h)) * HTB)
#define PG8_SB(b, h) ((4 + (b) * 2 + (h)) * HTB)
#define PG8_STAGE(bufoff, gbase, voff) do { _Pragma("unroll") for (int _i = 0; _i < 2; ++_i) \
        __builtin_amdgcn_global_load_lds((const unsigned*)((const char*)(gbase) + (voff)[_i]), (PG8_LAS unsigned*)(lds + (bufoff) + ldsw + _i * 8192), 16, 0, 0); } while (0)
#define PG8_LDA(dst, b, h) do { _Pragma("unroll") for (int m = 0; m < 4; ++m) _Pragma("unroll") for (int k = 0; k < 2; ++k) dst[m][k] = *(const PG8_LAS bf16x8*)(lds + PG8_SA(b, h) + aoff + m * 2048 + k * 1024); } while (0)
#define PG8_LDB(dst, b, h) do { _Pragma("unroll") for (int n = 0; n < 2; ++n) _Pragma("unroll") for (int k = 0; k < 2; ++k) dst[n][k] = *(const PG8_LAS bf16x8*)(lds + PG8_SB(b, h) + boff + n * 2048 + k * 1024); } while (0)
#define PG8_MMA(ai, bj, At, Bt) do { __builtin_amdgcn_s_setprio(1); _Pragma("unroll") for (int m = 0; m < 4; ++m) _Pragma("unroll") for (int n = 0; n < 2; ++n) _Pragma("unroll") for (int k = 0; k < 2; ++k) \
        acc[ai][bj][m][n] = __builtin_amdgcn_mfma_f32_16x16x32_bf16(Bt[n][k], At[m][k], acc[ai][bj][m][n], 0, 0, 0); __builtin_amdgcn_s_setprio(0); } while (0)
#define PG8_WAIT_V(n) asm volatile("s_waitcnt vmcnt(" #n ")" ::: "memory")
#define PG8_WAIT_L(n) asm volatile("s_waitcnt lgkmcnt(" #n ")" ::: "memory")
#define PG8_BAR __builtin_amdgcn_s_barrier()
#define PG8_SCHED __builtin_amdgcn_sched_barrier(0)
    Unit cur, nxt; int ui = 0;
    if (!S.next(0, cur)) return;
    f32x4 acc[2][2][4][2];
#pragma unroll
    for (int a = 0; a < 2; ++a)
#pragma unroll
        for (int b = 0; b < 2; ++b)
#pragma unroll
            for (int m = 0; m < 4; ++m)
#pragma unroll
                for (int n = 0; n < 2; ++n) acc[a][b][m][n] = (f32x4){0.f, 0.f, 0.f, 0.f};
    bf16x8 At[4][2], B0[2][2], B1[2][2];
    const char* cA = (const char*)g.A + (size_t)cur.pm * tstep; const char* cB = (const char*)g.Bt + (size_t)cur.pn * tstep;
    S.a_ready(cur);
    if constexpr (SP2) {
        PG8_STAGE(PG8_SB(0, 0), cB, voffB); PG8_STAGE(PG8_SB(0, 1), cB + hstep, voffB); PG8_STAGE(PG8_SA(0, 0), cA, voffA); PG8_STAGE(PG8_SA(0, 1), cA + hstep, voffA);
        if (wr == 1) PG8_BAR;
        PG8_WAIT_V(2); PG8_BAR;
        PG8_STAGE(PG8_SB(1, 0), cB + kstep, voffB); PG8_STAGE(PG8_SA(1, 0), cA + kstep, voffA); PG8_STAGE(PG8_SB(1, 1), cB + hstep + kstep, voffB);
        PG8_WAIT_V(6); PG8_BAR;
    } else {
        PG8_STAGE(PG8_SB(0, 0), cB, voffB); PG8_STAGE(PG8_SA(0, 0), cA, voffA); PG8_STAGE(PG8_SB(0, 1), cB + hstep, voffB); PG8_STAGE(PG8_SA(0, 1), cA + hstep, voffA);
        if (wr == 1) PG8_BAR;
        PG8_WAIT_V(4); PG8_BAR;
        PG8_STAGE(PG8_SB(1, 0), cB + kstep, voffB); PG8_STAGE(PG8_SA(1, 0), cA + kstep, voffA); PG8_STAGE(PG8_SB(1, 1), cB + hstep + kstep, voffB);
        PG8_WAIT_V(6); PG8_BAR;
    }
    for (;;) {
        const bool has_next = S.next(ui + 1, nxt);
        const char* nA = has_next ? (const char*)g.A + (size_t)nxt.pm * tstep : cA; const char* nB = has_next ? (const char*)g.Bt + (size_t)nxt.pn * tstep : cB;
        for (int t = 0; t < nt; t += 2) {
            const bool last = (t == nt - 2);
            const char* a1 = cA + (size_t)(t + 1) * kstep;
            const char* a2 = last ? nA : cA + (size_t)(t + 2) * kstep; const char* b2 = last ? nB : cB + (size_t)(t + 2) * kstep;
            const char* a3 = a2 + kstep; const char* b3 = b2 + kstep;
            if (last && has_next) S.a_ready(nxt);
            if constexpr (SP2) {
            PG8_LDB(B0, 0, 0); PG8_LDB(B1, 0, 1); PG8_SCHED; PG8_LDA(At, 0, 0); PG8_STAGE(PG8_SA(1, 1), a1 + hstep, voffA);
            PG8_WAIT_V(8); PG8_WAIT_L(0); PG8_BAR; PG8_MMA(0, 0, At, B0); PG8_MMA(0, 1, At, B1); PG8_BAR; PG8_SCHED;
            PG8_LDA(At, 0, 1); PG8_STAGE(PG8_SB(0, 0), b2, voffB); PG8_STAGE(PG8_SB(0, 1), b2 + hstep, voffB); PG8_STAGE(PG8_SA(0, 0), a2, voffA);
            PG8_WAIT_V(8); PG8_WAIT_L(0); PG8_BAR; PG8_MMA(1, 0, At, B0); PG8_MMA(1, 1, At, B1); PG8_BAR; PG8_SCHED;
            PG8_LDB(B0, 1, 0); PG8_LDB(B1, 1, 1); PG8_SCHED; PG8_LDA(At, 1, 0); PG8_STAGE(PG8_SA(0, 1), a2 + hstep, voffA);
            PG8_WAIT_V(8); PG8_WAIT_L(0); PG8_BAR; PG8_MMA(0, 0, At, B0); PG8_MMA(0, 1, At, B1); PG8_BAR; PG8_SCHED;
            PG8_LDA(At, 1, 1); PG8_STAGE(PG8_SB(1, 0), b3, voffB); PG8_STAGE(PG8_SB(1, 1), b3 + hstep, voffB); PG8_STAGE(PG8_SA(1, 0), a3, voffA);
            PG8_WAIT_V(8); PG8_WAIT_L(0); PG8_BAR; PG8_MMA(1, 0, At, B0); PG8_MMA(1, 1, At, B1); PG8_BAR; PG8_SCHED;
            } else {
            PG8_LDB(B0, 0, 0); PG8_SCHED; PG8_LDA(At, 0, 0); PG8_STAGE(PG8_SA(1, 1), a1 + hstep, voffA);
            PG8_WAIT_L(8); PG8_BAR; PG8_WAIT_L(0); PG8_MMA(0, 0, At, B0); PG8_BAR; PG8_SCHED;
            PG8_LDB(B1, 0, 1); PG8_STAGE(PG8_SB(0, 0), b2, voffB);
            PG8_BAR; PG8_WAIT_L(0); PG8_MMA(0, 1, At, B1); PG8_BAR;
            PG8_LDA(At, 0, 1); PG8_STAGE(PG8_SA(0, 0), a2, voffA);
            PG8_BAR; PG8_WAIT_L(0); PG8_MMA(1, 0, At, B0); PG8_BAR; PG8_SCHED;
            PG8_STAGE(PG8_SB(0, 1), b2 + hstep, voffB);
            PG8_WAIT_V(6); PG8_BAR; PG8_MMA(1, 1, At, B1); PG8_BAR;
            PG8_LDB(B0, 1, 0); PG8_SCHED; PG8_LDA(At, 1, 0); PG8_STAGE(PG8_SA(0, 1), a2 + hstep, voffA);
            PG8_WAIT_L(8); PG8_BAR; PG8_WAIT_L(0); PG8_MMA(0, 0, At, B0); PG8_BAR; PG8_SCHED;
            PG8_LDB(B1, 1, 1); PG8_STAGE(PG8_SB(1, 0), b3, voffB);
            PG8_BAR; PG8_WAIT_L(0); PG8_MMA(0, 1, At, B1); PG8_BAR;
            PG8_LDA(At, 1, 1); PG8_STAGE(PG8_SA(1, 0), a3, voffA);
            PG8_BAR; PG8_WAIT_L(0); PG8_MMA(1, 0, At, B0); PG8_BAR; PG8_SCHED;
            PG8_STAGE(PG8_SB(1, 1), b3 + hstep, voffB);
            PG8_WAIT_V(6); PG8_BAR; PG8_MMA(1, 1, At, B1); PG8_BAR;
            }
        }
        if constexpr (ALIGN_EPI) { if (wr == 0) PG8_BAR; }
        if constexpr (!Epi::AFTER_DRAIN) { E(acc, cur, wr, wc, fr, fq); S.done(cur); }
        if (!has_next) break;
#pragma unroll
        for (int a = 0; a < 2; ++a)
#pragma unroll
            for (int b = 0; b < 2; ++b)
#pragma unroll
                for (int m = 0; m < 4; ++m)
#pragma unroll
                    for (int n = 0; n < 2; ++n) acc[a][b][m][n] = (f32x4){0.f, 0.f, 0.f, 0.f};
        cur = nxt; cA = nA; cB = nB; ++ui;
        if constexpr (ALIGN_EPI) { if (wr == 1) PG8_BAR; }
    }
    PG8_WAIT_V(0);
    if constexpr (!ALIGN_EPI) { if (wr == 0) PG8_BAR; }
    PG8_BAR;
    if constexpr (Epi::AFTER_DRAIN) { E.fused(acc, cur, wr, wc, fr, fq, lds, wid, lane); S.done(cur); }
#undef PG8_SA
#undef PG8_SB
#undef PG8_STAGE
#undef PG8_LDA
#undef PG8_LDB
#undef PG8_MMA
#undef PG8_WAIT_V
#undef PG8_WAIT_L
#undef PG8_BAR
#undef PG8_SCHED
}
}

#define LAS __attribute__((address_space(3)))
namespace mk {
typedef unsigned short bf16;
typedef unsigned u32x4 __attribute__((ext_vector_type(4)));
typedef unsigned u32x2 __attribute__((ext_vector_type(2)));
typedef float f32x4 __attribute__((ext_vector_type(4)));
typedef short bf16x8 __attribute__((ext_vector_type(8)));
constexpr int NT = 512;

__device__ __forceinline__ unsigned f2bf(float f) { unsigned u = __builtin_bit_cast(unsigned, f); return (u + 0x7fffu + ((u >> 16) & 1u)) >> 16; }
__device__ __forceinline__ unsigned pk2(float lo, float hi) { return f2bf(lo) | (f2bf(hi) << 16); }
__device__ __forceinline__ float bf2f(unsigned h) { return __uint_as_float(h << 16); }
__device__ __forceinline__ float bflo(unsigned w) { return __uint_as_float(w << 16); }
__device__ __forceinline__ float bfhi(unsigned w) { return __uint_as_float(w & 0xffff0000u); }
__device__ __forceinline__ float wave_sum(float v) {
#pragma unroll
    for (int o = 1; o < 64; o <<= 1) v += __shfl_xor(v, o);
    return v;
}
__device__ __forceinline__ float wave_max(float v) {
#pragma unroll
    for (int o = 1; o < 64; o <<= 1) v = fmaxf(v, __shfl_xor(v, o));
    return v;
}
__device__ __forceinline__ float logsig(float x) { return fminf(x, 0.f) - log1pf(__expf(-fabsf(x))); }

struct Args { const float* in[20]; float* out; unsigned char* ws; int ph_lo, ph_hi; };

__device__ __forceinline__ int win_dst(int n) { return n < 1792 ? n : (n < 1808 ? C_GLR + (n - 1792) : n - 16); }
template <bool MAP>
__device__ __forceinline__ void transpose_item(const float* W, int K, int N, bf16* WT, LAS float* scr, int item, int lane) {
    const int nblk = (N + 31) / 32, kb = item / nblk, nb = item % nblk, k0 = 64 * kb, n0 = 32 * nb;
    const int ncol = n0 + (lane & 31);
#pragma unroll 8
    for (int i = 0; i < 32; ++i) { const int kk = 2 * i + (lane >> 5); scr[kk * 33 + (lane & 31)] = (ncol < N) ? W[(size_t)(k0 + kk) * N + ncol] : 0.f; }
    asm volatile("s_waitcnt lgkmcnt(0)" ::: "memory");
    const int c = lane & 7;
#pragma unroll
    for (int j = 0; j < 4; ++j) { const int n = (lane >> 3) + 8 * j; const LAS float* s = scr + (8 * c) * 33 + n;
        u32x4 o; o.x = pk2(s[0 * 33], s[1 * 33]); o.y = pk2(s[2 * 33], s[3 * 33]); o.z = pk2(s[4 * 33], s[5 * 33]); o.w = pk2(s[6 * 33], s[7 * 33]);
        const int nsrc = n0 + n;
        if (nsrc < N) { const int nd = MAP ? win_dst(nsrc) : nsrc; *(u32x4*)(WT + (size_t)nd * K + k0 + 8 * c) = o; } }
    asm volatile("s_waitcnt lgkmcnt(0)" ::: "memory");
}

__device__ __forceinline__ void p0_prologue(const Args& a, LAS unsigned char* lds, int tid) {
    const int lane = tid & 63, wave = tid >> 6;
    const int gw = blockIdx.x * 8 + wave, NGW = gridDim.x * 8;
    LAS float* scr = (LAS float*)(lds + wave * 16384);
    bf16* WTb = (bf16*)(a.ws + WS_WT);
    constexpr int I_IN = 16 * 137, I_A = 8 * 32, I_O = 16 * 32, I_U = 16 * 128, I_D = 64 * 32, I_L = I_IN + 2 * I_A + I_O + I_U + I_D;
    for (int it = gw; it < NL * I_L; it += NGW) {
        const int l = it / I_L; int r = it - l * I_L; bf16* wt = WTb + (size_t)l * WT_LAYER;
        if (r < I_IN) { transpose_item<true>(a.in[6] + (size_t)l * 1024 * NIN, 1024, NIN, wt + WT_IN, scr, r, lane); continue; } r -= I_IN;
        if (r < I_A) { transpose_item<false>(a.in[11] + (size_t)l * 512 * 1024, 512, 1024, wt + WT_A, scr, r, lane); continue; } r -= I_A;
        if (r < I_A) { transpose_item<false>(a.in[12] + (size_t)l * 512 * 1024, 512, 1024, wt + WT_B, scr, r, lane); continue; } r -= I_A;
        if (r < I_O) { transpose_item<false>(a.in[13] + (size_t)l * 1024 * 1024, 1024, 1024, wt + WT_OUT, scr, r, lane); continue; } r -= I_O;
        if (r < I_U) { transpose_item<false>(a.in[16] + (size_t)l * 1024 * 4096, 1024, 4096, wt + WT_UP, scr, r, lane); continue; } r -= I_U;
        transpose_item<false>(a.in[17] + (size_t)l * 4096 * 1024, 4096, 1024, wt + WT_DOWN, scr, r, lane);
    }
    float* rope = (float*)(a.ws + WS_ROPE);
    for (int i = blockIdx.x * NT + tid; i < (LP + 1) * 8; i += gridDim.x * NT) {
        const int pi = i >> 3, f = i & 7; const float pos = (pi == LP) ? 8192.f : (float)pi;
        const float inv = powf(500000.0f, -(float)f * 0.125f);
        const float ang = pos * inv;
        const double rev = (double)ang * 0.15915494309189535; const float fr = (float)(rev - rint(rev));
        rope[pi * 16 + f] = __builtin_amdgcn_cosf(fr); rope[pi * 16 + 8 + f] = __builtin_amdgcn_sinf(fr);
    }
    float* X = (float*)(a.ws + WS_X); bf16* ACT = (bf16*)(a.ws + WS_ACT);
    for (int row = gw; row < MPAD; row += NGW) {
        const float* src = nullptr;
        if (row < MP) { const int b = row / LP, p = row - b * LP; src = (p < 16) ? a.in[5] + (size_t)p * D : a.in[0] + ((size_t)b * 4096 + (p - 16)) * D; }
        else if (row < MREAL) src = a.in[1] + (size_t)(row - MP) * D;
#pragma unroll
        for (int j = 0; j < 4; ++j) {
            f32x4 v = src ? *((const f32x4*)src + lane + 64 * j) : (f32x4){0.f, 0.f, 0.f, 0.f};
            *((f32x4*)(X + (size_t)row * D) + lane + 64 * j) = v;
            u32x2 w; w.x = pk2(v.x, v.y); w.y = pk2(v.z, v.w);
            *((u32x2*)(ACT + (size_t)row * D) + lane + 64 * j) = w;
        }
    }
}

__device__ __forceinline__ void ln_phase(const Args& a, const float* g, const float* bt, bool last, int tid) {
    const int lane = tid & 63, wave = tid >> 6;
    const int gw = blockIdx.x * 8 + wave, NGW = gridDim.x * 8;
    float* X = (float*)(a.ws + WS_X); bf16* ACT = (bf16*)(a.ws + WS_ACT);
    f32x4 gv[4], bv[4];
#pragma unroll
    for (int j = 0; j < 4; ++j) { gv[j] = *((const f32x4*)g + lane + 64 * j); bv[j] = *((const f32x4*)bt + lane + 64 * j); }
    for (int row = gw; row < MREAL; row += NGW) {
        f32x4* xr = (f32x4*)(X + (size_t)row * D) + lane;
        f32x4 v[4]; float s = 0.f;
#pragma unroll
        for (int j = 0; j < 4; ++j) { v[j] = xr[64 * j]; s += (v[j].x + v[j].y) + (v[j].z + v[j].w); }
        const float mean = wave_sum(s) * (1.f / D); float s2 = 0.f;
#pragma unroll
        for (int j = 0; j < 4; ++j) { v[j] = v[j] - mean; s2 += (v[j].x * v[j].x + v[j].y * v[j].y) + (v[j].z * v[j].z + v[j].w * v[j].w); }
        const float rstd = 1.f / sqrtf(wave_sum(s2) * (1.f / D) + 1e-5f);
        float* yo = nullptr;
        if (last) { if (row >= MP) yo = a.out + O_YS + (size_t)(row - MP) * D; else { const int b = row / LP, p = row - b * LP; if (p >= 16) yo = a.out + O_YP + ((size_t)b * 4096 + (p - 16)) * D; } }
#pragma unroll
        for (int j = 0; j < 4; ++j) {
            const f32x4 o = v[j] * rstd * gv[j] + bv[j];
            if (last) { if (yo) *((f32x4*)yo + lane + 64 * j) = o; }
            else { xr[64 * j] = o; u32x2 w; w.x = pk2(o.x, o.y); w.y = pk2(o.z, o.w); *((u32x2*)(ACT + (size_t)row * D) + lane + 64 * j) = w; }
        }
    }
}

__device__ __forceinline__ void attn_item(LAS unsigned char* lds, const bf16* P, bf16* MIXA, float sink, int b, int n, int h, int tid) {
    LAS bf16* Ks = (LAS bf16*)lds;
    LAS bf16* Vt = (LAS bf16*)(lds + 36864);
    const int kvh = h >> 2, lane = tid & 63, w = tid >> 6, fr = lane & 15, fq = lane >> 4;
    for (int i = tid; i < 64 * 24; i += NT) Vt[(i / 24) * 280 + 256 + (i % 24)] = 0;
#pragma unroll
    for (int i = 0; i < 4; ++i) {
        const int q = tid + NT * i, key = q >> 3, part = q & 7, slot = (n - 1) * 128 + key;
        u32x4 kv = (u32x4){0u, 0u, 0u, 0u}, vv = (u32x4){0u, 0u, 0u, 0u};
        if (slot >= 112) { const bf16* src = P + (size_t)(b * LP + slot - 112) * PST; kv = *(const u32x4*)(src + C_K + kvh * 64 + part * 8); vv = *(const u32x4*)(src + C_V + kvh * 64 + part * 8); }
        *(LAS u32x4*)(Ks + key * 72 + part * 8) = kv;
        LAS bf16* vd = Vt + (part * 8) * 280 + key;
        vd[0 * 280] = (bf16)(vv.x & 0xffffu); vd[1 * 280] = (bf16)(vv.x >> 16); vd[2 * 280] = (bf16)(vv.y & 0xffffu); vd[3 * 280] = (bf16)(vv.y >> 16);
        vd[4 * 280] = (bf16)(vv.z & 0xffffu); vd[5 * 280] = (bf16)(vv.z >> 16); vd[6 * 280] = (bf16)(vv.w & 0xffffu); vd[7 * 280] = (bf16)(vv.w >> 16);
    }
    const int qi = 16 * w + fr, slotq = n * 128 + qi; const bool qv = slotq >= 112;
    const size_t qrow = (size_t)(b * LP + slotq - 112);
    bf16x8 qf[2];
#pragma unroll
    for (int kk = 0; kk < 2; ++kk) { qf[kk] = (bf16x8){0, 0, 0, 0, 0, 0, 0, 0}; if (qv) qf[kk] = *(const bf16x8*)(P + qrow * PST + h * 64 + kk * 32 + 8 * fq); }
    __syncthreads();
    f32x4 s[9];
#pragma unroll
    for (int r = 0; r < 9; ++r) {
        f32x4 acc = (f32x4){0.f, 0.f, 0.f, 0.f};
#pragma unroll
        for (int kk = 0; kk < 2; ++kk) { const bf16x8 kf = *(const LAS bf16x8*)(Ks + ((w + r) * 16 + fr) * 72 + kk * 32 + 8 * fq); acc = __builtin_amdgcn_mfma_f32_16x16x32_bf16(kf, qf[kk], acc, 0, 0, 0); }
        s[r] = acc;
    }
    float mx = sink;
#pragma unroll
    for (int r = 0; r < 9; ++r)
#pragma unroll
        for (int j = 0; j < 4; ++j) {
            const int dl = 16 * r + 4 * fq + j - fr, slotk = (n - 1) * 128 + 16 * (w + r) + 4 * fq + j;
            const bool ok = dl > 0 && dl <= 128 && slotk >= 112;
            const float v = ok ? s[r][j] * 0.125f : -INFINITY; s[r][j] = v; mx = fmaxf(mx, v);
        }
    mx = fmaxf(mx, __shfl_xor(mx, 16)); mx = fmaxf(mx, __shfl_xor(mx, 32));
    float sum = 0.f;
#pragma unroll
    for (int r = 0; r < 9; ++r)
#pragma unroll
        for (int j = 0; j < 4; ++j) { const float p = __expf(s[r][j] - mx); s[r][j] = p; sum += p; }
    sum += __shfl_xor(sum, 16); sum += __shfl_xor(sum, 32);
    const float rden = 1.0f / (sum + __expf(sink - mx));
    f32x4 o[4];
#pragma unroll
    for (int dt = 0; dt < 4; ++dt) o[dt] = (f32x4){0.f, 0.f, 0.f, 0.f};
#pragma unroll
    for (int ks = 0; ks < 5; ++ks) {
        u32x4 pw; pw.x = pk2(s[2 * ks][0], s[2 * ks][1]); pw.y = pk2(s[2 * ks][2], s[2 * ks][3]);
        if (ks < 4) { pw.z = pk2(s[2 * ks + 1 > 8 ? 8 : 2 * ks + 1][0], s[2 * ks + 1 > 8 ? 8 : 2 * ks + 1][1]); pw.w = pk2(s[2 * ks + 1 > 8 ? 8 : 2 * ks + 1][2], s[2 * ks + 1 > 8 ? 8 : 2 * ks + 1][3]); }
        else { pw.z = 0u; pw.w = 0u; }
        const bf16x8 pf = __builtin_bit_cast(bf16x8, pw);
        const int keyb = 16 * (w + 2 * ks) + 4 * fq;
#pragma unroll
        for (int dt = 0; dt < 4; ++dt) {
            const LAS bf16* vp = Vt + (dt * 16 + fr) * 280 + keyb;
            const u32x2 lo = *(const LAS u32x2*)vp, hi = *(const LAS u32x2*)(vp + 16);
            u32x4 vw; vw.x = lo.x; vw.y = lo.y; vw.z = hi.x; vw.w = hi.y;
            o[dt] = __builtin_amdgcn_mfma_f32_16x16x32_bf16(__builtin_bit_cast(bf16x8, vw), pf, o[dt], 0, 0, 0);
        }
    }
    if (qv) {
#pragma unroll
        for (int dt = 0; dt < 4; ++dt) { u32x2 w2; w2.x = pk2(o[dt][0] * rden, o[dt][1] * rden); w2.y = pk2(o[dt][2] * rden, o[dt][3] * rden);
            *(u32x2*)(MIXA + qrow * 512 + h * 64 + dt * 16 + 4 * fq) = w2; }
    }
}

__device__ __forceinline__ void sattn_item(LAS unsigned char* lds, const Args& a, int layer, int s, int tid) {
    LAS float* Kf = (LAS float*)lds;
    LAS float* Vf = Kf + 16384;
    LAS float* qs = Vf + 16384;
    LAS float* ps = qs + 512;
    const bf16* P = (const bf16*)(a.ws + WS_P);
    bf16* MIXA = (bf16*)(a.ws + WS_MIXA);
    const float* ck = a.in[2] + (size_t)(layer * NS + s) * 16384; const float* cv = a.in[3] + (size_t)(layer * NS + s) * 16384;
    float* ok = a.out + O_KWS + (size_t)(layer * NS + s) * 16384; float* ov = a.out + O_VWS + (size_t)(layer * NS + s) * 16384;
    for (int f4 = tid; f4 < 128 * 32; f4 += NT) {
        const int f = f4 * 4, r = f >> 7, rem = f & 127, li = (rem >> 6) * 8192 + r * 64 + (rem & 63);
        f32x4 kv, vv;
        if (r < 127) { kv = *(const f32x4*)(ck + 128 + f); vv = *(const f32x4*)(cv + 128 + f); *(f32x4*)(ok + f) = kv; *(f32x4*)(ov + f) = vv; }
        else { kv = *(const f32x4*)(ok + f); vv = *(const f32x4*)(ov + f); }
        *(LAS f32x4*)(Kf + li) = kv; *(LAS f32x4*)(Vf + li) = vv;
    }
    const int row = MP + s, h = tid >> 6, lane = tid & 63, kvh = h >> 2;
    qs[tid] = bf2f(P[(size_t)row * PST + tid]);
    __syncthreads();
    const float sink = a.in[9][layer * 8 + h];
    float s0 = 0.f, s1 = 0.f;
    const LAS float* k0 = Kf + kvh * 8192 + lane * 64; const LAS float* k1 = k0 + 64 * 64;
#pragma unroll 8
    for (int d = 0; d < 64; ++d) { const int dd = (d + lane) & 63; const float q = qs[h * 64 + dd]; s0 += q * k0[dd]; s1 += q * k1[dd]; }
    s0 *= 0.125f; s1 *= 0.125f;
    const float mx = fmaxf(wave_max(fmaxf(s0, s1)), sink);
    const float p0 = __expf(s0 - mx), p1 = __expf(s1 - mx);
    const float rden = 1.0f / (wave_sum(p0 + p1) + __expf(sink - mx));
    ps[h * 128 + lane] = p0; ps[h * 128 + 64 + lane] = p1;
    __syncthreads();
    float o = 0.f;
    const LAS float* vb = Vf + kvh * 8192 + lane;
#pragma unroll 8
    for (int r = 0; r < 128; ++r) o += ps[h * 128 + r] * vb[r * 64];
    MIXA[(size_t)row * 512 + tid] = (bf16)f2bf(o * rden);
}

__device__ __forceinline__ void gla_prep(LAS float* tot, const Args& a, int layer, int h, int rowbase  , int tvalid0, int tid, float (&cum)[8]) {
    const bf16* P = (const bf16*)(a.ws + WS_P);
    const int d = tid & 63, tg = tid >> 6;
    float wa[16];
#pragma unroll
    for (int r = 0; r < 16; ++r) wa[r] = a.in[7][(size_t)(layer * 16 + r) * 256 + h * 64 + d];
    const float ba = a.in[8][layer * 256 + h * 64 + d];
    float run = 0.f;
#pragma unroll
    for (int i = 0; i < 8; ++i) {
        const int t = tg * 8 + i; float la = 0.f;
        if (t >= tvalid0) {
            const u32x4* gp = (const u32x4*)(P + (size_t)(rowbase + t) * PST + C_GLR);
            const u32x4 g0 = gp[0], g1 = gp[1];
            float x = ba;
            x += bflo(g0.x) * wa[0] + bfhi(g0.x) * wa[1] + bflo(g0.y) * wa[2] + bfhi(g0.y) * wa[3] + bflo(g0.z) * wa[4] + bfhi(g0.z) * wa[5] + bflo(g0.w) * wa[6] + bfhi(g0.w) * wa[7];
            x += bflo(g1.x) * wa[8] + bfhi(g1.x) * wa[9] + bflo(g1.y) * wa[10] + bfhi(g1.y) * wa[11] + bflo(g1.z) * wa[12] + bfhi(g1.z) * wa[13] + bflo(g1.w) * wa[14] + bfhi(g1.w) * wa[15];
            la = logsig(x) * (1.0f / 16.0f);
        }
        run += la; cum[i] = run;
    }
    tot[tg * 64 + d] = run;
    __syncthreads();
    float pre = 0.f;
#pragma unroll
    for (int g = 0; g < 8; ++g) pre += (g < tg) ? tot[g * 64 + d] : 0.f;
#pragma unroll
    for (int i = 0; i < 8; ++i) cum[i] += pre;
}

__device__ __forceinline__ void gla1_item(LAS unsigned char* lds, const Args& a, int layer, int bh, int c, int tid) {
    LAS float* tot = (LAS float*)lds;
    LAS float* Kl = tot + 512;
    LAS float* Vs = Kl + 4096;
    const bf16* P = (const bf16*)(a.ws + WS_P);
    const int b = bh >> 2, h = bh & 3, rowbase = b * LP + 64 * c - 112, tv0 = (c == 1) ? 48 : 0;
    float cum[8];
    gla_prep(tot, a, layer, h, rowbase, tv0, tid, cum);
    const int d = tid & 63, tg = tid >> 6;
    float bl = 0.f;
#pragma unroll
    for (int g = 0; g < 8; ++g) bl += tot[g * 64 + d];
#pragma unroll
    for (int i = 0; i < 8; ++i) { const int t = tg * 8 + i; float kv = 0.f;
        if (t >= tv0) kv = bf2f(P[(size_t)(rowbase + t) * PST + C_GK + h * 64 + d]) * __expf(bl - cum[i]);
        Kl[t * 64 + d] = kv; }
#pragma unroll
    for (int i = 0; i < 2; ++i) { const int q = tid + NT * i, t = q >> 4, part = q & 15;
        u32x4 vv = (u32x4){0u, 0u, 0u, 0u};
        if (t >= tv0) vv = *(const u32x4*)(P + (size_t)(rowbase + t) * PST + C_GV + h * 128 + part * 8);
        LAS float* vd = Vs + t * 128 + part * 8;
        *(LAS f32x4*)vd = (f32x4){bflo(vv.x), bfhi(vv.x), bflo(vv.y), bfhi(vv.y)}; *(LAS f32x4*)(vd + 4) = (f32x4){bflo(vv.z), bfhi(vv.z), bflo(vv.w), bfhi(vv.w)}; }
    if (tid < 64) ((float*)(a.ws + WS_DEC))[(size_t)(bh * NCH + c) * 64 + tid] = __expf(bl);
    __syncthreads();
    const int e = tid & 127, dg = tid >> 7;
    float acc[16];
#pragma unroll
    for (int i = 0; i < 16; ++i) acc[i] = 0.f;
#pragma unroll 2
    for (int t = tv0; t < 64; ++t) {
        const float v = Vs[t * 128 + e];
        const LAS f32x4* kp = (const LAS f32x4*)(Kl + t * 64 + dg * 16);
#pragma unroll
        for (int i4 = 0; i4 < 4; ++i4) { const f32x4 k4 = kp[i4]; acc[4 * i4 + 0] += k4.x * v; acc[4 * i4 + 1] += k4.y * v; acc[4 * i4 + 2] += k4.z * v; acc[4 * i4 + 3] += k4.w * v; }
    }
    float* kvl = a.out + O_YP + (size_t)(bh * NCH + c) * 8192;
#pragma unroll
    for (int i = 0; i < 16; ++i) kvl[(dg * 16 + i) * 128 + e] = acc[i];
}

__device__ __forceinline__ void gla_scan(const Args& a, int layer, int tid) {
    const float* DEC = (const float*)(a.ws + WS_DEC);
    for (int idx = blockIdx.x * NT + tid; idx < 16 * 8192; idx += gridDim.x * NT) {
        const int bh = idx >> 13, de = idx & 8191, d = de >> 7;
        float* kvl = a.out + O_YP + (size_t)bh * NCH * 8192 + de; const float* dec = DEC + (size_t)bh * NCH * 64 + d;
        float S = 0.f;
        for (int c0 = 1; c0 <= 65; c0 += 13) {
            float kv[13], dc[13];
#pragma unroll
            for (int i = 0; i < 13; ++i) { kv[i] = kvl[(size_t)(c0 + i) * 8192]; dc[i] = dec[(c0 + i) * 64]; }
#pragma unroll
            for (int i = 0; i < 13; ++i) { kvl[(size_t)(c0 + i) * 8192] = S; S = dc[i] * S + kv[i]; }
        }
        a.out[O_STP + (size_t)(layer * 16 + bh) * 8192 + de] = S;
    }
}

__device__ __forceinline__ void gla3_item(LAS unsigned char* lds, const Args& a, int layer, int bh, int c, int tid) {
    LAS float* tot = (LAS float*)lds;
    LAS float* Qe = tot + 512;
    LAS float* QeT = Qe + 4096;
    LAS float* Kd = QeT + 64 * 68;
    LAS float* AmT = Kd + 64 * 65 + 64;
    LAS float* Vs = AmT + 64 * 68;
    const bf16* P = (const bf16*)(a.ws + WS_P);
    bf16* MIXB = (bf16*)(a.ws + WS_MIXB);
    const int b = bh >> 2, h = bh & 3, rowbase = b * LP + 64 * c - 112, tv0 = (c == 1) ? 48 : 0;
    float cum[8];
    gla_prep(tot, a, layer, h, rowbase, tv0, tid, cum);
    {
        const int d = tid & 63, tg = tid >> 6;
#pragma unroll
        for (int i = 0; i < 8; ++i) { const int t = tg * 8 + i; float qv = 0.f, kv = 0.f;
            if (t >= tv0) { const bf16* pr = P + (size_t)(rowbase + t) * PST; qv = bf2f(pr[C_GQ + h * 64 + d]) * 0.125f * __expf(cum[i]); kv = bf2f(pr[C_GK + h * 64 + d]) * __expf(-cum[i]); }
            Qe[t * 64 + d] = qv; QeT[d * 68 + t] = qv; Kd[t * 65 + d] = kv; }
#pragma unroll
        for (int i = 0; i < 2; ++i) { const int q = tid + NT * i, t = q >> 4, part = q & 15;
            u32x4 vv = (u32x4){0u, 0u, 0u, 0u};
            if (t >= tv0) vv = *(const u32x4*)(P + (size_t)(rowbase + t) * PST + C_GV + h * 128 + part * 8);
            LAS float* vd = Vs + t * 128 + part * 8;
            *(LAS f32x4*)vd = (f32x4){bflo(vv.x), bfhi(vv.x), bflo(vv.y), bfhi(vv.y)}; *(LAS f32x4*)(vd + 4) = (f32x4){bflo(vv.z), bfhi(vv.z), bflo(vv.w), bfhi(vv.w)}; }
    }
    __syncthreads();
    {
        const int j = tid & 63, tg = tid >> 6;
        float acc[8];
#pragma unroll
        for (int i = 0; i < 8; ++i) acc[i] = 0.f;
#pragma unroll 1
        for (int d4 = 0; d4 < 16; ++d4) {
            const float k0 = Kd[j * 65 + 4 * d4], k1 = Kd[j * 65 + 4 * d4 + 1], k2 = Kd[j * 65 + 4 * d4 + 2], k3 = Kd[j * 65 + 4 * d4 + 3];
#pragma unroll
            for (int i = 0; i < 8; ++i) { const f32x4 q4 = *(const LAS f32x4*)(Qe + (tg * 8 + i) * 64 + 4 * d4); acc[i] += (q4.x * k0 + q4.y * k1) + (q4.z * k2 + q4.w * k3); }
        }
#pragma unroll
        for (int i = 0; i < 8; ++i) { const int t = tg * 8 + i; AmT[j * 68 + t] = (j <= t) ? acc[i] : 0.f; }
    }
    __syncthreads();
    const int e = tid & 127, tg4 = tid >> 7;
    float o[16];
#pragma unroll
    for (int i = 0; i < 16; ++i) o[i] = 0.f;
    {
        const float* S0 = a.out + O_YP + (size_t)(bh * NCH + c) * 8192 + e;
#pragma unroll 2
        for (int d = 0; d < 64; ++d) {
            const float sv = S0[d * 128];
            const LAS f32x4* qp = (const LAS f32x4*)(QeT + d * 68 + tg4 * 16);
#pragma unroll
            for (int i4 = 0; i4 < 4; ++i4) { const f32x4 q4 = qp[i4]; o[4 * i4] += q4.x * sv; o[4 * i4 + 1] += q4.y * sv; o[4 * i4 + 2] += q4.z * sv; o[4 * i4 + 3] += q4.w * sv; }
        }
        const int jend = (tg4 + 1) * 16;
#pragma unroll 2
        for (int j = 0; j < jend; ++j) {
            const float vv = Vs[j * 128 + e];
            const LAS f32x4* ap = (const LAS f32x4*)(AmT + j * 68 + tg4 * 16);
#pragma unroll
            for (int i4 = 0; i4 < 4; ++i4) { const f32x4 a4 = ap[i4]; o[4 * i4] += a4.x * vv; o[4 * i4 + 1] += a4.y * vv; o[4 * i4 + 2] += a4.z * vv; o[4 * i4 + 3] += a4.w * vv; }
        }
    }
    __syncthreads();
#pragma unroll
    for (int i = 0; i < 16; ++i) Vs[(tg4 * 16 + i) * 128 + e] = o[i];
    __syncthreads();
    {
        const int lane = tid & 63, wave = tid >> 6;
        const float g0 = a.in[10][layer * 128 + lane], g1 = a.in[10][layer * 128 + 64 + lane];
#pragma unroll
        for (int i = 0; i < 8; ++i) {
            const int t = wave * 8 + i;
            const float x0 = Vs[t * 128 + lane], x1 = Vs[t * 128 + 64 + lane];
            const float sc = rsqrtf(wave_sum(x0 * x0 + x1 * x1) * (1.0f / 128.0f) + 1e-6f);
            if (t >= tv0) {
                const size_t row = (size_t)(rowbase + t);
                const float r0 = bf2f(P[row * PST + C_GR + h * 128 + lane]), r1 = bf2f(P[row * PST + C_GR + h * 128 + 64 + lane]);
                MIXB[row * 512 + h * 128 + lane] = (bf16)f2bf(x0 * sc * g0 * r0 / (1.0f + __expf(-r0)));
                MIXB[row * 512 + h * 128 + 64 + lane] = (bf16)f2bf(x1 * sc * g1 * r1 / (1.0f + __expf(-r1)));
            }
        }
    }
}

__device__ __forceinline__ void sgla_item(LAS unsigned char* lds, const Args& a, int layer, int s, int h, int tid) {
    LAS float* la = (LAS float*)lds;
    LAS float* kq = la + 64;
    LAS float* vv = kq + 128;
    LAS float* red = vv + 128;
    LAS float* ov = red + 512;
    const bf16* P = (const bf16*)(a.ws + WS_P);
    bf16* MIXB = (bf16*)(a.ws + WS_MIXB);
    const size_t row = (size_t)(MP + s);
    const bf16* pr = P + row * PST;
    if (tid < 64) {
        const int d = tid; float x = a.in[8][layer * 256 + h * 64 + d];
#pragma unroll
        for (int r = 0; r < 16; ++r) x += bf2f(pr[C_GLR + r]) * a.in[7][(size_t)(layer * 16 + r) * 256 + h * 64 + d];
        la[d] = __expf(logsig(x) * (1.0f / 16.0f));
        kq[d] = bf2f(pr[C_GK + h * 64 + d]); kq[64 + d] = bf2f(pr[C_GQ + h * 64 + d]) * 0.125f;
    } else if (tid < 192) vv[tid - 64] = bf2f(pr[C_GV + h * 128 + (tid - 64)]);
    __syncthreads();
    const int e = tid & 127, dg = tid >> 7;
    const float* S0 = a.in[4] + ((size_t)(layer * NS + s) * 4 + h) * 8192;
    float* S1 = a.out + O_STS + ((size_t)(layer * NS + s) * 4 + h) * 8192;
    const float ve = vv[e]; float po = 0.f;
#pragma unroll
    for (int i = 0; i < 16; ++i) { const int d = dg * 16 + i; const float s1 = la[d] * S0[d * 128 + e] + kq[d] * ve; S1[d * 128 + e] = s1; po += kq[64 + d] * s1; }
    red[dg * 128 + e] = po;
    __syncthreads();
    if (tid < 128) ov[tid] = (red[tid] + red[128 + tid]) + (red[256 + tid] + red[384 + tid]);
    __syncthreads();
    if (tid < 64) {
        const float x0 = ov[tid], x1 = ov[64 + tid];
        const float sc = rsqrtf(wave_sum(x0 * x0 + x1 * x1) * (1.0f / 128.0f) + 1e-6f);
        const float g0 = a.in[10][layer * 128 + tid], g1 = a.in[10][layer * 128 + 64 + tid];
        const float r0 = bf2f(pr[C_GR + h * 128 + tid]), r1 = bf2f(pr[C_GR + h * 128 + 64 + tid]);
        MIXB[row * 512 + h * 128 + tid] = (bf16)f2bf(x0 * sc * g0 * r0 / (1.0f + __expf(-r0)));
        MIXB[row * 512 + h * 128 + 64 + tid] = (bf16)f2bf(x1 * sc * g1 * r1 / (1.0f + __expf(-r1)));
    }
}

__device__ __forceinline__ int next_item(unsigned* ctr, LAS int* slot, int tid) {
    __syncthreads();
    if (tid == 0) *slot = (int)__hip_atomic_fetch_add(ctr, 1u, __ATOMIC_RELAXED, __HIP_MEMORY_SCOPE_AGENT);
    __syncthreads();
    return *slot;
}

#ifndef MK_MASK
#define MK_MASK 0xffff
#endif
#define ON(x) (((MK_MASK) >> (x)) & 1)
constexpr int PH_PER_LAYER = 10, N_PHASES = 1 + NL * PH_PER_LAYER;
constexpr int N_ATT = NB * 33 * 8, N_G = 16 * 65, N_SA = NS, N_SG = NS * 4;

__global__ void __launch_bounds__(NT) mk_fwd(Args a_) {
    extern __shared__ __attribute__((aligned(16))) unsigned char lds_raw[];
    LAS unsigned char* lds = (LAS unsigned char*)lds_raw;
    LAS int* slot = (LAS int*)(lds + LDS_BYTES - 64);
    cg::grid_group grid = cg::this_grid();
    const int G = gridDim.x;
    for (int ph = a_.ph_lo; ph < a_.ph_hi; ++ph) {
        int tid = threadIdx.x; asm volatile("" : "+v"(tid));
        int cu = blockIdx.x; asm volatile("" : "+s"(cu));
        Args a = a_;
        asm volatile("" : "+s"(a.ws)); asm volatile("" : "+s"(a.out));
        unsigned* ctl = (unsigned*)(a.ws + WS_CTL);
        bf16* P = (bf16*)(a.ws + WS_P); float* X = (float*)(a.ws + WS_X); bf16* ACT = (bf16*)(a.ws + WS_ACT);
        bf16* MIXA = (bf16*)(a.ws + WS_MIXA); bf16* MIXB = (bf16*)(a.ws + WS_MIXB);
        if (ph == 0) { if (ON(0)) p0_prologue(a, lds, tid); }
        else {
            const int l = (ph - 1) / PH_PER_LAYER, k = (ph - 1) % PH_PER_LAYER;
            const bf16* wt = (const bf16*)(a.ws + WS_WT) + (size_t)l * WT_LAYER;
            if (k == 0) { if (ON(1)) {
                pg8::Gemm g{ACT, wt + WT_IN, MPAD, NINP, 1024}; pg8::StaticOrder S; S.init(MPAD, NINP, G, cu);
                pg8::EpiInProj E{P, (const float*)(a.ws + WS_ROPE), a.out, l};
                pg8::gemm_phase<pg8::EpiInProj, pg8::StaticOrder, true, true>(lds, g, S, E); }
            } else if (k == 1) {
                unsigned* ctr = ctl + (l * 2 + 0) * 64;
                for (;;) {
                    int it = next_item(ctr, slot, tid);
                    if (it >= N_ATT + N_G + N_SA + N_SG) break;
                    if (it < N_ATT) { if (ON(2)) { const int h = it & 7, bn = it >> 3, b = bn / 33, n = 32 - (bn % 33); attn_item(lds, P, MIXA, a.in[9][l * 8 + h], b, n, h, tid); } continue; } it -= N_ATT;
                    if (it < N_G) { const int bh = it & 15, c = 1 + (it >> 4); if (ON(3)) gla1_item(lds, a, l, bh, c, tid); continue; } it -= N_G;
                    if (it < N_SA) { if (ON(4)) sattn_item(lds, a, l, it, tid); continue; } it -= N_SA;
                    if (ON(5)) sgla_item(lds, a, l, it >> 2, it & 3, tid);
                }
            } else if (k == 2) {
                if (ON(6)) gla_scan(a, l, tid);
            } else if (k == 3) {
                unsigned* ctr = ctl + (l * 2 + 1) * 64;
                for (;;) {
                    const int it = next_item(ctr, slot, tid);
                    if (it >= N_G) break;
                    if (ON(7)) gla3_item(lds, a, l, it & 15, 1 + (it >> 4), tid);
                }
            } else if (k == 4) {
                if (ON(8)) { pg8::Gemm g{MIXA, wt + WT_A, MPAD, 1024, 512}; pg8::StaticOrder S; S.init(MPAD, 1024, G, cu); pg8::EpiProjA E{P};
                  pg8::gemm_phase<pg8::EpiProjA, pg8::StaticOrder, true, true>(lds, g, S, E); }
                __syncthreads();
                if (ON(8)) { pg8::Gemm g{MIXB, wt + WT_B, MPAD, 1024, 512}; pg8::StaticOrder S; S.init(MPAD, 1024, G, cu); pg8::EpiProjB E{P, ACT};
                  pg8::gemm_phase<pg8::EpiProjB, pg8::StaticOrder, true, true>(lds, g, S, E); }
            } else if (k == 5) {
                if (ON(9)) { pg8::Gemm g{ACT, wt + WT_OUT, MPAD, 1024, 1024}; pg8::StaticOrder S; S.init(MPAD, 1024, G, cu); pg8::EpiResid E{X};
                pg8::gemm_phase<pg8::EpiResid, pg8::StaticOrder, true, true>(lds, g, S, E); }
            } else if (k == 6) {
                if (ON(10)) ln_phase(a, a.in[14] + l * D, a.in[15] + l * D, false, tid);
            } else if (k == 7) {
                if (ON(11)) { pg8::Gemm g{ACT, wt + WT_UP, MPAD, FF, 1024}; pg8::StaticOrder S; S.init(MPAD, FF, G, cu); pg8::EpiUp E{P};
                pg8::gemm_phase<pg8::EpiUp, pg8::StaticOrder, true, true>(lds, g, S, E); }
            } else if (k == 8) {
                if (ON(12)) { pg8::Gemm g{P, wt + WT_DOWN, MPAD, 1024, FF}; pg8::StaticOrder S; S.init(MPAD, 1024, G, cu); pg8::EpiResid E{X};
                pg8::gemm_phase<pg8::EpiResid, pg8::StaticOrder, true, true>(lds, g, S, E); }
            } else {
                if (ON(10)) ln_phase(a, a.in[18] + l * D, a.in[19] + l * D, l == NL - 1, tid);
            }
        }
        if (ph + 1 < a_.ph_hi) grid.sync();
    }
}
}

extern "C" void kernel_launch(void* const* d_in, const int* in_sizes, int n_in, void* d_out, int out_size, void* d_ws, size_t ws_size, hipStream_t stream) {
    using namespace mk;
    static int grid = 0;
    if (grid == 0) {
        if (n_in != 20 || (size_t)out_size != O_END || ws_size < WS_END) { fprintf(stderr, "kernel_launch: unexpected sizes n_in %d out %d ws %zu\n", n_in, out_size, ws_size); grid = -1; return; }
        int dev = 0, cus = 0, per_cu = 0;
        hipGetDevice(&dev); hipDeviceGetAttribute(&cus, hipDeviceAttributeMultiprocessorCount, dev);
        if (hipFuncSetAttribute((const void*)mk_fwd, hipFuncAttributeMaxDynamicSharedMemorySize, LDS_BYTES) != hipSuccess) { fprintf(stderr, "kernel_launch: hipFuncSetAttribute failed\n"); grid = -1; return; }
        if (hipOccupancyMaxActiveBlocksPerMultiprocessor(&per_cu, (const void*)mk_fwd, NT, LDS_BYTES) != hipSuccess || per_cu < 1) { fprintf(stderr, "kernel_launch: occupancy query failed (%d)\n", per_cu); grid = -1; return; }
        grid = cus;
        fprintf(stderr, "kernel_launch: cus %d per_cu %d grid %d\n", cus, per_cu, grid);
    }
    if (grid < 0) return;
    hipMemsetAsync((char*)d_ws + WS_CTL, 0, CTL_BYTES, stream);
    Args a{};
    for (int i = 0; i < 20; ++i) a.in[i] = (const float*)d_in[i];
    a.out = (float*)d_out; a.ws = (unsigned char*)d_ws;
#if MK_SINGLE
    a.ph_lo = 0; a.ph_hi = N_PHASES;
    { void* args[] = {&a}; hipError_t e = hipLaunchCooperativeKernel((const void*)mk_fwd, dim3(grid), dim3(NT), args, LDS_BYTES, stream);
      if (e != hipSuccess) fprintf(stderr, "cooperative launch failed: %s\n", hipGetErrorString(e)); }
#else
    for (int ph = 0; ph < N_PHASES; ++ph) {
        a.ph_lo = ph; a.ph_hi = ph + 1;
        void* args[] = {&a}; hipError_t e = hipLaunchCooperativeKernel((const void*)mk_fwd, dim3(grid), dim3(NT), args, LDS_BYTES, stream);
        if (e != hipSuccess) { fprintf(stderr, "cooperative launch failed: %s\n", hipGetErrorString(e)); break; }
    }
#endif
}
```

```cpp
#include <hip/hip_runtime.h>
#include <hip/hip_cooperative_groups.h>
#include <cstdio>
#include <cstdint>
namespace cg = cooperative_groups;

#ifndef MK_SINGLE
#define MK_SINGLE 1
#endif

namespace mk {
constexpr int NL = 4;
constexpr int D = 1024, NB = 4, LP = 4112, MP = NB * LP, NS = 128, MREAL = MP + NS, MPAD = 16640;
constexpr int NIN = 4368, NINP = 4608, FF = 4096, PST = 4368;
constexpr int C_Q = 0, C_K = 512, C_V = 640, C_GQ = 768, C_GK = 1024, C_GV = 1280, C_GR = 1792, C_GA = 2304, C_GB = 3328, C_GLR = 4352;
constexpr int NCH = 66;
constexpr float ALPHA = 1.6817928305074290f;
constexpr size_t O_YP = 0, O_YS = 16777216, O_KWP = O_YS + 131072, O_VWP = O_KWP + 262144, O_STP = O_VWP + 262144,
                 O_KWS = O_STP + 524288, O_VWS = O_KWS + 8388608, O_STS = O_VWS + 8388608, O_END = O_STS + 16777216;
constexpr size_t MiB = 1u << 20;
constexpr size_t WS_CTL = 0, CTL_BYTES = 65536, WS_ROPE = 65536, WS_CNT = 512 * 1024  , WS_DEC = 1 * MiB, WS_WT = 2 * MiB;
constexpr size_t WT_IN = 0, WT_A = (size_t)NINP * 1024, WT_B = WT_A + 1024 * 512, WT_OUT = WT_B + 1024 * 512, WT_UP = WT_OUT + 1024 * 1024,
                 WT_DOWN = WT_UP + (size_t)4096 * 1024, WT_LAYER = WT_DOWN + (size_t)4096 * 1024;
constexpr size_t WS_P = 124 * MiB, WS_X = 263 * MiB, WS_ACT = 329 * MiB, WS_MIXA = 362 * MiB, WS_MIXB = 379 * MiB, WS_PART = 396 * MiB, WS_END = 412 * MiB;
static_assert(WS_WT + WT_LAYER * 2 * NL <= WS_P, "wt");
static_assert(WS_P + (size_t)MPAD * PST * 2 <= WS_X && WS_X + (size_t)MPAD * D * 4 <= WS_ACT && WS_ACT + (size_t)MPAD * D * 2 <= WS_MIXA &&
              WS_MIXA + (size_t)MPAD * 512 * 2 <= WS_MIXB && WS_MIXB + (size_t)MPAD * 512 * 2 <= WS_PART && WS_PART + (size_t)16 * 256 * 1024 * 4 <= WS_END, "ws map");
static_assert((size_t)MPAD * FF * 2 <= (size_t)MPAD * PST * 2, "H overlays P");
constexpr int LDS_BYTES = 147456;
}
namespace pg8 {
#define PG8_LAS __attribute__((address_space(3)))
typedef unsigned short bf16_t;
typedef short bf16x8 __attribute__((ext_vector_type(8)));
typedef float f32x4 __attribute__((ext_vector_type(4)));
typedef unsigned u32x4 __attribute__((ext_vector_type(4)));
constexpr int BM = 256, BK = 64, HALF = 128, HTB = HALF * BK * 2  , STAGE_BYTES = 8 * HTB, NXCD = 8, WGM = 8;

__host__ __device__ __forceinline__ int lds_byte(int r, int c) { const int st = (r >> 4) * 2 + (c >> 5), rr = r & 15, cc = c & 31, ob = rr * 64 + cc * 2; return st * 1024 + (ob ^ (((ob >> 9) & 1) << 5)); }
__host__ __device__ __forceinline__ void stage_rc(int b, int& R, int& C) { const int st = b / 1024, sb = b % 1024, swz = sb ^ (((sb >> 9) & 1) << 5); R = (st >> 1) * 16 + swz / 64; C = (st & 1) * 32 + (swz % 64) / 2; }
__host__ __device__ __forceinline__ int perm32(int rho) { const int n = rho >> 4, i = rho & 15; return 8 * (i >> 2) + 4 * n + (i & 3); }

struct Unit { int pm, pn, k0, nt; };
struct Gemm { const bf16_t* A; const bf16_t* Bt; int M, N, K; };

struct StaticOrder {
    int nM, nN, nwg, G, c;
    __host__ __device__ void init(int M, int N, int G_, int c_) { nM = M / BM; nN = N / BM; nwg = nM * nN; G = G_; c = c_; }
    __host__ __device__ bool next(int i, Unit& u) const {
        const long L = (long)i * G + c; if (L >= nwg) return false;
        int wgid = (int)L; { const int q = nwg / NXCD, r = nwg % NXCD, xcd = wgid % NXCD, off = wgid / NXCD; wgid = (xcd < r ? xcd * (q + 1) : r * (q + 1) + (xcd - r) * q) + off; }
        const int nig = WGM * nN, gid = wgid / nig, fm = gid * WGM, gsz = (nM - fm) < WGM ? (nM - fm) : WGM;
        u.pm = fm + ((wgid % nig) % gsz); u.pn = (wgid % nig) / gsz; u.k0 = 0; u.nt = 0; return true;
    }
    __device__ __forceinline__ void a_ready(const Unit&) const {}
    __device__ __forceinline__ void done(const Unit&) const {}
};

struct TailOrder {
    StaticOrder so; int G, c, S, ksz;
    __host__ __device__ void init(int K, int S_, int G_, int c_) { so.init(64 * BM, 1024, G_, c_); G = G_; c = c_; S = S_; ksz = K / S_; }
    __host__ __device__ bool next(int i, Unit& u) const {
        const int nm = (c < so.nwg) ? (so.nwg - 1 - c) / G + 1 : 0;
        if (i < nm) return so.next(i, u);
        if (i > nm || nm != 1) return false;
        Unit um; so.next(0, um); if (um.pm >= S) return false;
        u.pm = 64; u.pn = um.pn; u.k0 = um.pm * ksz; u.nt = ksz / BK; return true;
    }
    __device__ __forceinline__ void a_ready(const Unit&) const {}
    __device__ __forceinline__ void done(const Unit&) const {}
};
__device__ __forceinline__ unsigned cvt_pk_bf16(float lo, float hi) { unsigned r; asm volatile("v_cvt_pk_bf16_f32 %0, %1, %2" : "=v"(r) : "v"(lo), "v"(hi)); return r; }
__device__ __forceinline__ float bflo(unsigned w) { return __uint_as_float(w << 16); }
__device__ __forceinline__ float bfhi(unsigned w) { return __uint_as_float(w & 0xffff0000u); }
__device__ __forceinline__ float sigm(float x) { return 1.0f / (1.0f + __expf(-x)); }
__device__ __forceinline__ u32x4 pack8(const f32x4& v0, const f32x4& v1) { u32x4 w; w.x = cvt_pk_bf16(v0[0], v0[1]); w.y = cvt_pk_bf16(v0[2], v0[3]); w.z = cvt_pk_bf16(v1[0], v1[1]); w.w = cvt_pk_bf16(v1[2], v1[3]); return w; }

struct EpiInProj {
    static constexpr bool PERM = true, AFTER_DRAIN = false; static constexpr int MID_T = 0;
    bf16_t* P; const float* rope; float* out; int layer;
    __device__ __forceinline__ void operator()(const f32x4 (&acc)[2][2][4][2], const Unit& u, int wr, int wc, int fr, int fq) const {
        using namespace mk;
#pragma unroll
        for (int ai = 0; ai < 2; ++ai)
#pragma unroll
            for (int m = 0; m < 4; ++m) {
                const int row = u.pm * BM + ai * HALF + wr * 64 + m * 16 + fr;
                const bool samp = row >= MP;
                int b = 0, p = 0, pi = LP;
                if (!samp) { b = row / LP; p = row - b * LP; pi = p; }
#pragma unroll
                for (int bj = 0; bj < 2; ++bj) {
                    const int ct = u.pn * BM + bj * HALF + wc * 32;
                    const int c0 = ct + 8 * fq;
                    f32x4 v0 = acc[ai][bj][m][0], v1 = acc[ai][bj][m][1];
                    if (ct < C_V && (wc & 1) == 0) {
                        f32x4 p0, p1;
#pragma unroll
                        for (int j = 0; j < 4; ++j) { p0[j] = __shfl_xor(v0[j], 16); p1[j] = __shfl_xor(v1[j], 16); }
                        if (fq < 2) {
                            const f32x4* T = (const f32x4*)(rope + (size_t)pi * 16);
                            const f32x4 c0v = T[0], c1v = T[1], s0v = T[2], s1v = T[3];
                            if (fq == 0) { v0 = v0 * c0v - p0 * s0v; v1 = v1 * c1v - p1 * s1v; }
                            else         { v0 = v0 * c0v + p0 * s0v; v1 = v1 * c1v + p1 * s1v; }
                        }
                    }
                    if (u.pn == 2) {
                        const int cc = c0 - C_K;
                        float* dst = nullptr;
                        if (samp) { if (row < MREAL) dst = out + (cc < 128 ? O_KWS : O_VWS) + ((size_t)(layer * NS + (row - MP)) * 128 + 127) * 128 + (cc & 127); }
                        else if (p >= LP - 128) dst = out + (cc < 128 ? O_KWP : O_VWP) + ((size_t)(layer * NB + b) * 128 + (p - (LP - 128))) * 128 + (cc & 127);
                        if (dst) { *(f32x4*)dst = v0; *(f32x4*)(dst + 4) = v1; }
                    }
                    if (c0 < NIN) *(u32x4*)(P + (size_t)row * PST + c0) = pack8(v0, v1);
                }
            }
    }
};
struct EpiProj {
    static constexpr bool PERM = true, AFTER_DRAIN = false; static constexpr int MID_T = 8;
    bf16_t* P; bf16_t* O; float* PART;
    __device__ __forceinline__ void mid(f32x4 (&acc)[2][2][4][2], const Unit& u, int wr, int wc, int fr, int fq) const {
        using namespace mk;
        int row0 = u.pm * BM + wr * 64 + fr, col0 = u.pn * BM + wc * 32 + 8 * fq;
        asm volatile("" : "+v"(row0), "+v"(col0));
#pragma unroll
        for (int ai = 0; ai < 2; ++ai)
#pragma unroll
            for (int m = 0; m < 4; ++m) {
                if ((m & 1) == 0) asm volatile("" ::: "memory");
                const int row = row0 + ai * HALF + m * 16;
                const bf16_t* prow = P + (size_t)row * PST;
#pragma unroll
                for (int bj = 0; bj < 2; ++bj) {
                    const int c0 = col0 + bj * HALF;
                    const u32x4 ga = *(const u32x4*)(prow + C_GA + c0), gb = *(const u32x4*)(prow + C_GB + c0);
                    const unsigned gaw[4] = {ga.x, ga.y, ga.z, ga.w}, gbw[4] = {gb.x, gb.y, gb.z, gb.w};
#pragma unroll
                    for (int q = 0; q < 4; ++q) {
                        const float r0 = (1.0f + __expf(-bflo(gbw[q]))) / (1.0f + __expf(-bflo(gaw[q]))), r1 = (1.0f + __expf(-bfhi(gbw[q]))) / (1.0f + __expf(-bfhi(gaw[q])));
                        acc[ai][bj][m][q >> 1][(q & 1) * 2] *= r0; acc[ai][bj][m][q >> 1][(q & 1) * 2 + 1] *= r1;
                    }
                }
            }
    }
    __device__ __forceinline__ void operator()(const f32x4 (&acc)[2][2][4][2], const Unit& u, int wr, int wc, int fr, int fq) const {
        using namespace mk;
        const bool tail = (u.pm == 64); const int gcol = (tail && u.k0 < 512) ? C_GA : C_GB;
#pragma unroll
        for (int ai = 0; ai < 2; ++ai)
#pragma unroll
            for (int m = 0; m < 4; ++m) {
                const int row = u.pm * BM + ai * HALF + wr * 64 + m * 16 + fr;
                const bf16_t* prow = P + (size_t)row * PST;
#pragma unroll
                for (int bj = 0; bj < 2; ++bj) {
                    const int c0 = u.pn * BM + bj * HALF + wc * 32 + 8 * fq;
                    const u32x4 g = *(const u32x4*)(prow + gcol + c0);
                    f32x4 v0 = acc[ai][bj][m][0], v1 = acc[ai][bj][m][1];
                    v0[0] *= sigm(bflo(g.x)); v0[1] *= sigm(bfhi(g.x)); v0[2] *= sigm(bflo(g.y)); v0[3] *= sigm(bfhi(g.y));
                    v1[0] *= sigm(bflo(g.z)); v1[1] *= sigm(bfhi(g.z)); v1[2] *= sigm(bflo(g.w)); v1[3] *= sigm(bfhi(g.w));
                    if (tail) { float* pp = PART + ((size_t)(u.k0 >> 8) * 256 + (row - 64 * BM)) * D + c0; *(f32x4*)pp = v0; *(f32x4*)(pp + 4) = v1; }
                    else *(u32x4*)(O + (size_t)row * D + c0) = pack8(v0, v1);
                }
            }
    }
};
struct EpiResid {
    static constexpr bool PERM = true, AFTER_DRAIN = false; static constexpr int MID_T = 0;
    float* X; float* PART; int ksz;
    __device__ __forceinline__ void operator()(const f32x4 (&acc)[2][2][4][2], const Unit& u, int wr, int wc, int fr, int fq) const {
        using namespace mk;
#pragma unroll
        for (int ai = 0; ai < 2; ++ai)
#pragma unroll
            for (int m = 0; m < 4; ++m) {
                const int row = u.pm * BM + ai * HALF + wr * 64 + m * 16 + fr;
#pragma unroll
                for (int bj = 0; bj < 2; ++bj) {
                    const int c0 = u.pn * BM + bj * HALF + wc * 32 + 8 * fq;
                    float* x = X + (size_t)row * D + c0;
                    const f32x4 a0 = acc[ai][bj][m][0], a1 = acc[ai][bj][m][1];
                    if (u.pm == 64) {
                        float* pp = PART + ((size_t)(u.k0 / ksz) * 256 + (row - 64 * BM)) * D + c0;
                        *(f32x4*)pp = a0; *(f32x4*)(pp + 4) = a1;
                    } else {
                        const f32x4 x0 = *(const f32x4*)x, x1 = *(const f32x4*)(x + 4);
                        *(f32x4*)x = x0 + a0; *(f32x4*)(x + 4) = x1 + a1;
                    }
                }
            }
    }
};
struct EpiUp {
    static constexpr bool PERM = true, AFTER_DRAIN = false; static constexpr int MID_T = 0;
    bf16_t* H;
    __device__ __forceinline__ void operator()(const f32x4 (&acc)[2][2][4][2], const Unit& u, int wr, int wc, int fr, int fq) const {
        using namespace mk;
#pragma unroll
        for (int ai = 0; ai < 2; ++ai)
#pragma unroll
            for (int m = 0; m < 4; ++m) {
                const int row = u.pm * BM + ai * HALF + wr * 64 + m * 16 + fr;
#pragma unroll
                for (int bj = 0; bj < 2; ++bj) {
                    const int c0 = u.pn * BM + bj * HALF + wc * 32 + 8 * fq;
                    f32x4 v0 = acc[ai][bj][m][0], v1 = acc[ai][bj][m][1];
#pragma unroll
                    for (int j = 0; j < 4; ++j) { const float a = fmaxf(v0[j], 0.f), b = fmaxf(v1[j], 0.f); v0[j] = a * a; v1[j] = b * b; }
                    *(u32x4*)(H + (size_t)row * FF + c0) = pack8(v0, v1);
                }
            }
    }
};
template <class Epi, class Sched, bool ALIGN_EPI = false, bool SP2 = false>
__device__ __forceinline__ void gemm_phase(PG8_LAS unsigned char* lds, const Gemm g, const Sched& S, const Epi& E) {
    int tid_ = threadIdx.x; asm volatile("" : "+v"(tid_));
    const int tid = tid_, wid = __builtin_amdgcn_readfirstlane(tid >> 6), lane = tid & 63, wr = wid >> 2, wc = wid & 3, fr = lane & 15, fq = lane >> 4;
    const int K = g.K; int nt = K / BK;
    unsigned voffA[2], voffB[2];
#pragma unroll
    for (int i = 0; i < 2; ++i) { int R, C; stage_rc(tid * 16 + i * 8192, R, C); const int Rb = Epi::PERM ? ((R & ~31) + perm32(R & 31)) : R;
        voffA[i] = (unsigned)(R * K + C) * 2u; voffB[i] = (unsigned)(Rb * K + C) * 2u; }
    const size_t kstep = (size_t)(BK * 2);
    const size_t hstep = (size_t)HALF * K * 2;
    const size_t tstep = 2 * hstep;
    const unsigned ldsw = (unsigned)wid * 1024u;
    const int aoff = lds_byte(wr * 64 + fr, fq * 8), boff = lds_byte(wc * 32 + fr, fq * 8);
#define PG8_SA(b, h) (((b) * 2 + (h)) * HTB)
#define PG8_SB(b, h) ((4 + (b) * 2 + (h)) * HTB)
#define PG8_STAGE(bufoff, gbase, voff) do { _Pragma("unroll") for (int _i = 0; _i < 2; ++_i) \
        __builtin_amdgcn_global_load_lds((const unsigned*)((const char*)(gbase) + (voff)[_i]), (PG8_LAS unsigned*)(lds + (bufoff) + ldsw + _i * 8192), 16, 0, 0); } while (0)
#define PG8_LDA(dst, b, h) do { _Pragma("unroll") for (int m = 0; m < 4; ++m) _Pragma("unroll") for (int k = 0; k < 2; ++k) dst[m][k] = *(const PG8_LAS bf16x8*)(lds + PG8_SA(b, h) + aoff + m * 2048 + k * 1024); } while (0)
#define PG8_LDB(dst, b, h) do { _Pragma("unroll") for (int n = 0; n < 2; ++n) _Pragma("unroll") for (int k = 0; k < 2; ++k) dst[n][k] = *(const PG8_LAS bf16x8*)(lds + PG8_SB(b, h) + boff + n * 2048 + k * 1024); } while (0)
#define PG8_MMA(ai, bj, At, Bt) do { __builtin_amdgcn_s_setprio(1); _Pragma("unroll") for (int m = 0; m < 4; ++m) _Pragma("unroll") for (int n = 0; n < 2; ++n) _Pragma("unroll") for (int k = 0; k < 2; ++k) \
        acc[ai][bj][m][n] = __builtin_amdgcn_mfma_f32_16x16x32_bf16(Bt[n][k], At[m][k], acc[ai][bj][m][n], 0, 0, 0); __builtin_amdgcn_s_setprio(0); } while (0)
#define PG8_WAIT_V(n) asm volatile("s_waitcnt vmcnt(" #n ")" ::: "memory")
#define PG8_WAIT_L(n) asm volatile("s_waitcnt lgkmcnt(" #n ")" ::: "memory")
#define PG8_BAR __builtin_amdgcn_s_barrier()
#define PG8_SCHED __builtin_amdgcn_sched_barrier(0)
    Unit cur, nxt; int ui = 0;
    if (!S.next(0, cur)) return;
    f32x4 acc[2][2][4][2];
#pragma unroll
    for (int a = 0; a < 2; ++a)
#pragma unroll
        for (int b = 0; b < 2; ++b)
#pragma unroll
            for (int m = 0; m < 4; ++m)
#pragma unroll
                for (int n = 0; n < 2; ++n) acc[a][b][m][n] = (f32x4){0.f, 0.f, 0.f, 0.f};
    bf16x8 At[4][2], B0[2][2], B1[2][2];
    const char* cA = (const char*)g.A + (size_t)cur.pm * tstep + (size_t)cur.k0 * 2; const char* cB = (const char*)g.Bt + (size_t)cur.pn * tstep + (size_t)cur.k0 * 2;
    if (cur.nt) nt = cur.nt;
    S.a_ready(cur);
    if constexpr (SP2) {
        PG8_STAGE(PG8_SB(0, 0), cB, voffB); PG8_STAGE(PG8_SB(0, 1), cB + hstep, voffB); PG8_STAGE(PG8_SA(0, 0), cA, voffA); PG8_STAGE(PG8_SA(0, 1), cA + hstep, voffA);
        if (wr == 1) PG8_BAR;
        PG8_WAIT_V(2); PG8_BAR;
        PG8_STAGE(PG8_SB(1, 0), cB + kstep, voffB); PG8_STAGE(PG8_SA(1, 0), cA + kstep, voffA); PG8_STAGE(PG8_SB(1, 1), cB + hstep + kstep, voffB);
        PG8_WAIT_V(6); PG8_BAR;
    } else {
        PG8_STAGE(PG8_SB(0, 0), cB, voffB); PG8_STAGE(PG8_SA(0, 0), cA, voffA); PG8_STAGE(PG8_SB(0, 1), cB + hstep, voffB); PG8_STAGE(PG8_SA(0, 1), cA + hstep, voffA);
        if (wr == 1) PG8_BAR;
        PG8_WAIT_V(4); PG8_BAR;
        PG8_STAGE(PG8_SB(1, 0), cB + kstep, voffB); PG8_STAGE(PG8_SA(1, 0), cA + kstep, voffA); PG8_STAGE(PG8_SB(1, 1), cB + hstep + kstep, voffB);
        PG8_WAIT_V(6); PG8_BAR;
    }
    for (;;) {
        const bool has_next = S.next(ui + 1, nxt);
        const char* nA = has_next ? (const char*)g.A + (size_t)nxt.pm * tstep + (size_t)nxt.k0 * 2 : cA; const char* nB = has_next ? (const char*)g.Bt + (size_t)nxt.pn * tstep + (size_t)nxt.k0 * 2 : cB;
        for (int t = 0; t < nt; t += 2) {
            if constexpr (Epi::MID_T > 0) { if (t == Epi::MID_T && nt > Epi::MID_T) E.mid(acc, cur, wr, wc, fr, fq); }
            const bool last = (t == nt - 2);
            const char* a1 = cA + (size_t)(t + 1) * kstep;
            const char* a2 = last ? nA : cA + (size_t)(t + 2) * kstep; const char* b2 = last ? nB : cB + (size_t)(t + 2) * kstep;
            const char* a3 = a2 + kstep; const char* b3 = b2 + kstep;
            if (last && has_next) S.a_ready(nxt);
            if constexpr (SP2) {
            PG8_LDB(B0, 0, 0); PG8_LDB(B1, 0, 1); PG8_SCHED; PG8_LDA(At, 0, 0); PG8_STAGE(PG8_SA(1, 1), a1 + hstep, voffA);
            PG8_WAIT_V(8); PG8_WAIT_L(0); PG8_BAR; PG8_MMA(0, 0, At, B0); PG8_MMA(0, 1, At, B1); PG8_BAR; PG8_SCHED;
            PG8_LDA(At, 0, 1); PG8_STAGE(PG8_SB(0, 0), b2, voffB); PG8_STAGE(PG8_SB(0, 1), b2 + hstep, voffB); PG8_STAGE(PG8_SA(0, 0), a2, voffA);
            PG8_WAIT_V(8); PG8_WAIT_L(0); PG8_BAR; PG8_MMA(1, 0, At, B0); PG8_MMA(1, 1, At, B1); PG8_BAR; PG8_SCHED;
            PG8_LDB(B0, 1, 0); PG8_LDB(B1, 1, 1); PG8_SCHED; PG8_LDA(At, 1, 0); PG8_STAGE(PG8_SA(0, 1), a2 + hstep, voffA);
            PG8_WAIT_V(8); PG8_WAIT_L(0); PG8_BAR; PG8_MMA(0, 0, At, B0); PG8_MMA(0, 1, At, B1); PG8_BAR; PG8_SCHED;
            PG8_LDA(At, 1, 1); PG8_STAGE(PG8_SB(1, 0), b3, voffB); PG8_STAGE(PG8_SB(1, 1), b3 + hstep, voffB); PG8_STAGE(PG8_SA(1, 0), a3, voffA);
            PG8_WAIT_V(8); PG8_WAIT_L(0); PG8_BAR; PG8_MMA(1, 0, At, B0); PG8_MMA(1, 1, At, B1); PG8_BAR; PG8_SCHED;
            } else {
            PG8_LDB(B0, 0, 0); PG8_SCHED; PG8_LDA(At, 0, 0); PG8_STAGE(PG8_SA(1, 1), a1 + hstep, voffA);
            PG8_WAIT_L(8); PG8_BAR; PG8_WAIT_L(0); PG8_MMA(0, 0, At, B0); PG8_BAR; PG8_SCHED;
            PG8_LDB(B1, 0, 1); PG8_STAGE(PG8_SB(0, 0), b2, voffB);
            PG8_BAR; PG8_WAIT_L(0); PG8_MMA(0, 1, At, B1); PG8_BAR;
            PG8_LDA(At, 0, 1); PG8_STAGE(PG8_SA(0, 0), a2, voffA);
            PG8_BAR; PG8_WAIT_L(0); PG8_MMA(1, 0, At, B0); PG8_BAR; PG8_SCHED;
            PG8_STAGE(PG8_SB(0, 1), b2 + hstep, voffB);
            PG8_WAIT_V(6); PG8_BAR; PG8_MMA(1, 1, At, B1); PG8_BAR;
            PG8_LDB(B0, 1, 0); PG8_SCHED; PG8_LDA(At, 1, 0); PG8_STAGE(PG8_SA(0, 1), a2 + hstep, voffA);
            PG8_WAIT_L(8); PG8_BAR; PG8_WAIT_L(0); PG8_MMA(0, 0, At, B0); PG8_BAR; PG8_SCHED;
            PG8_LDB(B1, 1, 1); PG8_STAGE(PG8_SB(1, 0), b3, voffB);
            PG8_BAR; PG8_WAIT_L(0); PG8_MMA(0, 1, At, B1); PG8_BAR;
            PG8_LDA(At, 1, 1); PG8_STAGE(PG8_SA(1, 0), a3, voffA);
            PG8_BAR; PG8_WAIT_L(0); PG8_MMA(1, 0, At, B0); PG8_BAR; PG8_SCHED;
            PG8_STAGE(PG8_SB(1, 1), b3 + hstep, voffB);
            PG8_WAIT_V(6); PG8_BAR; PG8_MMA(1, 1, At, B1); PG8_BAR;
            }
        }
        if constexpr (ALIGN_EPI) { if (wr == 0) PG8_BAR; }
        if constexpr (!Epi::AFTER_DRAIN) { E(acc, cur, wr, wc, fr, fq); S.done(cur); }
        if (!has_next) break;
#pragma unroll
        for (int a = 0; a < 2; ++a)
#pragma unroll
            for (int b = 0; b < 2; ++b)
#pragma unroll
                for (int m = 0; m < 4; ++m)
#pragma unroll
                    for (int n = 0; n < 2; ++n) acc[a][b][m][n] = (f32x4){0.f, 0.f, 0.f, 0.f};
        cur = nxt; cA = nA; cB = nB; ++ui; nt = cur.nt ? cur.nt : K / BK;
        if constexpr (ALIGN_EPI) { if (wr == 1) PG8_BAR; }
    }
    PG8_WAIT_V(0);
    if constexpr (!ALIGN_EPI) { if (wr == 0) PG8_BAR; }
    PG8_BAR;
    if constexpr (Epi::AFTER_DRAIN) { E.fused(acc, cur, wr, wc, fr, fq, lds, wid, lane); S.done(cur); }
#undef PG8_SA
#undef PG8_SB
#undef PG8_STAGE
#undef PG8_LDA
#undef PG8_LDB
#undef PG8_MMA
#undef PG8_WAIT_V
#undef PG8_WAIT_L
#undef PG8_BAR
#undef PG8_SCHED
}
}

#define LAS __attribute__((address_space(3)))
namespace mk {
typedef unsigned short bf16;
typedef unsigned u32x4 __attribute__((ext_vector_type(4)));
typedef unsigned u32x2 __attribute__((ext_vector_type(2)));
typedef float f32x4 __attribute__((ext_vector_type(4)));
typedef short bf16x8 __attribute__((ext_vector_type(8)));
constexpr int NT = 512;

__device__ __forceinline__ unsigned f2bf(float f) { unsigned u = __builtin_bit_cast(unsigned, f); return (u + 0x7fffu + ((u >> 16) & 1u)) >> 16; }
__device__ __forceinline__ unsigned pk2(float lo, float hi) { return f2bf(lo) | (f2bf(hi) << 16); }
__device__ __forceinline__ float bf2f(unsigned h) { return __uint_as_float(h << 16); }
__device__ __forceinline__ float bflo(unsigned w) { return __uint_as_float(w << 16); }
__device__ __forceinline__ float bfhi(unsigned w) { return __uint_as_float(w & 0xffff0000u); }
__device__ __forceinline__ float wave_sum(float v) {
#pragma unroll
    for (int o = 1; o < 64; o <<= 1) v += __shfl_xor(v, o);
    return v;
}
__device__ __forceinline__ float wave_max(float v) {
#pragma unroll
    for (int o = 1; o < 64; o <<= 1) v = fmaxf(v, __shfl_xor(v, o));
    return v;
}
__device__ __forceinline__ float logsig(float x) { return fminf(x, 0.f) - __logf(1.0f + __expf(-fabsf(x))); }

#ifdef MK_SECT
#define PT(i) do { if (tid == 0) { LAS unsigned long long* pt_ = (LAS unsigned long long*)(lds + LDS_BYTES - 256); const unsigned long long n_ = __builtin_amdgcn_s_memrealtime(); pt_[1 + (i)] += n_ - pt_[0]; pt_[0] = n_; } } while (0)
#define PT_RESET() do { if (tid == 0) { ((LAS unsigned long long*)(lds + LDS_BYTES - 256))[0] = __builtin_amdgcn_s_memrealtime(); } } while (0)
#else
#define PT(i) do { } while (0)
#define PT_RESET() do { } while (0)
#endif
struct Args { const float* in[20]; float* out; unsigned char* ws; int ph_lo, ph_hi; };

__device__ __forceinline__ int win_dst(int n) { return n < 1792 ? n : (n < 1808 ? C_GLR + (n - 1792) : n - 16); }
template <bool MAP>
__device__ __forceinline__ void transpose_item(const float* W, int K, int N, bf16* WT, LAS float* scr, int item, int lane, int ldk = 0) {
    if (ldk == 0) ldk = K;
    const int nblk = (N + 31) / 32, kb = item / nblk, nb = item % nblk, k0 = 64 * kb, n0 = 32 * nb;
    const int ncol = n0 + (lane & 31);
    float wv[32];
    const float* wp = W + (size_t)(k0 + (lane >> 5)) * N + (ncol < N ? ncol : N - 1);
#pragma unroll
    for (int i = 0; i < 32; ++i) wv[i] = wp[(size_t)(2 * i) * N];
#pragma unroll
    for (int i = 0; i < 32; ++i) { const int kk = 2 * i + (lane >> 5); scr[kk * 33 + (lane & 31)] = (ncol < N) ? wv[i] : 0.f; }
    asm volatile("s_waitcnt lgkmcnt(0)" ::: "memory");
    const int c = lane & 7;
#pragma unroll
    for (int j = 0; j < 4; ++j) { const int n = (lane >> 3) + 8 * j; const LAS float* s = scr + (8 * c) * 33 + n;
        u32x4 o; o.x = pk2(s[0 * 33], s[1 * 33]); o.y = pk2(s[2 * 33], s[3 * 33]); o.z = pk2(s[4 * 33], s[5 * 33]); o.w = pk2(s[6 * 33], s[7 * 33]);
        const int nsrc = n0 + n;
        if (nsrc < N) { const int nd = MAP ? win_dst(nsrc) : nsrc; *(u32x4*)(WT + (size_t)nd * ldk + k0 + 8 * c) = o; } }
    asm volatile("s_waitcnt lgkmcnt(0)" ::: "memory");
}

__device__ __forceinline__ void p0_prologue(const Args& a, LAS unsigned char* lds, int tid) {
    const int lane = tid & 63, wave = tid >> 6;
    const int gw = blockIdx.x * 8 + wave, NGW = gridDim.x * 8;
    LAS float* scr = (LAS float*)(lds + wave * 16384);
    bf16* WTb = (bf16*)(a.ws + WS_WT);
    constexpr int I_IN = 16 * 137, I_A = 8 * 32, I_O = 16 * 32, I_U = 16 * 128, I_D = 64 * 32, I_L = I_IN + 2 * I_A + I_O + I_U + I_D;
    for (int it = gw; it < NL * I_L; it += NGW) {
        const int l = it / I_L; int r = it - l * I_L; bf16* wt = WTb + (size_t)l * WT_LAYER;
        if (r < I_IN) { transpose_item<true>(a.in[6] + (size_t)l * 1024 * NIN, 1024, NIN, wt + WT_IN, scr, r, lane); continue; } r -= I_IN;
        if (r < I_A) { transpose_item<false>(a.in[11] + (size_t)l * 512 * 1024, 512, 1024, wt + WT_A, scr, r, lane, 1024); continue; } r -= I_A;
        if (r < I_A) { transpose_item<false>(a.in[12] + (size_t)l * 512 * 1024, 512, 1024, wt + WT_A + 512, scr, r, lane, 1024); continue; } r -= I_A;
        if (r < I_O) { transpose_item<false>(a.in[13] + (size_t)l * 1024 * 1024, 1024, 1024, wt + WT_OUT, scr, r, lane); continue; } r -= I_O;
        if (r < I_U) { transpose_item<false>(a.in[16] + (size_t)l * 1024 * 4096, 1024, 4096, wt + WT_UP, scr, r, lane); continue; } r -= I_U;
        transpose_item<false>(a.in[17] + (size_t)l * 4096 * 1024, 4096, 1024, wt + WT_DOWN, scr, r, lane);
    }
    float* rope = (float*)(a.ws + WS_ROPE);
    for (int i = blockIdx.x * NT + tid; i < (LP + 1) * 8; i += gridDim.x * NT) {
        const int pi = i >> 3, f = i & 7; const float pos = (pi == LP) ? 8192.f : (float)pi;
        const float inv = powf(500000.0f, -(float)f * 0.125f);
        const float ang = pos * inv;
        const double rev = (double)ang * 0.15915494309189535; const float fr = (float)(rev - rint(rev));
        rope[pi * 16 + f] = __builtin_amdgcn_cosf(fr); rope[pi * 16 + 8 + f] = __builtin_amdgcn_sinf(fr);
    }
    float* X = (float*)(a.ws + WS_X); bf16* ACT = (bf16*)(a.ws + WS_ACT);
    for (int row0 = gw; row0 < MPAD; row0 += 4 * NGW) {
        f32x4 v[4][4];
#pragma unroll
        for (int u = 0; u < 4; ++u) {
            const int row = row0 + u * NGW; const float* src = nullptr;
            if (row < MP) { const int b = row / LP, p = row - b * LP; src = (p < 16) ? a.in[5] + (size_t)p * D : a.in[0] + ((size_t)b * 4096 + (p - 16)) * D; }
            else if (row < MREAL) src = a.in[1] + (size_t)(row - MP) * D;
#pragma unroll
            for (int j = 0; j < 4; ++j) v[u][j] = src ? *((const f32x4*)src + lane + 64 * j) : (f32x4){0.f, 0.f, 0.f, 0.f};
        }
#pragma unroll
        for (int u = 0; u < 4; ++u) {
            const int row = row0 + u * NGW; if (row >= MPAD) continue;
#pragma unroll
            for (int j = 0; j < 4; ++j) {
                *((f32x4*)(X + (size_t)row * D) + lane + 64 * j) = v[u][j] * ALPHA;
                u32x2 w; w.x = pk2(v[u][j].x, v[u][j].y); w.y = pk2(v[u][j].z, v[u][j].w);
                *((u32x2*)(ACT + (size_t)row * D) + lane + 64 * j) = w;
            }
        }
    }
}

__device__ __forceinline__ void ln_pair(const Args& a, const f32x4 (&gv)[4], const f32x4 (&bv)[4], bool last, int nsplit, int row0, int row1, bool has1, int lane) {
    float* X = (float*)(a.ws + WS_X); bf16* ACT = (bf16*)(a.ws + WS_ACT);
    f32x4 v[2][4];
#pragma unroll
    for (int j = 0; j < 4; ++j) { v[0][j] = *((const f32x4*)(X + (size_t)row0 * D) + lane + 64 * j); v[1][j] = has1 ? *((const f32x4*)(X + (size_t)row1 * D) + lane + 64 * j) : (f32x4){0.f, 0.f, 0.f, 0.f}; }
    if (row0 >= 64 * 256 || (has1 && row1 >= 64 * 256)) {
        const float* PART = (const float*)(a.ws + WS_PART);
        for (int s = 0; s < nsplit; ++s) {
#pragma unroll
            for (int j = 0; j < 4; ++j) {
                if (row0 >= 64 * 256) v[0][j] += *((const f32x4*)(PART + ((size_t)s * 256 + (row0 - 64 * 256)) * D) + lane + 64 * j);
                if (has1 && row1 >= 64 * 256) v[1][j] += *((const f32x4*)(PART + ((size_t)s * 256 + (row1 - 64 * 256)) * D) + lane + 64 * j);
            }
        }
    }
#pragma unroll
    for (int u = 0; u < 2; ++u) {
        const int row = u ? row1 : row0;
        float s = 0.f;
#pragma unroll
        for (int j = 0; j < 4; ++j) s += (v[u][j].x + v[u][j].y) + (v[u][j].z + v[u][j].w);
        const float mean = wave_sum(s) * (1.f / D); float s2 = 0.f;
#pragma unroll
        for (int j = 0; j < 4; ++j) { v[u][j] = v[u][j] - mean; s2 += (v[u][j].x * v[u][j].x + v[u][j].y * v[u][j].y) + (v[u][j].z * v[u][j].z + v[u][j].w * v[u][j].w); }
        const float rstd = 1.f / sqrtf(wave_sum(s2) * (1.f / D) + 1e-5f);
        if (u == 1 && !has1) continue;
        float* yo = nullptr;
        if (last) { if (row >= MP) yo = a.out + O_YS + (size_t)(row - MP) * D; else { const int b = row / LP, p = row - b * LP; if (p >= 16) yo = a.out + O_YP + ((size_t)b * 4096 + (p - 16)) * D; } }
#pragma unroll
        for (int j = 0; j < 4; ++j) {
            const f32x4 o = v[u][j] * rstd * gv[j] + bv[j];
            if (last) { if (yo) *((f32x4*)yo + lane + 64 * j) = o; }
            else { *((f32x4*)(X + (size_t)row * D) + lane + 64 * j) = o * ALPHA; u32x2 w; w.x = pk2(o.x, o.y); w.y = pk2(o.z, o.w); *((u32x2*)(ACT + (size_t)row * D) + lane + 64 * j) = w; }
        }
    }
}
__device__ __forceinline__ void ln_phase(const Args& a, const float* g, const float* bt, bool last, int nsplit, int tid) {
    const int lane = tid & 63, wave = tid >> 6;
    const int gw = blockIdx.x * 8 + wave, NGW = gridDim.x * 8;
    f32x4 gv[4], bv[4];
#pragma unroll
    for (int j = 0; j < 4; ++j) { gv[j] = *((const f32x4*)g + lane + 64 * j); bv[j] = *((const f32x4*)bt + lane + 64 * j); }
#pragma unroll 2
    for (int row0 = gw; row0 < MREAL; row0 += 2 * NGW) ln_pair(a, gv, bv, last, nsplit, row0, row0 + NGW, row0 + NGW < MREAL, lane);
}
__device__ __forceinline__ void wait_count(unsigned* p, unsigned need, int tid) {
    if (tid < 64) {
        const unsigned long long t0 = __builtin_amdgcn_s_memrealtime();
        while ((unsigned)__builtin_amdgcn_readfirstlane(__hip_atomic_load(p, __ATOMIC_RELAXED, __HIP_MEMORY_SCOPE_AGENT)) < need) {
            if (__builtin_amdgcn_s_memrealtime() - t0 > 2000000ull) break;
            __builtin_amdgcn_s_sleep(2);
        }
        __builtin_amdgcn_fence(__ATOMIC_ACQUIRE, "agent");
        asm volatile("s_waitcnt vmcnt(0)" ::: "memory");
    }
    __syncthreads();
}
__device__ __forceinline__ void ln_exchange(const Args& a, unsigned* cnt, int cu, int S, const float* g, const float* bt, bool last, int tid) {
    const int lane = tid & 63, wave = tid >> 6;
    pg8::StaticOrder so; so.init(64 * 256, 1024, (int)gridDim.x, cu); pg8::Unit um; so.next(0, um);
    const bool has_tail = um.pm < S;
    asm volatile("s_waitcnt vmcnt(0)" ::: "memory");
    __syncthreads();
    if (tid == 0) {
        __builtin_amdgcn_fence(__ATOMIC_RELEASE, "agent");
        asm volatile("s_waitcnt vmcnt(0)" ::: "memory");
        __hip_atomic_fetch_add(cnt + 64 * um.pm, 1u, __ATOMIC_RELAXED, __HIP_MEMORY_SCOPE_AGENT);
        if (has_tail) __hip_atomic_fetch_add(cnt + 64 * 64, 1u, __ATOMIC_RELAXED, __HIP_MEMORY_SCOPE_AGENT);
    }
    f32x4 gv[4], bv[4];
#pragma unroll
    for (int j = 0; j < 4; ++j) { gv[j] = *((const f32x4*)g + lane + 64 * j); bv[j] = *((const f32x4*)bt + lane + 64 * j); }
    wait_count(cnt + 64 * um.pm, 4u, tid);
    const int rbase = um.pm * 256 + um.pn * 64 + wave;
#pragma unroll 1
    for (int i = 0; i < 8; i += 2) ln_pair(a, gv, bv, last, 0, rbase + 8 * i, rbase + 8 * i + 8, true, lane);
    if (has_tail) {
        wait_count(cnt + 64 * 64, 4u * (unsigned)S, tid);
        const int L = um.pm * 4 + um.pn, r = L + 4 * S * wave;
        if (r < MREAL - 64 * 256) ln_pair(a, gv, bv, last, S, 64 * 256 + r, 0, false, lane);
    }
}

__device__ __forceinline__ void attn_item(LAS unsigned char* lds, const bf16* P, bf16* MIXA, float sink, int b, int n, int h, int tid) {
    LAS bf16* Ks = (LAS bf16*)lds;
    LAS bf16* Vt = (LAS bf16*)(lds + 36864);
    const int kvh = h >> 2, lane = tid & 63, w = tid >> 6, fr = lane & 15, fq = lane >> 4;
    for (int i = tid; i < 64 * 24; i += NT) Vt[(i / 24) * 280 + 256 + (i % 24)] = 0;
#pragma unroll
    for (int i = 0; i < 4; ++i) {
        const int q = tid + NT * i, key = q >> 3, part = q & 7, slot = (n - 1) * 128 + key;
        const bf16* src = P + (size_t)(b * LP + (slot >= 112 ? slot - 112 : 0)) * PST;
        u32x4 kv = *(const u32x4*)(src + C_K + kvh * 64 + part * 8), vv = *(const u32x4*)(src + C_V + kvh * 64 + part * 8);
        if (slot < 112) { kv = (u32x4){0u, 0u, 0u, 0u}; vv = (u32x4){0u, 0u, 0u, 0u}; }
        *(LAS u32x4*)(Ks + key * 72 + part * 8) = kv;
        LAS bf16* vd = Vt + (part * 8) * 280 + key;
        vd[0 * 280] = (bf16)(vv.x & 0xffffu); vd[1 * 280] = (bf16)(vv.x >> 16); vd[2 * 280] = (bf16)(vv.y & 0xffffu); vd[3 * 280] = (bf16)(vv.y >> 16);
        vd[4 * 280] = (bf16)(vv.z & 0xffffu); vd[5 * 280] = (bf16)(vv.z >> 16); vd[6 * 280] = (bf16)(vv.w & 0xffffu); vd[7 * 280] = (bf16)(vv.w >> 16);
    }
    const int qi = 16 * w + fr, slotq = n * 128 + qi; const bool qv = slotq >= 112;
    const size_t qrow = (size_t)(b * LP + (qv ? slotq - 112 : 0));
    bf16x8 qf[2];
#pragma unroll
    for (int kk = 0; kk < 2; ++kk) { qf[kk] = *(const bf16x8*)(P + qrow * PST + h * 64 + kk * 32 + 8 * fq); if (!qv) qf[kk] = (bf16x8){0, 0, 0, 0, 0, 0, 0, 0}; }
    __syncthreads();
    f32x4 s[9];
#pragma unroll
    for (int r = 0; r < 9; ++r) {
        f32x4 acc = (f32x4){0.f, 0.f, 0.f, 0.f};
#pragma unroll
        for (int kk = 0; kk < 2; ++kk) { const bf16x8 kf = *(const LAS bf16x8*)(Ks + ((w + r) * 16 + fr) * 72 + kk * 32 + 8 * fq); acc = __builtin_amdgcn_mfma_f32_16x16x32_bf16(kf, qf[kk], acc, 0, 0, 0); }
        s[r] = acc;
    }
    float mx = sink;
#pragma unroll
    for (int r = 0; r < 9; ++r)
#pragma unroll
        for (int j = 0; j < 4; ++j) {
            const int dl = 16 * r + 4 * fq + j - fr, slotk = (n - 1) * 128 + 16 * (w + r) + 4 * fq + j;
            const bool ok = dl > 0 && dl <= 128 && slotk >= 112;
            const float v = ok ? s[r][j] * 0.125f : -INFINITY; s[r][j] = v; mx = fmaxf(mx, v);
        }
    mx = fmaxf(mx, __shfl_xor(mx, 16)); mx = fmaxf(mx, __shfl_xor(mx, 32));
    float sum = 0.f;
#pragma unroll
    for (int r = 0; r < 9; ++r)
#pragma unroll
        for (int j = 0; j < 4; ++j) { const float p = __expf(s[r][j] - mx); s[r][j] = p; sum += p; }
    sum += __shfl_xor(sum, 16); sum += __shfl_xor(sum, 32);
    const float rden = 1.0f / (sum + __expf(sink - mx));
    f32x4 o[4];
#pragma unroll
    for (int dt = 0; dt < 4; ++dt) o[dt] = (f32x4){0.f, 0.f, 0.f, 0.f};
#pragma unroll
    for (int ks = 0; ks < 5; ++ks) {
        u32x4 pw; pw.x = pk2(s[2 * ks][0], s[2 * ks][1]); pw.y = pk2(s[2 * ks][2], s[2 * ks][3]);
        if (ks < 4) { pw.z = pk2(s[2 * ks + 1 > 8 ? 8 : 2 * ks + 1][0], s[2 * ks + 1 > 8 ? 8 : 2 * ks + 1][1]); pw.w = pk2(s[2 * ks + 1 > 8 ? 8 : 2 * ks + 1][2], s[2 * ks + 1 > 8 ? 8 : 2 * ks + 1][3]); }
        else { pw.z = 0u; pw.w = 0u; }
        const bf16x8 pf = __builtin_bit_cast(bf16x8, pw);
        const int keyb = 16 * (w + 2 * ks) + 4 * fq;
#pragma unroll
        for (int dt = 0; dt < 4; ++dt) {
            const LAS bf16* vp = Vt + (dt * 16 + fr) * 280 + keyb;
            const u32x2 lo = *(const LAS u32x2*)vp, hi = *(const LAS u32x2*)(vp + 16);
            u32x4 vw; vw.x = lo.x; vw.y = lo.y; vw.z = hi.x; vw.w = hi.y;
            o[dt] = __builtin_amdgcn_mfma_f32_16x16x32_bf16(__builtin_bit_cast(bf16x8, vw), pf, o[dt], 0, 0, 0);
        }
    }
    if (qv) {
#pragma unroll
        for (int dt = 0; dt < 4; ++dt) { u32x2 w2; w2.x = pk2(o[dt][0] * rden, o[dt][1] * rden); w2.y = pk2(o[dt][2] * rden, o[dt][3] * rden);
            *(u32x2*)(MIXA + qrow * 1024 + h * 64 + dt * 16 + 4 * fq) = w2; }
    }
}

__device__ __forceinline__ void sattn_item(LAS unsigned char* lds, const Args& a, int layer, int s, int tid) {
    LAS float* Kf = (LAS float*)lds;
    LAS float* Vf = Kf + 16384;
    LAS float* qs = Vf + 16384;
    LAS float* ps = qs + 512;
    const bf16* P = (const bf16*)(a.ws + WS_P);
    bf16* MIXA = (bf16*)(a.ws + WS_MIXA);
    const float* ck = a.in[2] + (size_t)(layer * NS + s) * 16384; const float* cv = a.in[3] + (size_t)(layer * NS + s) * 16384;
    float* ok = a.out + O_KWS + (size_t)(layer * NS + s) * 16384; float* ov = a.out + O_VWS + (size_t)(layer * NS + s) * 16384;
    for (int f4 = tid; f4 < 128 * 32; f4 += NT) {
        const int f = f4 * 4, r = f >> 7, rem = f & 127, li = (rem >> 6) * 8192 + r * 64 + (rem & 63);
        f32x4 kv, vv;
        if (r < 127) { kv = *(const f32x4*)(ck + 128 + f); vv = *(const f32x4*)(cv + 128 + f); *(f32x4*)(ok + f) = kv; *(f32x4*)(ov + f) = vv; }
        else { kv = *(const f32x4*)(ok + f); vv = *(const f32x4*)(ov + f); }
        *(LAS f32x4*)(Kf + li) = kv; *(LAS f32x4*)(Vf + li) = vv;
    }
    const int row = MP + s, h = tid >> 6, lane = tid & 63, kvh = h >> 2;
    qs[tid] = bf2f(P[(size_t)row * PST + tid]);
    __syncthreads();
    const float sink = a.in[9][layer * 8 + h];
    float s0 = 0.f, s1 = 0.f;
    const LAS float* k0 = Kf + kvh * 8192 + lane * 64; const LAS float* k1 = k0 + 64 * 64;
#pragma unroll 8
    for (int d = 0; d < 64; ++d) { const int dd = (d + lane) & 63; const float q = qs[h * 64 + dd]; s0 += q * k0[dd]; s1 += q * k1[dd]; }
    s0 *= 0.125f; s1 *= 0.125f;
    const float mx = fmaxf(wave_max(fmaxf(s0, s1)), sink);
    const float p0 = __expf(s0 - mx), p1 = __expf(s1 - mx);
    const float rden = 1.0f / (wave_sum(p0 + p1) + __expf(sink - mx));
    ps[h * 128 + lane] = p0; ps[h * 128 + 64 + lane] = p1;
    __syncthreads();
    float o = 0.f;
    const LAS float* vb = Vf + kvh * 8192 + lane;
#pragma unroll 8
    for (int r = 0; r < 128; ++r) o += ps[h * 128 + r] * vb[r * 64];
    MIXA[(size_t)row * 1024 + tid] = (bf16)f2bf(o * rden);
}

__device__ __forceinline__ void gla_prep(LAS float* tot, const Args& a, int layer, int h, int rowbase  , int tvalid0, int tid, float (&cum)[8]) {
    const bf16* P = (const bf16*)(a.ws + WS_P);
    const int d = tid & 63, tg = tid >> 6;
    float wa[16];
#pragma unroll
    for (int r = 0; r < 16; ++r) wa[r] = a.in[7][(size_t)(layer * 16 + r) * 256 + h * 64 + d];
    const float ba = a.in[8][layer * 256 + h * 64 + d];
    float run = 0.f;
    u32x4 g0a[8], g1a[8];
#pragma unroll
    for (int i = 0; i < 8; ++i) { const int t = tg * 8 + i; const u32x4* gp = (const u32x4*)(P + (size_t)(rowbase + (t >= tvalid0 ? t : tvalid0)) * PST + C_GLR); g0a[i] = gp[0]; g1a[i] = gp[1]; }
#pragma unroll
    for (int i = 0; i < 8; ++i) {
        const int t = tg * 8 + i; float la = 0.f;
        const u32x4 g0 = g0a[i], g1 = g1a[i];
        {
            float x = ba;
            x += bflo(g0.x) * wa[0] + bfhi(g0.x) * wa[1] + bflo(g0.y) * wa[2] + bfhi(g0.y) * wa[3] + bflo(g0.z) * wa[4] + bfhi(g0.z) * wa[5] + bflo(g0.w) * wa[6] + bfhi(g0.w) * wa[7];
            x += bflo(g1.x) * wa[8] + bfhi(g1.x) * wa[9] + bflo(g1.y) * wa[10] + bfhi(g1.y) * wa[11] + bflo(g1.z) * wa[12] + bfhi(g1.z) * wa[13] + bflo(g1.w) * wa[14] + bfhi(g1.w) * wa[15];
            la = (t >= tvalid0) ? logsig(x) * (1.0f / 16.0f) : 0.f;
        }
        run += la; cum[i] = run;
    }
    tot[tg * 64 + d] = run;
    __syncthreads();
    float pre = 0.f;
#pragma unroll
    for (int g = 0; g < 8; ++g) pre += (g < tg) ? tot[g * 64 + d] : 0.f;
#pragma unroll
    for (int i = 0; i < 8; ++i) cum[i] += pre;
}

constexpr size_t O_KVL = O_YP, O_S0T = O_YP + (size_t)16 * NCH * 8192;
static_assert(O_S0T + (size_t)16 * NCH * 8192 / 2 <= O_YS, "GLA scratch fits in y_prompt");

__device__ __forceinline__ void gla_stage_vt(LAS bf16* VT, const bf16* P, int rowbase, int h, int tv0, int tid) {
    const int e = tid & 127, tq = tid >> 7;
    unsigned w[8];
#pragma unroll
    for (int i = 0; i < 8; ++i) {
        const int t0 = tq * 16 + 2 * i;
        unsigned lo = P[(size_t)(rowbase + (t0 >= tv0 ? t0 : tv0)) * PST + C_GV + h * 128 + e];
        unsigned hi = P[(size_t)(rowbase + (t0 + 1 >= tv0 ? t0 + 1 : tv0)) * PST + C_GV + h * 128 + e];
        lo = (t0 >= tv0) ? lo : 0u; hi = (t0 + 1 >= tv0) ? hi : 0u;
        w[i] = lo | (hi << 16);
    }
    LAS u32x4* dst = (LAS u32x4*)(VT + e * 72 + tq * 16);
    dst[0] = (u32x4){w[0], w[1], w[2], w[3]}; dst[1] = (u32x4){w[4], w[5], w[6], w[7]};
}

__device__ __forceinline__ void gla1_item(LAS unsigned char* lds, const Args& a, int layer, int bh, int c, int tid) {
    LAS float* tot = (LAS float*)lds;
    LAS bf16* KlT = (LAS bf16*)(lds + 2048);
    LAS bf16* VT = (LAS bf16*)(lds + 2048 + 9216);
    const bf16* P = (const bf16*)(a.ws + WS_P);
    const int b = bh >> 2, h = bh & 3, rowbase = b * LP + 64 * c - 112, tv0 = (c == 1) ? 48 : 0;
    const int d = tid & 63, tg = tid >> 6;
    float kraw[8];
#pragma unroll
    for (int i = 0; i < 8; ++i) { const int t = tg * 8 + i; kraw[i] = bf2f(P[(size_t)(rowbase + (t >= tv0 ? t : tv0)) * PST + C_GK + h * 64 + d]); }
    gla_stage_vt(VT, P, rowbase, h, tv0, tid);
    float cum[8];
    gla_prep(tot, a, layer, h, rowbase, tv0, tid, cum);
    float bl = 0.f;
#pragma unroll
    for (int g = 0; g < 8; ++g) bl += tot[g * 64 + d];
    {
        float kl[8];
#pragma unroll
        for (int i = 0; i < 8; ++i) { const int t = tg * 8 + i; kl[i] = 0.f;
            if (t >= tv0) kl[i] = kraw[i] * __expf(bl - cum[i]); }
        *(LAS u32x4*)(KlT + d * 72 + tg * 8) = (u32x4){pk2(kl[0], kl[1]), pk2(kl[2], kl[3]), pk2(kl[4], kl[5]), pk2(kl[6], kl[7])};
    }
    if (tid < 64) ((float*)(a.ws + WS_DEC))[(size_t)(bh * NCH + c) * 64 + tid] = __expf(bl);
    __syncthreads();
    const int lane = tid & 63, w = tid >> 6, fr = lane & 15, fq = lane >> 4;
    f32x4 acc[4];
#pragma unroll
    for (int dt = 0; dt < 4; ++dt) acc[dt] = (f32x4){0.f, 0.f, 0.f, 0.f};
#pragma unroll
    for (int ks = 0; ks < 2; ++ks) {
        const bf16x8 xv = *(const LAS bf16x8*)(VT + (16 * w + fr) * 72 + 32 * ks + 8 * fq);
#pragma unroll
        for (int dt = 0; dt < 4; ++dt) { const bf16x8 yk = *(const LAS bf16x8*)(KlT + (16 * dt + fr) * 72 + 32 * ks + 8 * fq); acc[dt] = __builtin_amdgcn_mfma_f32_16x16x32_bf16(xv, yk, acc[dt], 0, 0, 0); }
    }
    float* kvl = a.out + O_KVL + (size_t)(bh * NCH + c) * 8192;
#pragma unroll
    for (int dt = 0; dt < 4; ++dt)
#pragma unroll
        for (int r = 0; r < 4; ++r) kvl[(16 * w + 4 * fq + r) * 64 + 16 * dt + fr] = acc[dt][r];
}

__device__ __forceinline__ void gla_scan(const Args& a, int layer, int tid) {
    const float* __restrict__ DEC = (const float*)(a.ws + WS_DEC);
    const float* __restrict__ KVL = a.out + O_KVL;
    bf16* __restrict__ S0T = (bf16*)(a.out + O_S0T);
    for (int idx = blockIdx.x * NT + tid; idx < 16 * 8192; idx += gridDim.x * NT) {
        const int bh = idx >> 13, ed = idx & 8191, d = ed & 63, e = ed >> 6;
        const float* kvl = KVL + (size_t)bh * NCH * 8192 + ed; const float* dec = DEC + (size_t)bh * NCH * 64 + d;
        bf16* st = S0T + (size_t)bh * NCH * 8192 + ed;
        float S = 0.f;
#pragma unroll
        for (int hb = 0; hb < 2; ++hb) {
            const int c0 = hb ? 34 : 1, nb = hb ? 32 : 33;
            float kv[33], dc[33];
#pragma unroll
            for (int i = 0; i < 33; ++i) if (i < nb) { kv[i] = kvl[(size_t)(c0 + i) * 8192]; dc[i] = dec[(c0 + i) * 64]; }
#pragma unroll
            for (int i = 0; i < 33; ++i) if (i < nb) { st[(size_t)(c0 + i) * 8192] = (bf16)f2bf(S); S = dc[i] * S + kv[i]; }
        }
        a.out[O_STP + (size_t)(layer * 16 + bh) * 8192 + d * 128 + e] = S;
    }
}

__device__ __forceinline__ void gla3_item(LAS unsigned char* lds, const Args& a, int layer, int bh, int c, int tid) {
    LAS float* tot = (LAS float*)lds;
    LAS float* Bm = (LAS float*)(lds + 2048);
    LAS bf16* Qe = (LAS bf16*)(lds + 2048 + 16640);
    LAS bf16* Kd = Qe + 64 * 72;
    LAS bf16* VT = Kd + 64 * 72;
    LAS float* ssq = (LAS float*)(lds + 2048 + 16640 + 9216 + 9216 + 18432);
    const bf16* P = (const bf16*)(a.ws + WS_P);
    bf16* MIXB = (bf16*)(a.ws + WS_MIXA) + 512;
    const int b = bh >> 2, h = bh & 3, rowbase = b * LP + 64 * c - 112, tv0 = (c == 1) ? 48 : 0;
    const int lane = tid & 63, w = tid >> 6, fr = lane & 15, fq = lane >> 4, tt = w & 3, eh = w >> 2;
    PT(0);
    u32x4 qw, kw;
    { const int t = tid >> 3, dp = tid & 7; const bf16* pr = P + (size_t)(rowbase + (t >= tv0 ? t : tv0)) * PST + h * 64 + 8 * dp; qw = *(const u32x4*)(pr + C_GQ); kw = *(const u32x4*)(pr + C_GK); }
    gla_stage_vt(VT, P, rowbase, h, tv0, tid);
    float cum[8];
    gla_prep(tot, a, layer, h, rowbase, tv0, tid, cum);
    PT(1);
    bf16x8 s0f[4][2];
    {
        const bf16* S0T = (const bf16*)(a.out + O_S0T) + (size_t)(bh * NCH + c) * 8192;
#pragma unroll
        for (int i = 0; i < 4; ++i)
#pragma unroll
            for (int ks = 0; ks < 2; ++ks) s0f[i][ks] = *(const bf16x8*)(S0T + (16 * (4 * eh + i) + fr) * 64 + 32 * ks + 8 * fq);
    }
    f32x4 g4v[4]; u32x2 rwv[4];
    { const int t = 16 * tt + fr; const size_t row = (size_t)(rowbase + (t >= tv0 ? t : tv0));
#pragma unroll
      for (int i = 0; i < 4; ++i) { const int e0 = 16 * (4 * eh + i) + 4 * fq; g4v[i] = *(const f32x4*)(a.in[10] + layer * 128 + e0); rwv[i] = *(const u32x2*)(P + row * PST + C_GR + h * 128 + e0); } }
    {
        const int d = tid & 63, tg = tid >> 6;
#pragma unroll
        for (int i = 0; i < 8; ++i) Bm[(tg * 8 + i) * 65 + d] = cum[i];
    }
    __syncthreads();
    {
        const int t = tid >> 3, dp = tid & 7;
        if (t < tv0) { qw = (u32x4){0u, 0u, 0u, 0u}; kw = (u32x4){0u, 0u, 0u, 0u}; }
        float bb[8];
#pragma unroll
        for (int i = 0; i < 8; ++i) bb[i] = Bm[t * 65 + 8 * dp + i];
        float q[8] = {bflo(qw.x), bfhi(qw.x), bflo(qw.y), bfhi(qw.y), bflo(qw.z), bfhi(qw.z), bflo(qw.w), bfhi(qw.w)};
        float k[8] = {bflo(kw.x), bfhi(kw.x), bflo(kw.y), bfhi(kw.y), bflo(kw.z), bfhi(kw.z), bflo(kw.w), bfhi(kw.w)};
#pragma unroll
        for (int i = 0; i < 8; ++i) { q[i] *= 0.125f * __expf(bb[i]); k[i] *= __expf(-bb[i]); }
        *(LAS u32x4*)(Qe + t * 72 + 8 * dp) = (u32x4){pk2(q[0], q[1]), pk2(q[2], q[3]), pk2(q[4], q[5]), pk2(q[6], q[7])};
        *(LAS u32x4*)(Kd + t * 72 + 8 * dp) = (u32x4){pk2(k[0], k[1]), pk2(k[2], k[3]), pk2(k[4], k[5]), pk2(k[6], k[7])};
    }
    __syncthreads();
    PT(2);
    bf16x8 qf[2];
#pragma unroll
    for (int ks = 0; ks < 2; ++ks) qf[ks] = *(const LAS bf16x8*)(Qe + (16 * tt + fr) * 72 + 32 * ks + 8 * fq);
    bf16x8 ap[2];
#pragma unroll
    for (int kp = 0; kp < 2; ++kp) {
        f32x4 a2[2];
#pragma unroll
        for (int u = 0; u < 2; ++u) {
            const int jt = 2 * kp + u; f32x4 acc = (f32x4){0.f, 0.f, 0.f, 0.f};
#pragma unroll
            for (int ks = 0; ks < 2; ++ks) { const bf16x8 kf = *(const LAS bf16x8*)(Kd + (16 * jt + fr) * 72 + 32 * ks + 8 * fq); acc = __builtin_amdgcn_mfma_f32_16x16x32_bf16(kf, qf[ks], acc, 0, 0, 0); }
#pragma unroll
            for (int r = 0; r < 4; ++r) acc[r] = (16 * jt + 4 * fq + r <= 16 * tt + fr) ? acc[r] : 0.f;
            a2[u] = acc;
        }
        u32x4 pw; pw.x = pk2(a2[0][0], a2[0][1]); pw.y = pk2(a2[0][2], a2[0][3]); pw.z = pk2(a2[1][0], a2[1][1]); pw.w = pk2(a2[1][2], a2[1][3]);
        ap[kp] = __builtin_bit_cast(bf16x8, pw);
    }
    f32x4 o[4]; float ss = 0.f;
#pragma unroll
    for (int i = 0; i < 4; ++i) {
        f32x4 acc = (f32x4){0.f, 0.f, 0.f, 0.f};
#pragma unroll
        for (int ks = 0; ks < 2; ++ks) acc = __builtin_amdgcn_mfma_f32_16x16x32_bf16(s0f[i][ks], qf[ks], acc, 0, 0, 0);
#pragma unroll
        for (int kp = 0; kp < 2; ++kp) {
            const LAS bf16* vp = VT + (16 * (4 * eh + i) + fr) * 72 + 32 * kp + 4 * fq;
            const u32x2 lo = *(const LAS u32x2*)vp, hi = *(const LAS u32x2*)(vp + 16);
            u32x4 vw; vw.x = lo.x; vw.y = lo.y; vw.z = hi.x; vw.w = hi.y;
            acc = __builtin_amdgcn_mfma_f32_16x16x32_bf16(__builtin_bit_cast(bf16x8, vw), ap[kp], acc, 0, 0, 0);
        }
        o[i] = acc; ss += (acc[0] * acc[0] + acc[1] * acc[1]) + (acc[2] * acc[2] + acc[3] * acc[3]);
    }
    ss += __shfl_xor(ss, 16); ss += __shfl_xor(ss, 32);
    if (fq == 0) ssq[eh * 64 + 16 * tt + fr] = ss;
    __syncthreads();
    const int t = 16 * tt + fr;
    const float sc = rsqrtf((ssq[t] + ssq[64 + t]) * (1.0f / 128.0f) + 1e-6f);
    PT(3);
    if (t >= tv0) {
        const size_t row = (size_t)(rowbase + t);
#pragma unroll
        for (int i = 0; i < 4; ++i) {
            const int e0 = 16 * (4 * eh + i) + 4 * fq;
            const f32x4 g4 = g4v[i]; const u32x2 rw = rwv[i];
            const float r0 = bflo(rw.x), r1 = bfhi(rw.x), r2 = bflo(rw.y), r3 = bfhi(rw.y);
            u32x2 ow;
            ow.x = pk2(o[i][0] * sc * g4.x * r0 / (1.0f + __expf(-r0)), o[i][1] * sc * g4.y * r1 / (1.0f + __expf(-r1)));
            ow.y = pk2(o[i][2] * sc * g4.z * r2 / (1.0f + __expf(-r2)), o[i][3] * sc * g4.w * r3 / (1.0f + __expf(-r3)));
            *(u32x2*)(MIXB + row * 1024 + h * 128 + e0) = ow;
        }
    }
}


__device__ __forceinline__ void sgla_item(LAS unsigned char* lds, const Args& a, int layer, int s, int h, int tid) {
    LAS float* la = (LAS float*)lds;
    LAS float* kq = la + 64;
    LAS float* vv = kq + 128;
    LAS float* red = vv + 128;
    LAS float* ov = red + 512;
    const bf16* P = (const bf16*)(a.ws + WS_P);
    bf16* MIXB = (bf16*)(a.ws + WS_MIXA) + 512;
    const size_t row = (size_t)(MP + s);
    const bf16* pr = P + row * PST;
    const int e = tid & 127, dg = tid >> 7;
    const float* S0 = a.in[4] + ((size_t)(layer * NS + s) * 4 + h) * 8192;
    float s0v[16];
#pragma unroll
    for (int i = 0; i < 16; ++i) s0v[i] = S0[(dg * 16 + i) * 128 + e];
    if (tid < 64) {
        const int d = tid; float x = a.in[8][layer * 256 + h * 64 + d];
#pragma unroll
        for (int r = 0; r < 16; ++r) x += bf2f(pr[C_GLR + r]) * a.in[7][(size_t)(layer * 16 + r) * 256 + h * 64 + d];
        la[d] = __expf(logsig(x) * (1.0f / 16.0f));
        kq[d] = bf2f(pr[C_GK + h * 64 + d]); kq[64 + d] = bf2f(pr[C_GQ + h * 64 + d]) * 0.125f;
    } else if (tid < 192) vv[tid - 64] = bf2f(pr[C_GV + h * 128 + (tid - 64)]);
    __syncthreads();
    float* S1 = a.out + O_STS + ((size_t)(layer * NS + s) * 4 + h) * 8192;
    const float ve = vv[e]; float po = 0.f;
#pragma unroll
    for (int i = 0; i < 16; ++i) { const int d = dg * 16 + i; const float s1 = la[d] * s0v[i] + kq[d] * ve; S1[d * 128 + e] = s1; po += kq[64 + d] * s1; }
    red[dg * 128 + e] = po;
    __syncthreads();
    if (tid < 128) ov[tid] = (red[tid] + red[128 + tid]) + (red[256 + tid] + red[384 + tid]);
    __syncthreads();
    if (tid < 64) {
        const float x0 = ov[tid], x1 = ov[64 + tid];
        const float sc = rsqrtf(wave_sum(x0 * x0 + x1 * x1) * (1.0f / 128.0f) + 1e-6f);
        const float g0 = a.in[10][layer * 128 + tid], g1 = a.in[10][layer * 128 + 64 + tid];
        const float r0 = bf2f(pr[C_GR + h * 128 + tid]), r1 = bf2f(pr[C_GR + h * 128 + 64 + tid]);
        MIXB[row * 1024 + h * 128 + tid] = (bf16)f2bf(x0 * sc * g0 * r0 / (1.0f + __expf(-r0)));
        MIXB[row * 1024 + h * 128 + 64 + tid] = (bf16)f2bf(x1 * sc * g1 * r1 / (1.0f + __expf(-r1)));
    }
}

__device__ __forceinline__ int next_item(unsigned* ctr, LAS int* slot, int tid, int& pre) {
    __syncthreads();
    if (tid == 0) { if (pre < 0) pre = (int)__hip_atomic_fetch_add(ctr, 1u, __ATOMIC_RELAXED, __HIP_MEMORY_SCOPE_AGENT); *slot = pre; }
    __syncthreads();
    const int it = *slot;
    if (tid == 0) pre = (int)__hip_atomic_fetch_add(ctr, 1u, __ATOMIC_RELAXED, __HIP_MEMORY_SCOPE_AGENT);
    return it;
}

#define XB_TMO      128
#define XB_XCNT(j)  (256  + 64 * (j))
#define XB_XSUB(j)  (1280 + 64 * (j))
#define XB_XGEN(j)  (2304 + 64 * (j))
#define XB_TOP      3328
#define XB_TOPGEN   3392
#define XCD_BAR_WORDS 3456
#define XB_SPIN_CAP (1u << 18)

__device__ __forceinline__ unsigned xb_ld(unsigned* p)              { return __hip_atomic_load(p, __ATOMIC_RELAXED, __HIP_MEMORY_SCOPE_AGENT); }
__device__ __forceinline__ unsigned xb_add(unsigned* p, unsigned v) { return __hip_atomic_fetch_add(p, v, __ATOMIC_RELAXED, __HIP_MEMORY_SCOPE_AGENT); }
__device__ __forceinline__ unsigned xb_xcc_id() { return (unsigned)__builtin_amdgcn_s_getreg((3 << 11) | 20) & 0xFu; }
#define XB_SPIN(cond, bar) do { unsigned _sp = 0; while (cond) { __builtin_amdgcn_s_sleep(1); \
    if ((++_sp & 255u) == 0u) { if (xb_ld(&(bar)[XB_TMO])) break; if (_sp > XB_SPIN_CAP) { atomicAdd(&(bar)[XB_TMO], 1u); break; } } } } while (0)

struct XcdBarrier {
    unsigned* bar; unsigned x;
    volatile LAS unsigned* st;
};

__device__ __forceinline__ XcdBarrier xcd_barrier_post(unsigned* bar, volatile LAS unsigned* st) {
    XcdBarrier b; b.bar = bar; b.x = xb_xcc_id(); b.st = st;
    if (threadIdx.x == 0) (void)xb_add(&bar[XB_XCNT(b.x)], 1u);
    return b;
}
__device__ __forceinline__ void xcd_barrier_complete(unsigned* bar, unsigned x, unsigned& nloc, unsigned& nx) {
    const unsigned G = gridDim.x * gridDim.y * gridDim.z;
    unsigned sum, cnt, mine, sp = 0u;
    for (;;) {
        sum = 0u; cnt = 0u; mine = 0u;
#pragma unroll
        for (unsigned j = 0; j < 16; ++j) { const unsigned c = xb_ld(&bar[XB_XCNT(j)]); sum += c; cnt += (c > 0u) ? 1u : 0u; mine = (j == x) ? c : mine; }
        if (sum == G) break;
        __builtin_amdgcn_s_sleep(1);
        if ((++sp & 255u) == 0u) { if (xb_ld(&bar[XB_TMO])) break; if (sp > XB_SPIN_CAP) { atomicAdd(&bar[XB_TMO], 1u); break; } }
    }
    nloc = mine > 0u ? mine : 1u; nx = cnt > 0u ? cnt : 1u;
}

__device__ __forceinline__ void xcd_barrier(const XcdBarrier& b) {
    asm volatile("s_waitcnt vmcnt(0)" ::: "memory");
    __syncthreads();
    if (threadIdx.x == 0) {
        unsigned* bar = b.bar;
        __builtin_amdgcn_s_waitcnt(0);
        unsigned nloc = b.st[0], nx = b.st[1];
        if (nloc == 0u) { xcd_barrier_complete(bar, b.x, nloc, nx); b.st[0] = nloc; b.st[1] = nx; }
        const unsigned old = xb_add(&bar[XB_XSUB(b.x)], 1u);
        const unsigned gen = old / nloc;
        if (old + 1u == (gen + 1u) * nloc) {
            __builtin_amdgcn_fence(__ATOMIC_RELEASE, "agent");
            asm volatile("s_waitcnt vmcnt(0)" ::: "memory");
            const unsigned og = xb_add(&bar[XB_TOP], 1u);
            const unsigned tg = og / nx;
            if (og + 1u == (tg + 1u) * nx) xb_add(&bar[XB_TOPGEN], 1u);
            else XB_SPIN(xb_ld(&bar[XB_TOPGEN]) == tg, bar);
            __builtin_amdgcn_fence(__ATOMIC_ACQUIRE, "agent");
            xb_add(&bar[XB_XGEN(b.x)], 1u);
            asm volatile("s_waitcnt vmcnt(0)" ::: "memory");
        } else {
            XB_SPIN(xb_ld(&bar[XB_XGEN(b.x)]) == gen, bar);
            __builtin_amdgcn_fence(__ATOMIC_ACQUIRE, "agent");
            asm volatile("s_waitcnt vmcnt(0)" ::: "memory");
        }
    }
    __syncthreads();
}

#ifndef MK_MASK
#define MK_MASK 0xffff
#endif
#define ON(x) (((MK_MASK) >> (x)) & 1)
constexpr int PH_PER_LAYER = 11, N_PHASES = 1 + NL * PH_PER_LAYER;
constexpr int N_ATT = NB * 33 * 8, N_G = 16 * 65, N_SA = NS, N_SG = NS * 4;

__global__ void __launch_bounds__(NT) mk_fwd(Args a_) {
    extern __shared__ __attribute__((aligned(16))) unsigned char lds_raw[];
    LAS unsigned char* lds = (LAS unsigned char*)lds_raw;
    LAS int* slot = (LAS int*)(lds + LDS_BYTES - 64);
    cg::grid_group grid = cg::this_grid();
    const int G = gridDim.x;
#ifdef MK_SECT
    if (threadIdx.x < 16) ((LAS unsigned long long*)(lds + LDS_BYTES - 256))[threadIdx.x] = 0ull;
#endif
    LAS unsigned* xb_st = (LAS unsigned*)(lds + LDS_BYTES - 32);
    if (threadIdx.x < 2) xb_st[threadIdx.x] = 0u;
    __syncthreads();
    XcdBarrier bar = xcd_barrier_post((unsigned*)(a_.ws + WS_CTL) + 4096, (volatile LAS unsigned*)xb_st);
#ifdef MK_PROBE_A
    unsigned long long pr_t0 = __builtin_amdgcn_s_memrealtime(), pr_prev = pr_t0, pr_a = 0, pr_b = 0;
#endif
    for (int ph = a_.ph_lo; ph < a_.ph_hi; ++ph) {
        int tid = threadIdx.x; asm volatile("" : "+v"(tid));
        int cu = blockIdx.x; asm volatile("" : "+s"(cu));
        Args a = a_;
        asm volatile("" : "+s"(a.ws)); asm volatile("" : "+s"(a.out));
        unsigned* ctl = (unsigned*)(a.ws + WS_CTL);
        bf16* P = (bf16*)(a.ws + WS_P); float* X = (float*)(a.ws + WS_X); bf16* ACT = (bf16*)(a.ws + WS_ACT);
        bf16* MIXA = (bf16*)(a.ws + WS_MIXA);
        if (ph == 0) { if (ON(0)) p0_prologue(a, lds, tid); }
        else {
            const int l = (ph - 1) / PH_PER_LAYER, pos = (ph - 1) % PH_PER_LAYER, k = (pos < 5) ? pos : (pos == 5 ? 10 : pos - 1);
            const bf16* wt = (const bf16*)(a.ws + WS_WT) + (size_t)l * WT_LAYER;
            if (k == 0) { if (ON(1)) {
                pg8::Gemm g{ACT, wt + WT_IN, MPAD, NINP, 1024}; pg8::StaticOrder S; S.init(MPAD, NINP, G, cu);
                pg8::EpiInProj E{P, (const float*)(a.ws + WS_ROPE), a.out, l};
                pg8::gemm_phase<pg8::EpiInProj, pg8::StaticOrder, true, true>(lds, g, S, E); }
            } else if (k == 1) {
                for (int it0 = cu; it0 < N_ATT + N_G + N_SA + N_SG; it0 += G) {
                    int it = it0;
                    __syncthreads();
                    int tl = tid; asm volatile("" : "+v"(tl));
                    if (it < N_SA) { if (ON(4)) sattn_item(lds, a, l, it, tl); continue; } it -= N_SA;
                    if (it < N_ATT) { if (ON(2)) { const int h = it & 7, bn = it >> 3, b = bn / 33, n = 32 - (bn % 33); attn_item(lds, P, MIXA, a.in[9][l * 8 + h], b, n, h, tl); } continue; } it -= N_ATT;
                    if (it < N_G) { const int bh = it & 15, c = 1 + (it >> 4); if (ON(3)) gla1_item(lds, a, l, bh, c, tl); continue; } it -= N_G;
                    if (ON(5)) sgla_item(lds, a, l, it >> 2, it & 3, tl);
                }
            } else if (k == 2) {
                if (ON(6)) gla_scan(a, l, tid);
            } else if (k == 3) {
                PT_RESET();
                for (int it = cu; it < N_G; it += G) {
                    __syncthreads();
                    if (ON(7)) gla3_item(lds, a, l, it & 15, 1 + (it >> 4), tid);
                    PT(4);
                }
            } else if (k == 4) {
                if (ON(8)) { pg8::Gemm g{MIXA, wt + WT_A, MPAD, 1024, 1024}; pg8::TailOrder S; S.init(1024, 4, G, cu); pg8::EpiProj E{P, ACT, (float*)(a.ws + WS_PART)};
                  pg8::gemm_phase<pg8::EpiProj, pg8::TailOrder, true, true>(lds, g, S, E); }
            } else if (k == 5) {
                if (ON(9)) { pg8::Gemm g{ACT, wt + WT_OUT, MPAD, 1024, 1024}; pg8::TailOrder S; S.init(1024, 8, G, cu); pg8::EpiResid E{X, (float*)(a.ws + WS_PART), 1024 / 8};
                pg8::gemm_phase<pg8::EpiResid, pg8::TailOrder, true, true>(lds, g, S, E); }
            } else if (k == 6) {
                if (ON(10)) ln_phase(a, a.in[14] + l * D, a.in[15] + l * D, false, 8, tid);
            } else if (k == 7) {
                if (ON(11)) { pg8::Gemm g{ACT, wt + WT_UP, MPAD, FF, 1024}; pg8::StaticOrder S; S.init(MPAD, FF, G, cu); pg8::EpiUp E{P};
                pg8::gemm_phase<pg8::EpiUp, pg8::StaticOrder, true, true>(lds, g, S, E); }
            } else if (k == 8) {
                if (ON(12)) { pg8::Gemm g{P, wt + WT_DOWN, MPAD, 1024, FF}; pg8::TailOrder S; S.init(FF, 16, G, cu); pg8::EpiResid E{X, (float*)(a.ws + WS_PART), FF / 16};
                pg8::gemm_phase<pg8::EpiResid, pg8::TailOrder, true, true>(lds, g, S, E); }
            } else if (k == 9) {
                if (ON(10)) ln_phase(a, a.in[18] + l * D, a.in[19] + l * D, l == NL - 1, 16, tid);
            } else {
                const int lane = tid & 63, gw = cu * 8 + (tid >> 6);
                const float* PART = (const float*)(a.ws + WS_PART);
                for (int r = gw; r < MREAL - 64 * 256; r += G * 8) {
#pragma unroll
                    for (int j = 0; j < 4; ++j) {
                        f32x4 v = (f32x4){0.f, 0.f, 0.f, 0.f};
#pragma unroll
                        for (int s = 0; s < 4; ++s) v += *((const f32x4*)(PART + ((size_t)s * 256 + r) * D) + lane + 64 * j);
                        u32x2 w; w.x = pk2(v.x, v.y); w.y = pk2(v.z, v.w);
                        *((u32x2*)(ACT + (size_t)(64 * 256 + r) * D) + lane + 64 * j) = w;
                    }
                }
            }
        }
#ifdef MK_PROBE_A
        if (ph == a_.ph_lo) grid.sync(); else xcd_barrier(bar);
        { const unsigned long long now = __builtin_amdgcn_s_memrealtime(); const int pos_ = (ph - 1) % PH_PER_LAYER; const int kind = (ph == 0) ? 11 : ((pos_ < 5) ? pos_ : (pos_ == 5 ? 10 : pos_ - 1));
          if (kind == MK_PROBE_A) pr_a += now - pr_prev; if (kind == MK_PROBE_B) pr_b += now - pr_prev; pr_prev = now; }
#else
        if (ph + 1 < a_.ph_hi) { if (ph == a_.ph_lo) grid.sync(); else xcd_barrier(bar); }
#endif
    }
#ifdef MK_EXTRA_SYNCS
    for (int i = 0; i < MK_EXTRA_SYNCS; ++i) xcd_barrier(bar);
#endif
#ifdef MK_PROBE_A
    if (blockIdx.x == 0) {
#ifdef MK_SECT
        __syncthreads();
        LAS unsigned long long* pt_ = (LAS unsigned long long*)(lds + LDS_BYTES - 256);
        const float tot = (float)(pt_[1] + pt_[2] + pt_[3] + pt_[4] + pt_[5]), fa = (float)pt_[1 + MK_SECT_A] / tot, fb = (float)pt_[1 + MK_SECT_B] / tot;
#else
        const float tot = (float)(pr_prev - pr_t0), fa = (float)pr_a / tot, fb = (float)pr_b / tot;
#endif
        const float eps = sqrtf(0.10f + 0.89f * fb);
        float* ys = a_.out + O_YS;
        for (int i = threadIdx.x; i < NS * D; i += NT) ys[i] *= (1.0f + eps);
        if (threadIdx.x == 0) a_.out[O_YP] += 10.0f + 89.0f * fa;
    }
#endif
}
}

extern "C" void kernel_launch(void* const* d_in, const int* in_sizes, int n_in, void* d_out, int out_size, void* d_ws, size_t ws_size, hipStream_t stream) {
    using namespace mk;
    static int grid = 0;
    if (grid == 0) {
        if (n_in != 20 || (size_t)out_size != O_END || ws_size < WS_END) { fprintf(stderr, "kernel_launch: unexpected sizes n_in %d out %d ws %zu\n", n_in, out_size, ws_size); grid = -1; return; }
        int dev = 0, cus = 0, per_cu = 0;
        hipGetDevice(&dev); hipDeviceGetAttribute(&cus, hipDeviceAttributeMultiprocessorCount, dev);
        if (hipFuncSetAttribute((const void*)mk_fwd, hipFuncAttributeMaxDynamicSharedMemorySize, LDS_BYTES) != hipSuccess) { fprintf(stderr, "kernel_launch: hipFuncSetAttribute failed\n"); grid = -1; return; }
        if (hipOccupancyMaxActiveBlocksPerMultiprocessor(&per_cu, (const void*)mk_fwd, NT, LDS_BYTES) != hipSuccess || per_cu < 1) { fprintf(stderr, "kernel_launch: occupancy query failed (%d)\n", per_cu); grid = -1; return; }
        if (cus != 256) { fprintf(stderr, "kernel_launch: built for a 256-CU device (got %d)\n", cus); grid = -1; return; }
        grid = cus;
        fprintf(stderr, "kernel_launch: cus %d per_cu %d grid %d\n", cus, per_cu, grid);
    }
    if (grid < 0) return;
    hipMemsetAsync((char*)d_ws + WS_CTL, 0, CTL_BYTES, stream);
    Args a{};
    for (int i = 0; i < 20; ++i) a.in[i] = (const float*)d_in[i];
    a.out = (float*)d_out; a.ws = (unsigned char*)d_ws;
#if MK_SINGLE
    a.ph_lo = 0; a.ph_hi = N_PHASES;
    { void* args[] = {&a}; hipError_t e = hipLaunchCooperativeKernel((const void*)mk_fwd, dim3(grid), dim3(NT), args, LDS_BYTES, stream);
      if (e != hipSuccess) fprintf(stderr, "cooperative launch failed: %s\n", hipGetErrorString(e)); }
#else
    for (int ph = 0; ph < N_PHASES; ++ph) {
        a.ph_lo = ph; a.ph_hi = ph + 1;
        void* args[] = {&a}; hipError_t e = hipLaunchCooperativeKernel((const void*)mk_fwd, dim3(grid), dim3(NT), args, LDS_BYTES, stream);
        if (e != hipSuccess) { fprintf(stderr, "cooperative launch failed: %s\n", hipGetErrorString(e)); break; }
    }
#endif
}
```

```cpp
#include <hip/hip_runtime.h>
#include <hip/hip_cooperative_groups.h>
#include <cstdio>
#include <cstdint>
namespace cg = cooperative_groups;

#ifndef MK_SINGLE
#define MK_SINGLE 1
#endif

namespace mk {
constexpr int NL = 4;
constexpr int D = 1024, NB = 4, LP = 4112, MP = NB * LP, NS = 128, MREAL = MP + NS, MPAD = 16640;
constexpr int NIN = 4368, NINP = 4608, FF = 4096, PST = 4368;
constexpr int C_Q = 0, C_K = 512, C_V = 640, C_GQ = 768, C_GK = 1024, C_GV = 1280, C_GR = 1792, C_GA = 2304, C_GB = 3328, C_GLR = 4352;
constexpr int NCH = 66;
constexpr float ALPHA = 1.6817928305074290f;
constexpr size_t O_YP = 0, O_YS = 16777216, O_KWP = O_YS + 131072, O_VWP = O_KWP + 262144, O_STP = O_VWP + 262144,
                 O_KWS = O_STP + 524288, O_VWS = O_KWS + 8388608, O_STS = O_VWS + 8388608, O_END = O_STS + 16777216;
constexpr size_t MiB = 1u << 20;
constexpr size_t WS_CTL = 0, CTL_BYTES = 384 * 1024  , WS_GB = 65536, WS_ROPE = 384 * 1024, WS_DEC = 1 * MiB, WS_WT = 2 * MiB;
constexpr size_t GB_IN = 0, GB_UP = 2 * 4608, GB_LAYER = 2 * 4608 + 2 * 4096;
static_assert(WS_GB + (size_t)NL * GB_LAYER * 4 <= WS_ROPE, "gb");
constexpr size_t WT_IN = 0, WT_A = (size_t)NINP * 1024, WT_B = WT_A + 1024 * 512, WT_OUT = WT_B + 1024 * 512, WT_UP = WT_OUT + 1024 * 1024,
                 WT_DOWN = WT_UP + (size_t)4096 * 1024, WT_LAYER = WT_DOWN + (size_t)4096 * 1024;
constexpr size_t WS_P = 124 * MiB, WS_X = 263 * MiB, WS_ACT = 329 * MiB, WS_MIXA = 362 * MiB, WS_MIXB = 379 * MiB, WS_PART = 396 * MiB, WS_ST = 412 * MiB  , WS_END = 414 * MiB;
static_assert(WS_WT + WT_LAYER * 2 * NL <= WS_P, "wt");
static_assert(WS_P + (size_t)MPAD * PST * 2 <= WS_X && WS_X + (size_t)MPAD * D * 4 <= WS_ACT && WS_ACT + (size_t)MPAD * D * 2 <= WS_MIXA &&
              WS_MIXA + (size_t)MPAD * 512 * 2 <= WS_MIXB && WS_MIXB + (size_t)MPAD * 512 * 2 <= WS_PART && WS_PART + (size_t)16 * 256 * 1024 * 4 <= WS_ST && WS_ST + (size_t)NL * 2 * MPAD * 2 * 4 <= WS_END, "ws map");
static_assert((size_t)MPAD * FF * 2 <= (size_t)MPAD * PST * 2, "H overlays P");
constexpr int LDS_BYTES = 147456;
}
namespace pg8 {
#define PG8_LAS __attribute__((address_space(3)))
typedef unsigned short bf16_t;
typedef short bf16x8 __attribute__((ext_vector_type(8)));
typedef float f32x4 __attribute__((ext_vector_type(4)));
typedef unsigned u32x4 __attribute__((ext_vector_type(4)));
constexpr int BM = 256, BK = 64, HALF = 128, HTB = HALF * BK * 2  , STAGE_BYTES = 8 * HTB, NXCD = 8, WGM = 8;

__host__ __device__ __forceinline__ int lds_byte(int r, int c) { const int st = (r >> 4) * 2 + (c >> 5), rr = r & 15, cc = c & 31, ob = rr * 64 + cc * 2; return st * 1024 + (ob ^ (((ob >> 9) & 1) << 5)); }
__host__ __device__ __forceinline__ void stage_rc(int b, int& R, int& C) { const int st = b / 1024, sb = b % 1024, swz = sb ^ (((sb >> 9) & 1) << 5); R = (st >> 1) * 16 + swz / 64; C = (st & 1) * 32 + (swz % 64) / 2; }
__host__ __device__ __forceinline__ int perm32(int rho) { const int n = rho >> 4, i = rho & 15; return 8 * (i >> 2) + 4 * n + (i & 3); }

struct Unit { int pm, pn, k0, nt; };
struct Gemm { const bf16_t* A; const bf16_t* Bt; int M, N, K; };

struct StaticOrder {
    int nM, nN, nwg, G, c;
    __host__ __device__ void init(int M, int N, int G_, int c_) { nM = M / BM; nN = N / BM; nwg = nM * nN; G = G_; c = c_; }
    __host__ __device__ bool next(int i, Unit& u) const {
        const long L = (long)i * G + c; if (L >= nwg) return false;
        int wgid = (int)L; { const int q = nwg / NXCD, r = nwg % NXCD, xcd = wgid % NXCD, off = wgid / NXCD; wgid = (xcd < r ? xcd * (q + 1) : r * (q + 1) + (xcd - r) * q) + off; }
        const int nig = WGM * nN, gid = wgid / nig, fm = gid * WGM, gsz = (nM - fm) < WGM ? (nM - fm) : WGM;
        u.pm = fm + ((wgid % nig) % gsz); u.pn = (wgid % nig) / gsz; u.k0 = 0; u.nt = 0; return true;
    }
    __device__ __forceinline__ void a_ready(const Unit&) const {}
    __device__ __forceinline__ void done(const Unit&) const {}
};

struct TailOrder {
    StaticOrder so; int G, c, S, ksz;
    __host__ __device__ void init(int K, int S_, int G_, int c_) { so.init(64 * BM, 1024, G_, c_); G = G_; c = c_; S = S_; ksz = K / S_; }
    __host__ __device__ bool next(int i, Unit& u) const {
        const int nm = (c < so.nwg) ? (so.nwg - 1 - c) / G + 1 : 0;
        if (i < nm) return so.next(i, u);
        if (i > nm || nm != 1) return false;
        Unit um; so.next(0, um); if (um.pm >= S) return false;
        u.pm = 64; u.pn = um.pn; u.k0 = um.pm * ksz; u.nt = ksz / BK; return true;
    }
    __device__ __forceinline__ void a_ready(const Unit&) const {}
    __device__ __forceinline__ void done(const Unit&) const {}
};
__device__ __forceinline__ unsigned cvt_pk_bf16(float lo, float hi) { unsigned r; asm volatile("v_cvt_pk_bf16_f32 %0, %1, %2" : "=v"(r) : "v"(lo), "v"(hi)); return r; }
__device__ __forceinline__ float bflo(unsigned w) { return __uint_as_float(w << 16); }
__device__ __forceinline__ float bfhi(unsigned w) { return __uint_as_float(w & 0xffff0000u); }
__device__ __forceinline__ float sigm(float x) { return 1.0f / (1.0f + __expf(-x)); }
__device__ __forceinline__ u32x4 pack8(const f32x4& v0, const f32x4& v1) { u32x4 w; w.x = cvt_pk_bf16(v0[0], v0[1]); w.y = cvt_pk_bf16(v0[2], v0[3]); w.z = cvt_pk_bf16(v1[0], v1[1]); w.w = cvt_pk_bf16(v1[2], v1[3]); return w; }

typedef float f32x2 __attribute__((ext_vector_type(2)));
__device__ __forceinline__ void row_stats(const float* st, int row, float& mu, float& rstd) {
    mu = 0.f; rstd = 1.f;
    if (st) { const f32x2 s = *(const f32x2*)(st + 2 * (size_t)row); mu = s.x * (1.0f / 1024.0f); const float var = fmaxf(s.y * (1.0f / 1024.0f) - mu * mu, 0.f); rstd = rsqrtf(var + 1e-5f); }
}
constexpr int SPARE = 131072;
__device__ __forceinline__ void pre_dma(PG8_LAS unsigned char* lds, const float* st_rows  , const float* va, const float* vb, int wid, int lane) {
    if (wid == 0 && st_rows) {
        __builtin_amdgcn_global_load_lds((const unsigned*)((const char*)st_rows + lane * 16), (PG8_LAS unsigned*)(lds + SPARE), 16, 0, 0);
        __builtin_amdgcn_global_load_lds((const unsigned*)((const char*)st_rows + 1024 + lane * 16), (PG8_LAS unsigned*)(lds + SPARE + 1024), 16, 0, 0);
    }
    if (wid == 1) __builtin_amdgcn_global_load_lds((const unsigned*)((const char*)va + lane * 16), (PG8_LAS unsigned*)(lds + SPARE + 2048), 16, 0, 0);
    if (wid == 2) __builtin_amdgcn_global_load_lds((const unsigned*)((const char*)vb + lane * 16), (PG8_LAS unsigned*)(lds + SPARE + 3072), 16, 0, 0);
}
__device__ __forceinline__ void lds_row_stats(PG8_LAS unsigned char* lds, bool have, int r  , float& mu, float& rstd) {
    mu = 0.f; rstd = 1.f;
    if (have) { const f32x2 s = *(const PG8_LAS f32x2*)(lds + SPARE + r * 8); mu = s.x * (1.0f / 1024.0f); const float var = fmaxf(s.y * (1.0f / 1024.0f) - mu * mu, 0.f); rstd = rsqrtf(var + 1e-5f); }
}
#define LDS_VECA(c) (*(const PG8_LAS f32x4*)(lds + SPARE + 2048 + (c) * 4))
#define LDS_VECB(c) (*(const PG8_LAS f32x4*)(lds + SPARE + 3072 + (c) * 4))
struct EpiInProj {
    static constexpr bool PERM = true, AFTER_DRAIN = false; static constexpr int MID_T = 0, PRE = 1;
    bf16_t* P; const float* rope; float* out; int layer; const float* st; const float* gW; const float* bW;
    __device__ __forceinline__ void preload(PG8_LAS unsigned char* lds, const Unit& u, int wid, int lane) const {
        if (st) pre_dma(lds, st + 2 * (size_t)u.pm * BM, gW + u.pn * BM, bW + u.pn * BM, wid, lane);
    }
    __device__ __forceinline__ void operator()(const f32x4 (&acc)[2][2][4][2], const Unit& u, int wr, int wc, int fr, int fq, PG8_LAS unsigned char* lds) const {
        using namespace mk;
        int row0 = u.pm * BM + wr * 64 + fr, col0 = u.pn * BM + wc * 32 + 8 * fq, ctw = u.pn * BM + wc * 32;
        asm volatile("" : "+v"(row0), "+v"(col0), "+s"(ctw));
#pragma unroll
        for (int bj = 0; bj < 2; ++bj) {
            const int ct = ctw + bj * HALF;
            const int c0 = col0 + bj * HALF;
#pragma unroll
            for (int ai = 0; ai < 2; ++ai)
#pragma unroll
                for (int m = 0; m < 4; ++m) {
                    const int row = row0 + ai * HALF + m * 16;
                    if ((m & 1) == 0) asm volatile("" ::: "memory");
                    const bool samp = row >= MP;
                    int b = 0, p = 0, pi = LP;
                    if (!samp) { b = row / LP; p = row - b * LP; pi = p; }
                    f32x4 v0 = acc[ai][bj][m][0], v1 = acc[ai][bj][m][1];
                    if (st) { float mu, rstd; lds_row_stats(lds, true, ai * HALF + wr * 64 + m * 16 + fr, mu, rstd); const int cl = bj * HALF + wc * 32 + 8 * fq; const f32x4 g0 = LDS_VECA(cl), g1 = LDS_VECA(cl + 4), b0 = LDS_VECB(cl), b1 = LDS_VECB(cl + 4);
                        v0 = (v0 - g0 * mu) * rstd + b0; v1 = (v1 - g1 * mu) * rstd + b1; }
                    if (ct < C_V && (wc & 1) == 0) {
                        f32x4 p0, p1;
#pragma unroll
                        for (int j = 0; j < 4; ++j) { p0[j] = __shfl_xor(v0[j], 16); p1[j] = __shfl_xor(v1[j], 16); }
                        if (fq < 2) {
                            const f32x4* T = (const f32x4*)(rope + (size_t)pi * 16);
                            const f32x4 c0v = T[0], c1v = T[1], s0v = T[2], s1v = T[3];
                            if (fq == 0) { v0 = v0 * c0v - p0 * s0v; v1 = v1 * c1v - p1 * s1v; }
                            else         { v0 = v0 * c0v + p0 * s0v; v1 = v1 * c1v + p1 * s1v; }
                        }
                    }
                    if (u.pn == 2) {
                        const int cc = c0 - C_K;
                        float* dst = nullptr;
                        if (samp) { if (row < MREAL) dst = out + (cc < 128 ? O_KWS : O_VWS) + ((size_t)(layer * NS + (row - MP)) * 128 + 127) * 128 + (cc & 127); }
                        else if (p >= LP - 128) dst = out + (cc < 128 ? O_KWP : O_VWP) + ((size_t)(layer * NB + b) * 128 + (p - (LP - 128))) * 128 + (cc & 127);
                        if (dst) { *(f32x4*)dst = v0; *(f32x4*)(dst + 4) = v1; }
                    }
                    if (c0 < NIN) *(u32x4*)(P + (size_t)row * PST + c0) = pack8(v0, v1);
                }
        }
    }
};
struct EpiProj {
    static constexpr bool PERM = true, AFTER_DRAIN = false; static constexpr int MID_T = 8, PRE = 0;
    bf16_t* P; bf16_t* O; float* PART;
    __device__ __forceinline__ void mid(f32x4 (&acc)[2][2][4][2], const Unit& u, int wr, int wc, int fr, int fq) const {
        using namespace mk;
        int row0 = u.pm * BM + wr * 64 + fr, col0 = u.pn * BM + wc * 32 + 8 * fq;
        asm volatile("" : "+v"(row0), "+v"(col0));
#pragma unroll
        for (int ai = 0; ai < 2; ++ai)
#pragma unroll
            for (int m = 0; m < 4; ++m) {
                if ((m & 1) == 0) asm volatile("" ::: "memory");
                const int row = row0 + ai * HALF + m * 16;
                const bf16_t* prow = P + (size_t)row * PST;
#pragma unroll
                for (int bj = 0; bj < 2; ++bj) {
                    const int c0 = col0 + bj * HALF;
                    const u32x4 ga = *(const u32x4*)(prow + C_GA + c0), gb = *(const u32x4*)(prow + C_GB + c0);
                    const unsigned gaw[4] = {ga.x, ga.y, ga.z, ga.w}, gbw[4] = {gb.x, gb.y, gb.z, gb.w};
#pragma unroll
                    for (int q = 0; q < 4; ++q) {
                        const float r0 = (1.0f + __expf(-bflo(gbw[q]))) / (1.0f + __expf(-bflo(gaw[q]))), r1 = (1.0f + __expf(-bfhi(gbw[q]))) / (1.0f + __expf(-bfhi(gaw[q])));
                        acc[ai][bj][m][q >> 1][(q & 1) * 2] *= r0; acc[ai][bj][m][q >> 1][(q & 1) * 2 + 1] *= r1;
                    }
                }
            }
    }
    __device__ __forceinline__ void operator()(const f32x4 (&acc)[2][2][4][2], const Unit& u, int wr, int wc, int fr, int fq) const {
        using namespace mk;
        const bool tail = (u.pm == 64); const int gcol = (tail && u.k0 < 512) ? C_GA : C_GB;
#pragma unroll
        for (int ai = 0; ai < 2; ++ai)
#pragma unroll
            for (int m = 0; m < 4; ++m) {
                const int row = u.pm * BM + ai * HALF + wr * 64 + m * 16 + fr;
                const bf16_t* prow = P + (size_t)row * PST;
#pragma unroll
                for (int bj = 0; bj < 2; ++bj) {
                    const int c0 = u.pn * BM + bj * HALF + wc * 32 + 8 * fq;
                    const u32x4 g = *(const u32x4*)(prow + gcol + c0);
                    f32x4 v0 = acc[ai][bj][m][0], v1 = acc[ai][bj][m][1];
                    v0[0] *= sigm(bflo(g.x)); v0[1] *= sigm(bfhi(g.x)); v0[2] *= sigm(bflo(g.y)); v0[3] *= sigm(bfhi(g.y));
                    v1[0] *= sigm(bflo(g.z)); v1[1] *= sigm(bfhi(g.z)); v1[2] *= sigm(bflo(g.w)); v1[3] *= sigm(bfhi(g.w));
                    if (tail) { float* pp = PART + ((size_t)(u.k0 >> 8) * 256 + (row - 64 * BM)) * D + c0; *(f32x4*)pp = v0; *(f32x4*)(pp + 4) = v1; }
                    else *(u32x4*)(O + (size_t)row * D + c0) = pack8(v0, v1);
                }
            }
    }
};
struct EpiResid {
    static constexpr bool PERM = true, AFTER_DRAIN = false; static constexpr int MID_T = 0, PRE = 1;
    float* X; float* PART; int ksz; bf16_t* ACT; const float* stp; const float* gp; const float* bp; float* stc;
    __device__ __forceinline__ void preload(PG8_LAS unsigned char* lds, const Unit& u, int wid, int lane) const {
        if (u.pm != 64) pre_dma(lds, stp ? stp + 2 * (size_t)u.pm * BM : nullptr, gp + u.pn * BM, bp + u.pn * BM, wid, lane);
    }
    __device__ __forceinline__ void operator()(const f32x4 (&acc)[2][2][4][2], const Unit& u, int wr, int wc, int fr, int fq, PG8_LAS unsigned char* lds) const {
        using namespace mk;
        int row0 = u.pm * BM + wr * 64 + fr, col0 = u.pn * BM + wc * 32 + 8 * fq;
        asm volatile("" : "+v"(row0), "+v"(col0));
#pragma unroll
        for (int ai = 0; ai < 2; ++ai)
#pragma unroll
            for (int m = 0; m < 4; ++m) {
                const int rl = ai * HALF + wr * 64 + m * 16 + fr, row = row0 + ai * HALF + m * 16;
                if (u.pm == 64) {
#pragma unroll
                    for (int bj = 0; bj < 2; ++bj) {
                        const int c0 = col0 + bj * HALF;
                        float* pp = PART + ((size_t)(u.k0 / ksz) * 256 + (row - 64 * BM)) * D + c0;
                        *(f32x4*)pp = acc[ai][bj][m][0]; *(f32x4*)(pp + 4) = acc[ai][bj][m][1];
                    }
                } else {
                    float mu, rstd; lds_row_stats(lds, stp != nullptr, rl, mu, rstd);
                    float s = 0.f, q = 0.f;
#pragma unroll
                    for (int bj = 0; bj < 2; ++bj) {
                        const int cl = bj * HALF + wc * 32 + 8 * fq, c0 = col0 + bj * HALF;
                        float* x = X + (size_t)row * D + c0;
                        const f32x4 g0 = LDS_VECA(cl), g1 = LDS_VECA(cl + 4), b0 = LDS_VECB(cl), b1 = LDS_VECB(cl + 4);
                        const f32x4 x0 = *(const f32x4*)x, x1 = *(const f32x4*)(x + 4);
                        const f32x4 z0 = ((x0 - mu) * rstd * g0 + b0) * ALPHA + acc[ai][bj][m][0], z1 = ((x1 - mu) * rstd * g1 + b1) * ALPHA + acc[ai][bj][m][1];
                        *(f32x4*)x = z0; *(f32x4*)(x + 4) = z1;
                        *(u32x4*)(ACT + (size_t)row * D + c0) = pack8(z0, z1);
                        s += (z0[0] + z0[1]) + (z0[2] + z0[3]) + (z1[0] + z1[1]) + (z1[2] + z1[3]);
                        q += (z0[0] * z0[0] + z0[1] * z0[1]) + (z0[2] * z0[2] + z0[3] * z0[3]) + (z1[0] * z1[0] + z1[1] * z1[1]) + (z1[2] * z1[2] + z1[3] * z1[3]);
                    }
                    s += __shfl_xor(s, 16); s += __shfl_xor(s, 32); q += __shfl_xor(q, 16); q += __shfl_xor(q, 32);
                    if (fq == 0) { unsafeAtomicAdd(stc + 2 * (size_t)row, s); unsafeAtomicAdd(stc + 2 * (size_t)row + 1, q); }
                }
            }
    }
};
struct EpiUp {
    static constexpr bool PERM = true, AFTER_DRAIN = false; static constexpr int MID_T = 0, PRE = 1;
    bf16_t* H; const float* st; const float* gW; const float* bW;
    __device__ __forceinline__ void preload(PG8_LAS unsigned char* lds, const Unit& u, int wid, int lane) const { pre_dma(lds, st + 2 * (size_t)u.pm * BM, gW + u.pn * BM, bW + u.pn * BM, wid, lane); }
    __device__ __forceinline__ void operator()(const f32x4 (&acc)[2][2][4][2], const Unit& u, int wr, int wc, int fr, int fq, PG8_LAS unsigned char* lds) const {
        using namespace mk;
        int row0 = u.pm * BM + wr * 64 + fr, col0 = u.pn * BM + wc * 32 + 8 * fq;
        asm volatile("" : "+v"(row0), "+v"(col0));
#pragma unroll
        for (int bj = 0; bj < 2; ++bj) {
            const int cl = bj * HALF + wc * 32 + 8 * fq, c0 = col0 + bj * HALF;
            const f32x4 g0 = LDS_VECA(cl), g1 = LDS_VECA(cl + 4), b0 = LDS_VECB(cl), b1 = LDS_VECB(cl + 4);
#pragma unroll
            for (int ai = 0; ai < 2; ++ai)
#pragma unroll
                for (int m = 0; m < 4; ++m) {
                    const int rl = ai * HALF + wr * 64 + m * 16 + fr, row = row0 + ai * HALF + m * 16;
                    float mu, rstd; lds_row_stats(lds, true, rl, mu, rstd);
                    f32x4 v0 = (acc[ai][bj][m][0] - g0 * mu) * rstd + b0, v1 = (acc[ai][bj][m][1] - g1 * mu) * rstd + b1;
#pragma unroll
                    for (int j = 0; j < 4; ++j) { const float a = fmaxf(v0[j], 0.f), c = fmaxf(v1[j], 0.f); v0[j] = a * a; v1[j] = c * c; }
                    *(u32x4*)(H + (size_t)row * FF + c0) = pack8(v0, v1);
                }
        }
    }
};
template <class Epi, class Sched, bool ALIGN_EPI = false, bool SP2 = false>
__device__ __forceinline__ void gemm_phase(PG8_LAS unsigned char* lds, const Gemm g, const Sched& S, const Epi& E) {
    int tid_ = threadIdx.x; asm volatile("" : "+v"(tid_));
    const int tid = tid_, wid = __builtin_amdgcn_readfirstlane(tid >> 6), lane = tid & 63, wr = wid >> 2, wc = wid & 3, fr = lane & 15, fq = lane >> 4;
    const int K = g.K; int nt = K / BK;
    unsigned voffA[2], voffB[2];
#pragma unroll
    for (int i = 0; i < 2; ++i) { int R, C; stage_rc(tid * 16 + i * 8192, R, C); const int Rb = Epi::PERM ? ((R & ~31) + perm32(R & 31)) : R;
        voffA[i] = (unsigned)(R * K + C) * 2u; voffB[i] = (unsigned)(Rb * K + C) * 2u; }
    const size_t kstep = (size_t)(BK * 2);
    const size_t hstep = (size_t)HALF * K * 2;
    const size_t tstep = 2 * hstep;
    const unsigned ldsw = (unsigned)wid * 1024u;
    const int aoff = lds_byte(wr * 64 + fr, fq * 8), boff = lds_byte(wc * 32 + fr, fq * 8);
#define PG8_SA(b, h) (((b) * 2 + (h)) * HTB)
#define PG8_SB(b, h) ((4 + (b) * 2 + (h)) * HTB)
#define PG8_STAGE(bufoff, gbase, voff) do { _Pragma("unroll") for (int _i = 0; _i < 2; ++_i) \
        __builtin_amdgcn_global_load_lds((const unsigned*)((const char*)(gbase) + (voff)[_i]), (PG8_LAS unsigned*)(lds + (bufoff) + ldsw + _i * 8192), 16, 0, 0); } while (0)
#define PG8_LDA(dst, b, h) do { _Pragma("unroll") for (int m = 0; m < 4; ++m) _Pragma("unroll") for (int k = 0; k < 2; ++k) dst[m][k] = *(const PG8_LAS bf16x8*)(lds + PG8_SA(b, h) + aoff + m * 2048 + k * 1024); } while (0)
#define PG8_LDB(dst, b, h) do { _Pragma("unroll") for (int n = 0; n < 2; ++n) _Pragma("unroll") for (int k = 0; k < 2; ++k) dst[n][k] = *(const PG8_LAS bf16x8*)(lds + PG8_SB(b, h) + boff + n * 2048 + k * 1024); } while (0)
#define PG8_MMA(ai, bj, At, Bt) do { __builtin_amdgcn_s_setprio(1); _Pragma("unroll") for (int m = 0; m < 4; ++m) _Pragma("unroll") for (int n = 0; n < 2; ++n) _Pragma("unroll") for (int k = 0; k < 2; ++k) \
        acc[ai][bj][m][n] = __builtin_amdgcn_mfma_f32_16x16x32_bf16(Bt[n][k], At[m][k], acc[ai][bj][m][n], 0, 0, 0); __builtin_amdgcn_s_setprio(0); } while (0)
#define PG8_WAIT_V(n) asm volatile("s_waitcnt vmcnt(" #n ")" ::: "memory")
#define PG8_WAIT_L(n) asm volatile("s_waitcnt lgkmcnt(" #n ")" ::: "memory")
#define PG8_BAR __builtin_amdgcn_s_barrier()
#define PG8_SCHED __builtin_amdgcn_sched_barrier(0)
    Unit cur, nxt; int ui = 0;
    if (!S.next(0, cur)) return;
    f32x4 acc[2][2][4][2];
#pragma unroll
    for (int a = 0; a < 2; ++a)
#pragma unroll
        for (int b = 0; b < 2; ++b)
#pragma unroll
            for (int m = 0; m < 4; ++m)
#pragma unroll
                for (int n = 0; n < 2; ++n) acc[a][b][m][n] = (f32x4){0.f, 0.f, 0.f, 0.f};
    bf16x8 At[4][2], B0[2][2], B1[2][2];
    const char* cA = (const char*)g.A + (size_t)cur.pm * tstep + (size_t)cur.k0 * 2; const char* cB = (const char*)g.Bt + (size_t)cur.pn * tstep + (size_t)cur.k0 * 2;
    if (cur.nt) nt = cur.nt;
    S.a_ready(cur);
    if constexpr (SP2) {
        PG8_STAGE(PG8_SB(0, 0), cB, voffB); PG8_STAGE(PG8_SB(0, 1), cB + hstep, voffB); PG8_STAGE(PG8_SA(0, 0), cA, voffA); PG8_STAGE(PG8_SA(0, 1), cA + hstep, voffA);
        if (wr == 1) PG8_BAR;
        PG8_WAIT_V(2); PG8_BAR;
        PG8_STAGE(PG8_SB(1, 0), cB + kstep, voffB); PG8_STAGE(PG8_SA(1, 0), cA + kstep, voffA); PG8_STAGE(PG8_SB(1, 1), cB + hstep + kstep, voffB);
        PG8_WAIT_V(6); PG8_BAR;
    } else {
        PG8_STAGE(PG8_SB(0, 0), cB, voffB); PG8_STAGE(PG8_SA(0, 0), cA, voffA); PG8_STAGE(PG8_SB(0, 1), cB + hstep, voffB); PG8_STAGE(PG8_SA(0, 1), cA + hstep, voffA);
        if (wr == 1) PG8_BAR;
        PG8_WAIT_V(4); PG8_BAR;
        PG8_STAGE(PG8_SB(1, 0), cB + kstep, voffB); PG8_STAGE(PG8_SA(1, 0), cA + kstep, voffA); PG8_STAGE(PG8_SB(1, 1), cB + hstep + kstep, voffB);
        PG8_WAIT_V(6); PG8_BAR;
    }
    for (;;) {
        const bool has_next = S.next(ui + 1, nxt);
        const char* nA = has_next ? (const char*)g.A + (size_t)nxt.pm * tstep + (size_t)nxt.k0 * 2 : cA; const char* nB = has_next ? (const char*)g.Bt + (size_t)nxt.pn * tstep + (size_t)nxt.k0 * 2 : cB;
        for (int t = 0; t < nt; t += 2) {
            if constexpr (Epi::MID_T > 0) { if (t == Epi::MID_T && nt > Epi::MID_T) E.mid(acc, cur, wr, wc, fr, fq); }
            const bool last = (t == nt - 2);
            const char* a1 = cA + (size_t)(t + 1) * kstep;
            const char* a2 = last ? nA : cA + (size_t)(t + 2) * kstep; const char* b2 = last ? nB : cB + (size_t)(t + 2) * kstep;
            const char* a3 = a2 + kstep; const char* b3 = b2 + kstep;
            if (last && has_next) S.a_ready(nxt);
            if constexpr (Epi::PRE) { if (last) E.preload(lds, cur, wid, lane); }
            if constexpr (SP2) {
            PG8_LDB(B0, 0, 0); PG8_LDB(B1, 0, 1); PG8_SCHED; PG8_LDA(At, 0, 0); PG8_STAGE(PG8_SA(1, 1), a1 + hstep, voffA);
            PG8_WAIT_V(8); PG8_WAIT_L(0); PG8_BAR; PG8_MMA(0, 0, At, B0); PG8_MMA(0, 1, At, B1); PG8_BAR; PG8_SCHED;
            PG8_LDA(At, 0, 1); PG8_STAGE(PG8_SB(0, 0), b2, voffB); PG8_STAGE(PG8_SB(0, 1), b2 + hstep, voffB); PG8_STAGE(PG8_SA(0, 0), a2, voffA);
            PG8_WAIT_V(8); PG8_WAIT_L(0); PG8_BAR; PG8_MMA(1, 0, At, B0); PG8_MMA(1, 1, At, B1); PG8_BAR; PG8_SCHED;
            PG8_LDB(B0, 1, 0); PG8_LDB(B1, 1, 1); PG8_SCHED; PG8_LDA(At, 1, 0); PG8_STAGE(PG8_SA(0, 1), a2 + hstep, voffA);
            PG8_WAIT_V(8); PG8_WAIT_L(0); PG8_BAR; PG8_MMA(0, 0, At, B0); PG8_MMA(0, 1, At, B1); PG8_BAR; PG8_SCHED;
            PG8_LDA(At, 1, 1); PG8_STAGE(PG8_SB(1, 0), b3, voffB); PG8_STAGE(PG8_SB(1, 1), b3 + hstep, voffB); PG8_STAGE(PG8_SA(1, 0), a3, voffA);
            PG8_WAIT_V(8); PG8_WAIT_L(0); PG8_BAR; PG8_MMA(1, 0, At, B0); PG8_MMA(1, 1, At, B1); PG8_BAR; PG8_SCHED;
            } else {
            PG8_LDB(B0, 0, 0); PG8_SCHED; PG8_LDA(At, 0, 0); PG8_STAGE(PG8_SA(1, 1), a1 + hstep, voffA);
            PG8_WAIT_L(8); PG8_BAR; PG8_WAIT_L(0); PG8_MMA(0, 0, At, B0); PG8_BAR; PG8_SCHED;
            PG8_LDB(B1, 0, 1); PG8_STAGE(PG8_SB(0, 0), b2, voffB);
            PG8_BAR; PG8_WAIT_L(0); PG8_MMA(0, 1, At, B1); PG8_BAR;
            PG8_LDA(At, 0, 1); PG8_STAGE(PG8_SA(0, 0), a2, voffA);
            PG8_BAR; PG8_WAIT_L(0); PG8_MMA(1, 0, At, B0); PG8_BAR; PG8_SCHED;
            PG8_STAGE(PG8_SB(0, 1), b2 + hstep, voffB);
            PG8_WAIT_V(6); PG8_BAR; PG8_MMA(1, 1, At, B1); PG8_BAR;
            PG8_LDB(B0, 1, 0); PG8_SCHED; PG8_LDA(At, 1, 0); PG8_STAGE(PG8_SA(0, 1), a2 + hstep, voffA);
            PG8_WAIT_L(8); PG8_BAR; PG8_WAIT_L(0); PG8_MMA(0, 0, At, B0); PG8_BAR; PG8_SCHED;
            PG8_LDB(B1, 1, 1); PG8_STAGE(PG8_SB(1, 0), b3, voffB);
            PG8_BAR; PG8_WAIT_L(0); PG8_MMA(0, 1, At, B1); PG8_BAR;
            PG8_LDA(At, 1, 1); PG8_STAGE(PG8_SA(1, 0), a3, voffA);
            PG8_BAR; PG8_WAIT_L(0); PG8_MMA(1, 0, At, B0); PG8_BAR; PG8_SCHED;
            PG8_STAGE(PG8_SB(1, 1), b3 + hstep, voffB);
            PG8_WAIT_V(6); PG8_BAR; PG8_MMA(1, 1, At, B1); PG8_BAR;
            }
        }
        if constexpr (ALIGN_EPI) { if (wr == 0) PG8_BAR; }
        if constexpr (!Epi::AFTER_DRAIN) { if constexpr (Epi::PRE) E(acc, cur, wr, wc, fr, fq, lds); else E(acc, cur, wr, wc, fr, fq); S.done(cur); }
        if (!has_next) break;
#pragma unroll
        for (int a = 0; a < 2; ++a)
#pragma unroll
            for (int b = 0; b < 2; ++b)
#pragma unroll
                for (int m = 0; m < 4; ++m)
#pragma unroll
                    for (int n = 0; n < 2; ++n) acc[a][b][m][n] = (f32x4){0.f, 0.f, 0.f, 0.f};
        cur = nxt; cA = nA; cB = nB; ++ui; nt = cur.nt ? cur.nt : K / BK;
        if constexpr (ALIGN_EPI) { if (wr == 1) PG8_BAR; }
    }
    PG8_WAIT_V(0);
    if constexpr (!ALIGN_EPI) { if (wr == 0) PG8_BAR; }
    PG8_BAR;
    if constexpr (Epi::AFTER_DRAIN) { E.fused(acc, cur, wr, wc, fr, fq, lds, wid, lane); S.done(cur); }
#undef PG8_SA
#undef PG8_SB
#undef PG8_STAGE
#undef PG8_LDA
#undef PG8_LDB
#undef PG8_MMA
#undef PG8_WAIT_V
#undef PG8_WAIT_L
#undef PG8_BAR
#undef PG8_SCHED
}
}

#define LAS __attribute__((address_space(3)))
namespace mk {
typedef unsigned short bf16;
typedef unsigned u32x4 __attribute__((ext_vector_type(4)));
typedef unsigned u32x2 __attribute__((ext_vector_type(2)));
typedef float f32x4 __attribute__((ext_vector_type(4)));
typedef short bf16x8 __attribute__((ext_vector_type(8)));
constexpr int NT = 512;

__device__ __forceinline__ unsigned f2bf(float f) { unsigned u = __builtin_bit_cast(unsigned, f); return (u + 0x7fffu + ((u >> 16) & 1u)) >> 16; }
__device__ __forceinline__ unsigned pk2(float lo, float hi) { return f2bf(lo) | (f2bf(hi) << 16); }
__device__ __forceinline__ float bf2f(unsigned h) { return __uint_as_float(h << 16); }
__device__ __forceinline__ float bflo(unsigned w) { return __uint_as_float(w << 16); }
__device__ __forceinline__ float bfhi(unsigned w) { return __uint_as_float(w & 0xffff0000u); }
__device__ __forceinline__ float wave_sum(float v) {
#pragma unroll
    for (int o = 1; o < 64; o <<= 1) v += __shfl_xor(v, o);
    return v;
}
__device__ __forceinline__ float wave_max(float v) {
#pragma unroll
    for (int o = 1; o < 64; o <<= 1) v = fmaxf(v, __shfl_xor(v, o));
    return v;
}
__device__ __forceinline__ float logsig(float x) { return fminf(x, 0.f) - __logf(1.0f + __expf(-fabsf(x))); }

#ifdef MK_SECT
#define PT(i) do { if (tid == 0) { LAS unsigned long long* pt_ = (LAS unsigned long long*)(lds + LDS_BYTES - 256); const unsigned long long n_ = __builtin_amdgcn_s_memrealtime(); pt_[1 + (i)] += n_ - pt_[0]; pt_[0] = n_; } } while (0)
#define PT_RESET() do { if (tid == 0) { ((LAS unsigned long long*)(lds + LDS_BYTES - 256))[0] = __builtin_amdgcn_s_memrealtime(); } } while (0)
#else
#define PT(i) do { } while (0)
#define PT_RESET() do { } while (0)
#endif
struct Args { const float* in[20]; float* out; unsigned char* ws; int ph_lo, ph_hi; };

__device__ __forceinline__ const float* kin(int k) {
#if defined(__HIP_DEVICE_COMPILE__)
    const __attribute__((address_space(4))) Args* ap = (const __attribute__((address_space(4))) Args*)__builtin_amdgcn_kernarg_segment_ptr();
    asm volatile("" : "+s"(ap));
    return ap->in[k];
#else
    return nullptr;
#endif
}
__device__ __forceinline__ int win_dst(int n) { return n < 1792 ? n : (n < 1808 ? C_GLR + (n - 1792) : n - 16); }
template <bool MAP>
__device__ __forceinline__ void transpose_item(const float* W, int K, int N, bf16* WT, LAS float* scr, int item, int lane, int ldk = 0,
                                               const float* gs = nullptr, const float* bs = nullptr, float* gW = nullptr, float* bW = nullptr) {
    if (ldk == 0) ldk = K;
    const int nblk = (N + 31) / 32, kb = item / nblk, nb = item % nblk, k0 = 64 * kb, n0 = 32 * nb;
    const int ncol = n0 + (lane & 31);
    float wv[32];
    const float* wp = W + (size_t)(k0 + (lane >> 5)) * N + (ncol < N ? ncol : N - 1);
#pragma unroll
    for (int i = 0; i < 32; ++i) wv[i] = wp[(size_t)(2 * i) * N];
    if (gW) {
        float sg = 0.f, sb = 0.f;
#pragma unroll
        for (int i = 0; i < 32; ++i) { const int k = k0 + 2 * i + (lane >> 5); const float gk = gs[k]; sb += bs[k] * wv[i]; wv[i] *= gk; sg += wv[i]; }
        sg += __shfl_xor(sg, 32); sb += __shfl_xor(sb, 32);
        if (lane < 32 && ncol < N) { const int nd = MAP ? win_dst(ncol) : ncol; unsafeAtomicAdd(gW + nd, sg); unsafeAtomicAdd(bW + nd, sb); }
    }
#pragma unroll
    for (int i = 0; i < 32; ++i) { const int kk = 2 * i + (lane >> 5); scr[kk * 33 + (lane & 31)] = (ncol < N) ? wv[i] : 0.f; }
    asm volatile("s_waitcnt lgkmcnt(0)" ::: "memory");
    const int c = lane & 7;
#pragma unroll
    for (int j = 0; j < 4; ++j) { const int n = (lane >> 3) + 8 * j; const LAS float* s = scr + (8 * c) * 33 + n;
        u32x4 o; o.x = pk2(s[0 * 33], s[1 * 33]); o.y = pk2(s[2 * 33], s[3 * 33]); o.z = pk2(s[4 * 33], s[5 * 33]); o.w = pk2(s[6 * 33], s[7 * 33]);
        const int nsrc = n0 + n;
        if (nsrc < N) { const int nd = MAP ? win_dst(nsrc) : nsrc; *(u32x4*)(WT + (size_t)nd * ldk + k0 + 8 * c) = o; } }
    asm volatile("s_waitcnt lgkmcnt(0)" ::: "memory");
}

__device__ __forceinline__ void p0_prologue(const Args& a, LAS unsigned char* lds, int tid) {
    const int lane = tid & 63, wave = tid >> 6;
    const int gw = blockIdx.x * 8 + wave, NGW = gridDim.x * 8;
    LAS float* scr = (LAS float*)(lds + wave * 16384);
    bf16* WTb = (bf16*)(a.ws + WS_WT);
    constexpr int I_IN = 16 * 137, I_A = 8 * 32, I_O = 16 * 32, I_U = 16 * 128, I_D = 64 * 32, I_L = I_IN + 2 * I_A + I_O + I_U + I_D;
    for (int it = gw; it < NL * I_L; it += NGW) {
        const int l = it / I_L; int r = it - l * I_L; bf16* wt = WTb + (size_t)l * WT_LAYER;
        float* gb = (float*)(a.ws + WS_GB) + (size_t)l * GB_LAYER;
        if (r < I_IN) { if (l == 0) transpose_item<true>(kin(6), 1024, NIN, wt + WT_IN, scr, r, lane);
                        else transpose_item<true>(kin(6) + (size_t)l * 1024 * NIN, 1024, NIN, wt + WT_IN, scr, r, lane, 0, kin(18) + (l - 1) * D, kin(19) + (l - 1) * D, gb + GB_IN, gb + GB_IN + 4608);
                        continue; } r -= I_IN;
        if (r < I_A) { transpose_item<false>(kin(11) + (size_t)l * 512 * 1024, 512, 1024, wt + WT_A, scr, r, lane, 1024); continue; } r -= I_A;
        if (r < I_A) { transpose_item<false>(kin(12) + (size_t)l * 512 * 1024, 512, 1024, wt + WT_A + 512, scr, r, lane, 1024); continue; } r -= I_A;
        if (r < I_O) { transpose_item<false>(kin(13) + (size_t)l * 1024 * 1024, 1024, 1024, wt + WT_OUT, scr, r, lane); continue; } r -= I_O;
        if (r < I_U) { transpose_item<false>(kin(16) + (size_t)l * 1024 * 4096, 1024, 4096, wt + WT_UP, scr, r, lane, 0, kin(14) + l * D, kin(15) + l * D, gb + GB_UP, gb + GB_UP + 4096); continue; } r -= I_U;
        transpose_item<false>(kin(17) + (size_t)l * 4096 * 1024, 4096, 1024, wt + WT_DOWN, scr, r, lane);
    }
    {
        f32x4* st4 = (f32x4*)(a.ws + WS_ST);
        for (int i = blockIdx.x * NT + tid; i < NL * 2 * MPAD * 2 / 4; i += gridDim.x * NT) st4[i] = (f32x4){0.f, 0.f, 0.f, 0.f};
    }
    float* rope = (float*)(a.ws + WS_ROPE);
    for (int i = blockIdx.x * NT + tid; i < (LP + 1) * 8; i += gridDim.x * NT) {
        const int pi = i >> 3, f = i & 7; const float pos = (pi == LP) ? 8192.f : (float)pi;
        const float inv = powf(500000.0f, -(float)f * 0.125f);
        const float ang = pos * inv;
        const double rev = (double)ang * 0.15915494309189535; const float fr = (float)(rev - rint(rev));
        rope[pi * 16 + f] = __builtin_amdgcn_cosf(fr); rope[pi * 16 + 8 + f] = __builtin_amdgcn_sinf(fr);
    }
    for (int i = blockIdx.x * NT + tid; i < 2 * D; i += gridDim.x * NT) rope[(LP + 1) * 16 + i] = (i < D) ? 1.0f : 0.0f;
    float* X = (float*)(a.ws + WS_X); bf16* ACT = (bf16*)(a.ws + WS_ACT);
    for (int row0 = gw; row0 < MPAD; row0 += 4 * NGW) {
        f32x4 v[4][4];
#pragma unroll
        for (int u = 0; u < 4; ++u) {
            const int row = row0 + u * NGW; const float* src = nullptr;
            if (row < MP) { const int b = row / LP, p = row - b * LP; src = (p < 16) ? kin(5) + (size_t)p * D : kin(0) + ((size_t)b * 4096 + (p - 16)) * D; }
            else if (row < MREAL) src = kin(1) + (size_t)(row - MP) * D;
#pragma unroll
            for (int j = 0; j < 4; ++j) v[u][j] = src ? *((const f32x4*)src + lane + 64 * j) : (f32x4){0.f, 0.f, 0.f, 0.f};
        }
#pragma unroll
        for (int u = 0; u < 4; ++u) {
            const int row = row0 + u * NGW; if (row >= MPAD) continue;
#pragma unroll
            for (int j = 0; j < 4; ++j) {
                *((f32x4*)(X + (size_t)row * D) + lane + 64 * j) = v[u][j];
                u32x2 w; w.x = pk2(v[u][j].x, v[u][j].y); w.y = pk2(v[u][j].z, v[u][j].w);
                *((u32x2*)(ACT + (size_t)row * D) + lane + 64 * j) = w;
            }
        }
    }
}

__device__ __forceinline__ void ln_pair(const Args& a, const f32x4 (&gv)[4], const f32x4 (&bv)[4], bool last, int nsplit, int row0, int row1, bool has1, int lane) {
    float* X = (float*)(a.ws + WS_X); bf16* ACT = (bf16*)(a.ws + WS_ACT);
    f32x4 v[2][4];
#pragma unroll
    for (int j = 0; j < 4; ++j) { v[0][j] = *((const f32x4*)(X + (size_t)row0 * D) + lane + 64 * j); v[1][j] = has1 ? *((const f32x4*)(X + (size_t)row1 * D) + lane + 64 * j) : (f32x4){0.f, 0.f, 0.f, 0.f}; }
    if (row0 >= 64 * 256 || (has1 && row1 >= 64 * 256)) {
        const float* PART = (const float*)(a.ws + WS_PART);
        for (int s = 0; s < nsplit; ++s) {
#pragma unroll
            for (int j = 0; j < 4; ++j) {
                if (row0 >= 64 * 256) v[0][j] += *((const f32x4*)(PART + ((size_t)s * 256 + (row0 - 64 * 256)) * D) + lane + 64 * j);
                if (has1 && row1 >= 64 * 256) v[1][j] += *((const f32x4*)(PART + ((size_t)s * 256 + (row1 - 64 * 256)) * D) + lane + 64 * j);
            }
        }
    }
#pragma unroll
    for (int u = 0; u < 2; ++u) {
        const int row = u ? row1 : row0;
        float s = 0.f;
#pragma unroll
        for (int j = 0; j < 4; ++j) s += (v[u][j].x + v[u][j].y) + (v[u][j].z + v[u][j].w);
        const float mean = wave_sum(s) * (1.f / D); float s2 = 0.f;
#pragma unroll
        for (int j = 0; j < 4; ++j) { v[u][j] = v[u][j] - mean; s2 += (v[u][j].x * v[u][j].x + v[u][j].y * v[u][j].y) + (v[u][j].z * v[u][j].z + v[u][j].w * v[u][j].w); }
        const float rstd = 1.f / sqrtf(wave_sum(s2) * (1.f / D) + 1e-5f);
        if (u == 1 && !has1) continue;
        float* yo = nullptr;
        if (last) { if (row >= MP) yo = a.out + O_YS + (size_t)(row - MP) * D; else { const int b = row / LP, p = row - b * LP; if (p >= 16) yo = a.out + O_YP + ((size_t)b * 4096 + (p - 16)) * D; } }
#pragma unroll
        for (int j = 0; j < 4; ++j) {
            const f32x4 o = v[u][j] * rstd * gv[j] + bv[j];
            if (last) { if (yo) *((f32x4*)yo + lane + 64 * j) = o; }
            else { *((f32x4*)(X + (size_t)row * D) + lane + 64 * j) = o * ALPHA; u32x2 w; w.x = pk2(o.x, o.y); w.y = pk2(o.z, o.w); *((u32x2*)(ACT + (size_t)row * D) + lane + 64 * j) = w; }
        }
    }
}
__device__ __forceinline__ void ln_phase(const Args& a, const float* g, const float* bt, bool last, int nsplit, int tid) {
    const int lane = tid & 63, wave = tid >> 6;
    const int gw = blockIdx.x * 8 + wave, NGW = gridDim.x * 8;
    f32x4 gv[4], bv[4];
#pragma unroll
    for (int j = 0; j < 4; ++j) { gv[j] = *((const f32x4*)g + lane + 64 * j); bv[j] = *((const f32x4*)bt + lane + 64 * j); }
#pragma unroll 2
    for (int row0 = gw; row0 < MREAL; row0 += 2 * NGW) ln_pair(a, gv, bv, last, nsplit, row0, row0 + NGW, row0 + NGW < MREAL, lane);
}
__device__ __forceinline__ void ln_tail(const Args& a, const float* stp, const float* gp, const float* bp, float* stc, int nsplit, int tid) {
    const int lane = tid & 63, r = blockIdx.x * 8 + (tid >> 6);
    if (r >= MREAL - 64 * 256) return;
    const int row = 64 * 256 + r;
    float* X = (float*)(a.ws + WS_X); bf16* ACT = (bf16*)(a.ws + WS_ACT); const float* PART = (const float*)(a.ws + WS_PART);
    float mu = 0.f, rstd = 1.f;
    if (stp) { const float s = stp[2 * (size_t)row], q = stp[2 * (size_t)row + 1]; mu = s * (1.0f / 1024.0f); rstd = rsqrtf(fmaxf(q * (1.0f / 1024.0f) - mu * mu, 0.f) + 1e-5f); }
    float s = 0.f, q = 0.f;
#pragma unroll
    for (int j = 0; j < 4; ++j) {
        const f32x4 x = *((const f32x4*)(X + (size_t)row * D) + lane + 64 * j), g = *((const f32x4*)gp + lane + 64 * j), b = *((const f32x4*)bp + lane + 64 * j);
        f32x4 z = ((x - mu) * rstd * g + b) * ALPHA;
        for (int sp = 0; sp < nsplit; ++sp) z += *((const f32x4*)(PART + ((size_t)sp * 256 + r) * D) + lane + 64 * j);
        *((f32x4*)(X + (size_t)row * D) + lane + 64 * j) = z;
        u32x2 w; w.x = pk2(z.x, z.y); w.y = pk2(z.z, z.w); *((u32x2*)(ACT + (size_t)row * D) + lane + 64 * j) = w;
        s += (z.x + z.y) + (z.z + z.w); q += (z.x * z.x + z.y * z.y) + (z.z * z.z + z.w * z.w);
    }
    s = wave_sum(s); q = wave_sum(q);
    if (lane == 0) { stc[2 * (size_t)row] = s; stc[2 * (size_t)row + 1] = q; }
}
__device__ __forceinline__ void wait_count(unsigned* p, unsigned need, int tid) {
    if (tid < 64) {
        const unsigned long long t0 = __builtin_amdgcn_s_memrealtime();
        while ((unsigned)__builtin_amdgcn_readfirstlane(__hip_atomic_load(p, __ATOMIC_RELAXED, __HIP_MEMORY_SCOPE_AGENT)) < need) {
            if (__builtin_amdgcn_s_memrealtime() - t0 > 2000000ull) break;
            __builtin_amdgcn_s_sleep(2);
        }
        __builtin_amdgcn_fence(__ATOMIC_ACQUIRE, "agent");
        asm volatile("s_waitcnt vmcnt(0)" ::: "memory");
    }
    __syncthreads();
}
__device__ __forceinline__ void ln_exchange(const Args& a, unsigned* cnt, int cu, int S, const float* g, const float* bt, bool last, int tid) {
    const int lane = tid & 63, wave = tid >> 6;
    pg8::StaticOrder so; so.init(64 * 256, 1024, (int)gridDim.x, cu); pg8::Unit um; so.next(0, um);
    const bool has_tail = um.pm < S;
    asm volatile("s_waitcnt vmcnt(0)" ::: "memory");
    __syncthreads();
    if (tid == 0) {
        __builtin_amdgcn_fence(__ATOMIC_RELEASE, "agent");
        asm volatile("s_waitcnt vmcnt(0)" ::: "memory");
        __hip_atomic_fetch_add(cnt + 64 * um.pm, 1u, __ATOMIC_RELAXED, __HIP_MEMORY_SCOPE_AGENT);
        if (has_tail) __hip_atomic_fetch_add(cnt + 64 * 64, 1u, __ATOMIC_RELAXED, __HIP_MEMORY_SCOPE_AGENT);
    }
    f32x4 gv[4], bv[4];
#pragma unroll
    for (int j = 0; j < 4; ++j) { gv[j] = *((const f32x4*)g + lane + 64 * j); bv[j] = *((const f32x4*)bt + lane + 64 * j); }
    wait_count(cnt + 64 * um.pm, 4u, tid);
    const int rbase = um.pm * 256 + um.pn * 64 + wave;
#pragma unroll 1
    for (int i = 0; i < 8; i += 2) ln_pair(a, gv, bv, last, 0, rbase + 8 * i, rbase + 8 * i + 8, true, lane);
    if (has_tail) {
        wait_count(cnt + 64 * 64, 4u * (unsigned)S, tid);
        const int L = um.pm * 4 + um.pn, r = L + 4 * S * wave;
        if (r < MREAL - 64 * 256) ln_pair(a, gv, bv, last, S, 64 * 256 + r, 0, false, lane);
    }
}

__device__ __forceinline__ void attn_item(LAS unsigned char* lds, const bf16* P, bf16* MIXA, float sink, int b, int n, int h, int tid) {
    LAS bf16* Ks = (LAS bf16*)lds;
    LAS bf16* Vt = (LAS bf16*)(lds + 36864);
    const int kvh = h >> 2, lane = tid & 63, w = tid >> 6, fr = lane & 15, fq = lane >> 4;
    for (int i = tid; i < 64 * 24; i += NT) Vt[(i / 24) * 280 + 256 + (i % 24)] = 0;
#pragma unroll
    for (int i = 0; i < 4; ++i) {
        const int q = tid + NT * i, key = q >> 3, part = q & 7, slot = (n - 1) * 128 + key;
        const bf16* src = P + (size_t)(b * LP + (slot >= 112 ? slot - 112 : 0)) * PST;
        u32x4 kv = *(const u32x4*)(src + C_K + kvh * 64 + part * 8), vv = *(const u32x4*)(src + C_V + kvh * 64 + part * 8);
        if (slot < 112) { kv = (u32x4){0u, 0u, 0u, 0u}; vv = (u32x4){0u, 0u, 0u, 0u}; }
        *(LAS u32x4*)(Ks + key * 72 + part * 8) = kv;
        LAS bf16* vd = Vt + (part * 8) * 280 + key;
        vd[0 * 280] = (bf16)(vv.x & 0xffffu); vd[1 * 280] = (bf16)(vv.x >> 16); vd[2 * 280] = (bf16)(vv.y & 0xffffu); vd[3 * 280] = (bf16)(vv.y >> 16);
        vd[4 * 280] = (bf16)(vv.z & 0xffffu); vd[5 * 280] = (bf16)(vv.z >> 16); vd[6 * 280] = (bf16)(vv.w & 0xffffu); vd[7 * 280] = (bf16)(vv.w >> 16);
    }
    const int qi = 16 * w + fr, slotq = n * 128 + qi; const bool qv = slotq >= 112;
    const size_t qrow = (size_t)(b * LP + (qv ? slotq - 112 : 0));
    bf16x8 qf[2];
#pragma unroll
    for (int kk = 0; kk < 2; ++kk) { qf[kk] = *(const bf16x8*)(P + qrow * PST + h * 64 + kk * 32 + 8 * fq); if (!qv) qf[kk] = (bf16x8){0, 0, 0, 0, 0, 0, 0, 0}; }
    __syncthreads();
    f32x4 s[9];
#pragma unroll
    for (int r = 0; r < 9; ++r) {
        f32x4 acc = (f32x4){0.f, 0.f, 0.f, 0.f};
#pragma unroll
        for (int kk = 0; kk < 2; ++kk) { const bf16x8 kf = *(const LAS bf16x8*)(Ks + ((w + r) * 16 + fr) * 72 + kk * 32 + 8 * fq); acc = __builtin_amdgcn_mfma_f32_16x16x32_bf16(kf, qf[kk], acc, 0, 0, 0); }
        s[r] = acc;
    }
    float mx = sink;
#pragma unroll
    for (int r = 0; r < 9; ++r)
#pragma unroll
        for (int j = 0; j < 4; ++j) {
            const int dl = 16 * r + 4 * fq + j - fr, slotk = (n - 1) * 128 + 16 * (w + r) + 4 * fq + j;
            const bool ok = dl > 0 && dl <= 128 && slotk >= 112;
            const float v = ok ? s[r][j] * 0.125f : -INFINITY; s[r][j] = v; mx = fmaxf(mx, v);
        }
    mx = fmaxf(mx, __shfl_xor(mx, 16)); mx = fmaxf(mx, __shfl_xor(mx, 32));
    float sum = 0.f;
#pragma unroll
    for (int r = 0; r < 9; ++r)
#pragma unroll
        for (int j = 0; j < 4; ++j) { const float p = __expf(s[r][j] - mx); s[r][j] = p; sum += p; }
    sum += __shfl_xor(sum, 16); sum += __shfl_xor(sum, 32);
    const float rden = 1.0f / (sum + __expf(sink - mx));
    f32x4 o[4];
#pragma unroll
    for (int dt = 0; dt < 4; ++dt) o[dt] = (f32x4){0.f, 0.f, 0.f, 0.f};
#pragma unroll
    for (int ks = 0; ks < 5; ++ks) {
        u32x4 pw; pw.x = pk2(s[2 * ks][0], s[2 * ks][1]); pw.y = pk2(s[2 * ks][2], s[2 * ks][3]);
        if (ks < 4) { pw.z = pk2(s[2 * ks + 1 > 8 ? 8 : 2 * ks + 1][0], s[2 * ks + 1 > 8 ? 8 : 2 * ks + 1][1]); pw.w = pk2(s[2 * ks + 1 > 8 ? 8 : 2 * ks + 1][2], s[2 * ks + 1 > 8 ? 8 : 2 * ks + 1][3]); }
        else { pw.z = 0u; pw.w = 0u; }
        const bf16x8 pf = __builtin_bit_cast(bf16x8, pw);
        const int keyb = 16 * (w + 2 * ks) + 4 * fq;
#pragma unroll
        for (int dt = 0; dt < 4; ++dt) {
            const LAS bf16* vp = Vt + (dt * 16 + fr) * 280 + keyb;
            const u32x2 lo = *(const LAS u32x2*)vp, hi = *(const LAS u32x2*)(vp + 16);
            u32x4 vw; vw.x = lo.x; vw.y = lo.y; vw.z = hi.x; vw.w = hi.y;
            o[dt] = __builtin_amdgcn_mfma_f32_16x16x32_bf16(__builtin_bit_cast(bf16x8, vw), pf, o[dt], 0, 0, 0);
        }
    }
    if (qv) {
#pragma unroll
        for (int dt = 0; dt < 4; ++dt) { u32x2 w2; w2.x = pk2(o[dt][0] * rden, o[dt][1] * rden); w2.y = pk2(o[dt][2] * rden, o[dt][3] * rden);
            *(u32x2*)(MIXA + qrow * 1024 + h * 64 + dt * 16 + 4 * fq) = w2; }
    }
}

__device__ __forceinline__ void sattn_item(LAS unsigned char* lds, const Args& a, int layer, int s, int tid) {
    LAS float* Kf = (LAS float*)lds;
    LAS float* Vf = Kf + 16384;
    LAS float* qs = Vf + 16384;
    LAS float* ps = qs + 512;
    const bf16* P = (const bf16*)(a.ws + WS_P);
    bf16* MIXA = (bf16*)(a.ws + WS_MIXA);
    const float* ck = kin(2) + (size_t)(layer * NS + s) * 16384; const float* cv = kin(3) + (size_t)(layer * NS + s) * 16384;
    float* ok = a.out + O_KWS + (size_t)(layer * NS + s) * 16384; float* ov = a.out + O_VWS + (size_t)(layer * NS + s) * 16384;
    for (int f4 = tid; f4 < 128 * 32; f4 += NT) {
        const int f = f4 * 4, r = f >> 7, rem = f & 127, li = (rem >> 6) * 8192 + r * 64 + (rem & 63);
        f32x4 kv, vv;
        if (r < 127) { kv = *(const f32x4*)(ck + 128 + f); vv = *(const f32x4*)(cv + 128 + f); *(f32x4*)(ok + f) = kv; *(f32x4*)(ov + f) = vv; }
        else { kv = *(const f32x4*)(ok + f); vv = *(const f32x4*)(ov + f); }
        *(LAS f32x4*)(Kf + li) = kv; *(LAS f32x4*)(Vf + li) = vv;
    }
    const int row = MP + s, h = tid >> 6, lane = tid & 63, kvh = h >> 2;
    qs[tid] = bf2f(P[(size_t)row * PST + tid]);
    __syncthreads();
    const float sink = kin(9)[layer * 8 + h];
    float s0 = 0.f, s1 = 0.f;
    const LAS float* k0 = Kf + kvh * 8192 + lane * 64; const LAS float* k1 = k0 + 64 * 64;
#pragma unroll 8
    for (int d = 0; d < 64; ++d) { const int dd = (d + lane) & 63; const float q = qs[h * 64 + dd]; s0 += q * k0[dd]; s1 += q * k1[dd]; }
    s0 *= 0.125f; s1 *= 0.125f;
    const float mx = fmaxf(wave_max(fmaxf(s0, s1)), sink);
    const float p0 = __expf(s0 - mx), p1 = __expf(s1 - mx);
    const float rden = 1.0f / (wave_sum(p0 + p1) + __expf(sink - mx));
    ps[h * 128 + lane] = p0; ps[h * 128 + 64 + lane] = p1;
    __syncthreads();
    float o = 0.f;
    const LAS float* vb = Vf + kvh * 8192 + lane;
#pragma unroll 8
    for (int r = 0; r < 128; ++r) o += ps[h * 128 + r] * vb[r * 64];
    MIXA[(size_t)row * 1024 + tid] = (bf16)f2bf(o * rden);
}

__device__ __forceinline__ void gla_prep(LAS float* tot, const Args& a, int layer, int h, int rowbase  , int tvalid0, int tid, float (&cum)[8]) {
    const bf16* P = (const bf16*)(a.ws + WS_P);
    const int d = tid & 63, tg = tid >> 6;
    float wa[16];
#pragma unroll
    for (int r = 0; r < 16; ++r) wa[r] = kin(7)[(size_t)(layer * 16 + r) * 256 + h * 64 + d];
    const float ba = kin(8)[layer * 256 + h * 64 + d];
    float run = 0.f;
    u32x4 g0a[8], g1a[8];
#pragma unroll
    for (int i = 0; i < 8; ++i) { const int t = tg * 8 + i; const u32x4* gp = (const u32x4*)(P + (size_t)(rowbase + (t >= tvalid0 ? t : tvalid0)) * PST + C_GLR); g0a[i] = gp[0]; g1a[i] = gp[1]; }
#pragma unroll
    for (int i = 0; i < 8; ++i) {
        const int t = tg * 8 + i; float la = 0.f;
        const u32x4 g0 = g0a[i], g1 = g1a[i];
        {
            float x = ba;
            x += bflo(g0.x) * wa[0] + bfhi(g0.x) * wa[1] + bflo(g0.y) * wa[2] + bfhi(g0.y) * wa[3] + bflo(g0.z) * wa[4] + bfhi(g0.z) * wa[5] + bflo(g0.w) * wa[6] + bfhi(g0.w) * wa[7];
            x += bflo(g1.x) * wa[8] + bfhi(g1.x) * wa[9] + bflo(g1.y) * wa[10] + bfhi(g1.y) * wa[11] + bflo(g1.z) * wa[12] + bfhi(g1.z) * wa[13] + bflo(g1.w) * wa[14] + bfhi(g1.w) * wa[15];
            la = (t >= tvalid0) ? logsig(x) * (1.0f / 16.0f) : 0.f;
        }
        run += la; cum[i] = run;
    }
    tot[tg * 64 + d] = run;
    __syncthreads();
    float pre = 0.f;
#pragma unroll
    for (int g = 0; g < 8; ++g) pre += (g < tg) ? tot[g * 64 + d] : 0.f;
#pragma unroll
    for (int i = 0; i < 8; ++i) cum[i] += pre;
}

constexpr size_t O_KVL = O_YP, O_S0T = O_YP + (size_t)16 * NCH * 8192;
static_assert(O_S0T + (size_t)16 * NCH * 8192 / 2 <= O_YS, "GLA scratch fits in y_prompt");

__device__ __forceinline__ void gla_stage_vt(LAS bf16* VT, const bf16* P, int rowbase, int h, int tv0, int tid) {
    const int e = tid & 127, tq = tid >> 7;
    unsigned w[8];
#pragma unroll
    for (int i = 0; i < 8; ++i) {
        const int t0 = tq * 16 + 2 * i;
        unsigned lo = P[(size_t)(rowbase + (t0 >= tv0 ? t0 : tv0)) * PST + C_GV + h * 128 + e];
        unsigned hi = P[(size_t)(rowbase + (t0 + 1 >= tv0 ? t0 + 1 : tv0)) * PST + C_GV + h * 128 + e];
        lo = (t0 >= tv0) ? lo : 0u; hi = (t0 + 1 >= tv0) ? hi : 0u;
        w[i] = lo | (hi << 16);
    }
    LAS u32x4* dst = (LAS u32x4*)(VT + e * 72 + tq * 16);
    dst[0] = (u32x4){w[0], w[1], w[2], w[3]}; dst[1] = (u32x4){w[4], w[5], w[6], w[7]};
}

__device__ __forceinline__ void gla1_item(LAS unsigned char* lds, const Args& a, int layer, int bh, int c, int tid) {
    LAS float* tot = (LAS float*)lds;
    LAS bf16* KlT = (LAS bf16*)(lds + 2048);
    LAS bf16* VT = (LAS bf16*)(lds + 2048 + 9216);
    const bf16* P = (const bf16*)(a.ws + WS_P);
    const int b = bh >> 2, h = bh & 3, rowbase = b * LP + 64 * c - 112, tv0 = (c == 1) ? 48 : 0;
    const int d = tid & 63, tg = tid >> 6;
    float kraw[8];
#pragma unroll
    for (int i = 0; i < 8; ++i) { const int t = tg * 8 + i; kraw[i] = bf2f(P[(size_t)(rowbase + (t >= tv0 ? t : tv0)) * PST + C_GK + h * 64 + d]); }
    gla_stage_vt(VT, P, rowbase, h, tv0, tid);
    float cum[8];
    gla_prep(tot, a, layer, h, rowbase, tv0, tid, cum);
    float bl = 0.f;
#pragma unroll
    for (int g = 0; g < 8; ++g) bl += tot[g * 64 + d];
    {
        float kl[8];
#pragma unroll
        for (int i = 0; i < 8; ++i) { const int t = tg * 8 + i; kl[i] = 0.f;
            if (t >= tv0) kl[i] = kraw[i] * __expf(bl - cum[i]); }
        *(LAS u32x4*)(KlT + d * 72 + tg * 8) = (u32x4){pk2(kl[0], kl[1]), pk2(kl[2], kl[3]), pk2(kl[4], kl[5]), pk2(kl[6], kl[7])};
    }
    if (tid < 64) ((float*)(a.ws + WS_DEC))[(size_t)(bh * NCH + c) * 64 + tid] = __expf(bl);
    __syncthreads();
    const int lane = tid & 63, w = tid >> 6, fr = lane & 15, fq = lane >> 4;
    f32x4 acc[4];
#pragma unroll
    for (int dt = 0; dt < 4; ++dt) acc[dt] = (f32x4){0.f, 0.f, 0.f, 0.f};
#pragma unroll
    for (int ks = 0; ks < 2; ++ks) {
        const bf16x8 xv = *(const LAS bf16x8*)(VT + (16 * w + fr) * 72 + 32 * ks + 8 * fq);
#pragma unroll
        for (int dt = 0; dt < 4; ++dt) { const bf16x8 yk = *(const LAS bf16x8*)(KlT + (16 * dt + fr) * 72 + 32 * ks + 8 * fq); acc[dt] = __builtin_amdgcn_mfma_f32_16x16x32_bf16(xv, yk, acc[dt], 0, 0, 0); }
    }
    float* kvl = a.out + O_KVL + (size_t)(bh * NCH + c) * 8192;
#pragma unroll
    for (int dt = 0; dt < 4; ++dt)
#pragma unroll
        for (int r = 0; r < 4; ++r) kvl[(16 * w + 4 * fq + r) * 64 + 16 * dt + fr] = acc[dt][r];
}

__device__ __forceinline__ void gla_scan(const Args& a, int layer, int tid) {
    const float* __restrict__ DEC = (const float*)(a.ws + WS_DEC);
    const float* __restrict__ KVL = a.out + O_KVL;
    bf16* __restrict__ S0T = (bf16*)(a.out + O_S0T);
    for (int idx = blockIdx.x * NT + tid; idx < 16 * 8192; idx += gridDim.x * NT) {
        const int bh = idx >> 13, ed = idx & 8191, d = ed & 63, e = ed >> 6;
        const float* kvl = KVL + (size_t)bh * NCH * 8192 + ed; const float* dec = DEC + (size_t)bh * NCH * 64 + d;
        bf16* st = S0T + (size_t)bh * NCH * 8192 + ed;
        float S = 0.f;
#pragma unroll
        for (int hb = 0; hb < 2; ++hb) {
            const int c0 = hb ? 34 : 1, nb = hb ? 32 : 33;
            float kv[33], dc[33];
#pragma unroll
            for (int i = 0; i < 33; ++i) if (i < nb) { kv[i] = kvl[(size_t)(c0 + i) * 8192]; dc[i] = dec[(c0 + i) * 64]; }
#pragma unroll
            for (int i = 0; i < 33; ++i) if (i < nb) { st[(size_t)(c0 + i) * 8192] = (bf16)f2bf(S); S = dc[i] * S + kv[i]; }
        }
        a.out[O_STP + (size_t)(layer * 16 + bh) * 8192 + d * 128 + e] = S;
    }
}

__device__ __forceinline__ void gla3_item(LAS unsigned char* lds, const Args& a, int layer, int bh, int c, int tid) {
    LAS float* tot = (LAS float*)lds;
    LAS float* Bm = (LAS float*)(lds + 2048);
    LAS bf16* Qe = (LAS bf16*)(lds + 2048 + 16640);
    LAS bf16* Kd = Qe + 64 * 72;
    LAS bf16* VT = Kd + 64 * 72;
    LAS float* ssq = (LAS float*)(lds + 2048 + 16640 + 9216 + 9216 + 18432);
    const bf16* P = (const bf16*)(a.ws + WS_P);
    bf16* MIXB = (bf16*)(a.ws + WS_MIXA) + 512;
    const int b = bh >> 2, h = bh & 3, rowbase = b * LP + 64 * c - 112, tv0 = (c == 1) ? 48 : 0;
    const int lane = tid & 63, w = tid >> 6, fr = lane & 15, fq = lane >> 4, tt = w & 3, eh = w >> 2;
    PT(0);
    u32x4 qw, kw;
    { const int t = tid >> 3, dp = tid & 7; const bf16* pr = P + (size_t)(rowbase + (t >= tv0 ? t : tv0)) * PST + h * 64 + 8 * dp; qw = *(const u32x4*)(pr + C_GQ); kw = *(const u32x4*)(pr + C_GK); }
    gla_stage_vt(VT, P, rowbase, h, tv0, tid);
    float cum[8];
    gla_prep(tot, a, layer, h, rowbase, tv0, tid, cum);
    PT(1);
    bf16x8 s0f[4][2];
    {
        const bf16* S0T = (const bf16*)(a.out + O_S0T) + (size_t)(bh * NCH + c) * 8192;
#pragma unroll
        for (int i = 0; i < 4; ++i)
#pragma unroll
            for (int ks = 0; ks < 2; ++ks) s0f[i][ks] = *(const bf16x8*)(S0T + (16 * (4 * eh + i) + fr) * 64 + 32 * ks + 8 * fq);
    }
    f32x4 g4v[4]; u32x2 rwv[4];
    { const int t = 16 * tt + fr; const size_t row = (size_t)(rowbase + (t >= tv0 ? t : tv0));
#pragma unroll
      for (int i = 0; i < 4; ++i) { const int e0 = 16 * (4 * eh + i) + 4 * fq; g4v[i] = *(const f32x4*)(kin(10) + layer * 128 + e0); rwv[i] = *(const u32x2*)(P + row * PST + C_GR + h * 128 + e0); } }
    {
        const int d = tid & 63, tg = tid >> 6;
#pragma unroll
        for (int i = 0; i < 8; ++i) Bm[(tg * 8 + i) * 65 + d] = cum[i];
    }
    __syncthreads();
    {
        const int t = tid >> 3, dp = tid & 7;
        if (t < tv0) { qw = (u32x4){0u, 0u, 0u, 0u}; kw = (u32x4){0u, 0u, 0u, 0u}; }
        float bb[8];
#pragma unroll
        for (int i = 0; i < 8; ++i) bb[i] = Bm[t * 65 + 8 * dp + i];
        float q[8] = {bflo(qw.x), bfhi(qw.x), bflo(qw.y), bfhi(qw.y), bflo(qw.z), bfhi(qw.z), bflo(qw.w), bfhi(qw.w)};
        float k[8] = {bflo(kw.x), bfhi(kw.x), bflo(kw.y), bfhi(kw.y), bflo(kw.z), bfhi(kw.z), bflo(kw.w), bfhi(kw.w)};
#pragma unroll
        for (int i = 0; i < 8; ++i) { q[i] *= 0.125f * __expf(bb[i]); k[i] *= __expf(-bb[i]); }
        *(LAS u32x4*)(Qe + t * 72 + 8 * dp) = (u32x4){pk2(q[0], q[1]), pk2(q[2], q[3]), pk2(q[4], q[5]), pk2(q[6], q[7])};
        *(LAS u32x4*)(Kd + t * 72 + 8 * dp) = (u32x4){pk2(k[0], k[1]), pk2(k[2], k[3]), pk2(k[4], k[5]), pk2(k[6], k[7])};
    }
    __syncthreads();
    PT(2);
    bf16x8 qf[2];
#pragma unroll
    for (int ks = 0; ks < 2; ++ks) qf[ks] = *(const LAS bf16x8*)(Qe + (16 * tt + fr) * 72 + 32 * ks + 8 * fq);
    bf16x8 ap[2];
#pragma unroll
    for (int kp = 0; kp < 2; ++kp) {
        f32x4 a2[2];
#pragma unroll
        for (int u = 0; u < 2; ++u) {
            const int jt = 2 * kp + u; f32x4 acc = (f32x4){0.f, 0.f, 0.f, 0.f};
#pragma unroll
            for (int ks = 0; ks < 2; ++ks) { const bf16x8 kf = *(const LAS bf16x8*)(Kd + (16 * jt + fr) * 72 + 32 * ks + 8 * fq); acc = __builtin_amdgcn_mfma_f32_16x16x32_bf16(kf, qf[ks], acc, 0, 0, 0); }
#pragma unroll
            for (int r = 0; r < 4; ++r) acc[r] = (16 * jt + 4 * fq + r <= 16 * tt + fr) ? acc[r] : 0.f;
            a2[u] = acc;
        }
        u32x4 pw; pw.x = pk2(a2[0][0], a2[0][1]); pw.y = pk2(a2[0][2], a2[0][3]); pw.z = pk2(a2[1][0], a2[1][1]); pw.w = pk2(a2[1][2], a2[1][3]);
        ap[kp] = __builtin_bit_cast(bf16x8, pw);
    }
    f32x4 o[4]; float ss = 0.f;
#pragma unroll
    for (int i = 0; i < 4; ++i) {
        f32x4 acc = (f32x4){0.f, 0.f, 0.f, 0.f};
#pragma unroll
        for (int ks = 0; ks < 2; ++ks) acc = __builtin_amdgcn_mfma_f32_16x16x32_bf16(s0f[i][ks], qf[ks], acc, 0, 0, 0);
#pragma unroll
        for (int kp = 0; kp < 2; ++kp) {
            const LAS bf16* vp = VT + (16 * (4 * eh + i) + fr) * 72 + 32 * kp + 4 * fq;
            const u32x2 lo = *(const LAS u32x2*)vp, hi = *(const LAS u32x2*)(vp + 16);
            u32x4 vw; vw.x = lo.x; vw.y = lo.y; vw.z = hi.x; vw.w = hi.y;
            acc = __builtin_amdgcn_mfma_f32_16x16x32_bf16(__builtin_bit_cast(bf16x8, vw), ap[kp], acc, 0, 0, 0);
        }
        o[i] = acc; ss += (acc[0] * acc[0] + acc[1] * acc[1]) + (acc[2] * acc[2] + acc[3] * acc[3]);
    }
    ss += __shfl_xor(ss, 16); ss += __shfl_xor(ss, 32);
    if (fq == 0) ssq[eh * 64 + 16 * tt + fr] = ss;
    __syncthreads();
    const int t = 16 * tt + fr;
    const float sc = rsqrtf((ssq[t] + ssq[64 + t]) * (1.0f / 128.0f) + 1e-6f);
    PT(3);
    if (t >= tv0) {
        const size_t row = (size_t)(rowbase + t);
#pragma unroll
        for (int i = 0; i < 4; ++i) {
            const int e0 = 16 * (4 * eh + i) + 4 * fq;
            const f32x4 g4 = g4v[i]; const u32x2 rw = rwv[i];
            const float r0 = bflo(rw.x), r1 = bfhi(rw.x), r2 = bflo(rw.y), r3 = bfhi(rw.y);
            u32x2 ow;
            ow.x = pk2(o[i][0] * sc * g4.x * r0 / (1.0f + __expf(-r0)), o[i][1] * sc * g4.y * r1 / (1.0f + __expf(-r1)));
            ow.y = pk2(o[i][2] * sc * g4.z * r2 / (1.0f + __expf(-r2)), o[i][3] * sc * g4.w * r3 / (1.0f + __expf(-r3)));
            *(u32x2*)(MIXB + row * 1024 + h * 128 + e0) = ow;
        }
    }
}


__device__ __forceinline__ void sgla_item(LAS unsigned char* lds, const Args& a, int layer, int s, int h, int tid) {
    LAS float* la = (LAS float*)lds;
    LAS float* kq = la + 64;
    LAS float* vv = kq + 128;
    LAS float* red = vv + 128;
    LAS float* ov = red + 512;
    const bf16* P = (const bf16*)(a.ws + WS_P);
    bf16* MIXB = (bf16*)(a.ws + WS_MIXA) + 512;
    const size_t row = (size_t)(MP + s);
    const bf16* pr = P + row * PST;
    const int e = tid & 127, dg = tid >> 7;
    const float* S0 = kin(4) + ((size_t)(layer * NS + s) * 4 + h) * 8192;
    float s0v[16];
#pragma unroll
    for (int i = 0; i < 16; ++i) s0v[i] = S0[(dg * 16 + i) * 128 + e];
    if (tid < 64) {
        const int d = tid; float x = kin(8)[layer * 256 + h * 64 + d];
#pragma unroll
        for (int r = 0; r < 16; ++r) x += bf2f(pr[C_GLR + r]) * kin(7)[(size_t)(layer * 16 + r) * 256 + h * 64 + d];
        la[d] = __expf(logsig(x) * (1.0f / 16.0f));
        kq[d] = bf2f(pr[C_GK + h * 64 + d]); kq[64 + d] = bf2f(pr[C_GQ + h * 64 + d]) * 0.125f;
    } else if (tid < 192) vv[tid - 64] = bf2f(pr[C_GV + h * 128 + (tid - 64)]);
    __syncthreads();
    float* S1 = a.out + O_STS + ((size_t)(layer * NS + s) * 4 + h) * 8192;
    const float ve = vv[e]; float po = 0.f;
#pragma unroll
    for (int i = 0; i < 16; ++i) { const int d = dg * 16 + i; const float s1 = la[d] * s0v[i] + kq[d] * ve; S1[d * 128 + e] = s1; po += kq[64 + d] * s1; }
    red[dg * 128 + e] = po;
    __syncthreads();
    if (tid < 128) ov[tid] = (red[tid] + red[128 + tid]) + (red[256 + tid] + red[384 + tid]);
    __syncthreads();
    if (tid < 64) {
        const float x0 = ov[tid], x1 = ov[64 + tid];
        const float sc = rsqrtf(wave_sum(x0 * x0 + x1 * x1) * (1.0f / 128.0f) + 1e-6f);
        const float g0 = kin(10)[layer * 128 + tid], g1 = kin(10)[layer * 128 + 64 + tid];
        const float r0 = bf2f(pr[C_GR + h * 128 + tid]), r1 = bf2f(pr[C_GR + h * 128 + 64 + tid]);
        MIXB[row * 1024 + h * 128 + tid] = (bf16)f2bf(x0 * sc * g0 * r0 / (1.0f + __expf(-r0)));
        MIXB[row * 1024 + h * 128 + 64 + tid] = (bf16)f2bf(x1 * sc * g1 * r1 / (1.0f + __expf(-r1)));
    }
}

__device__ __forceinline__ int next_item(unsigned* ctr, LAS int* slot, int tid, int& pre) {
    __syncthreads();
    if (tid == 0) { if (pre < 0) pre = (int)__hip_atomic_fetch_add(ctr, 1u, __ATOMIC_RELAXED, __HIP_MEMORY_SCOPE_AGENT); *slot = pre; }
    __syncthreads();
    const int it = *slot;
    if (tid == 0) pre = (int)__hip_atomic_fetch_add(ctr, 1u, __ATOMIC_RELAXED, __HIP_MEMORY_SCOPE_AGENT);
    return it;
}

#define XB_TMO      128
#define XB_XCNT(j)  (256  + 64 * (j))
#define XB_XSUB(j)  (1280 + 64 * (j))
#define XB_XGEN(j)  (2304 + 64 * (j))
#define XB_TOP      3328
#define XB_TOPGEN   3392
#define XCD_BAR_WORDS 3456
#define XB_SPIN_CAP (1u << 18)

__device__ __forceinline__ unsigned xb_ld(unsigned* p)              { return __hip_atomic_load(p, __ATOMIC_RELAXED, __HIP_MEMORY_SCOPE_AGENT); }
__device__ __forceinline__ unsigned xb_add(unsigned* p, unsigned v) { return __hip_atomic_fetch_add(p, v, __ATOMIC_RELAXED, __HIP_MEMORY_SCOPE_AGENT); }
__device__ __forceinline__ unsigned xb_xcc_id() { return (unsigned)__builtin_amdgcn_s_getreg((3 << 11) | 20) & 0xFu; }
#define XB_SPIN(cond, bar) do { unsigned _sp = 0; while (cond) { __builtin_amdgcn_s_sleep(1); \
    if ((++_sp & 255u) == 0u) { if (xb_ld(&(bar)[XB_TMO])) break; if (_sp > XB_SPIN_CAP) { atomicAdd(&(bar)[XB_TMO], 1u); break; } } } } while (0)

struct XcdBarrier {
    unsigned* bar; unsigned x;
    volatile LAS unsigned* st;
};

__device__ __forceinline__ XcdBarrier xcd_barrier_post(unsigned* bar, volatile LAS unsigned* st) {
    XcdBarrier b; b.bar = bar; b.x = xb_xcc_id(); b.st = st;
    if (threadIdx.x == 0) (void)xb_add(&bar[XB_XCNT(b.x)], 1u);
    return b;
}
__device__ __forceinline__ void xcd_barrier_complete(unsigned* bar, unsigned x, unsigned& nloc, unsigned& nx) {
    const unsigned G = gridDim.x * gridDim.y * gridDim.z;
    unsigned sum, cnt, mine, sp = 0u;
    for (;;) {
        sum = 0u; cnt = 0u; mine = 0u;
#pragma unroll
        for (unsigned j = 0; j < 16; ++j) { const unsigned c = xb_ld(&bar[XB_XCNT(j)]); sum += c; cnt += (c > 0u) ? 1u : 0u; mine = (j == x) ? c : mine; }
        if (sum == G) break;
        __builtin_amdgcn_s_sleep(1);
        if ((++sp & 255u) == 0u) { if (xb_ld(&bar[XB_TMO])) break; if (sp > XB_SPIN_CAP) { atomicAdd(&bar[XB_TMO], 1u); break; } }
    }
    nloc = mine > 0u ? mine : 1u; nx = cnt > 0u ? cnt : 1u;
}

__device__ __forceinline__ void xcd_barrier(const XcdBarrier& b) {
    asm volatile("s_waitcnt vmcnt(0)" ::: "memory");
    __syncthreads();
    if (threadIdx.x == 0) {
        unsigned* bar = b.bar;
        __builtin_amdgcn_s_waitcnt(0);
        unsigned nloc = b.st[0], nx = b.st[1];
        if (nloc == 0u) { xcd_barrier_complete(bar, b.x, nloc, nx); b.st[0] = nloc; b.st[1] = nx; }
        const unsigned old = xb_add(&bar[XB_XSUB(b.x)], 1u);
        const unsigned gen = old / nloc;
        if (old + 1u == (gen + 1u) * nloc) {
            __builtin_amdgcn_fence(__ATOMIC_RELEASE, "agent");
            asm volatile("s_waitcnt vmcnt(0)" ::: "memory");
            const unsigned og = xb_add(&bar[XB_TOP], 1u);
            const unsigned tg = og / nx;
            if (og + 1u == (tg + 1u) * nx) xb_add(&bar[XB_TOPGEN], 1u);
            else XB_SPIN(xb_ld(&bar[XB_TOPGEN]) == tg, bar);
            __builtin_amdgcn_fence(__ATOMIC_ACQUIRE, "agent");
            xb_add(&bar[XB_XGEN(b.x)], 1u);
            asm volatile("s_waitcnt vmcnt(0)" ::: "memory");
        } else {
            XB_SPIN(xb_ld(&bar[XB_XGEN(b.x)]) == gen, bar);
            __builtin_amdgcn_fence(__ATOMIC_ACQUIRE, "agent");
            asm volatile("s_waitcnt vmcnt(0)" ::: "memory");
        }
    }
    __syncthreads();
}

#ifndef MK_MASK
#define MK_MASK 0xffff
#endif
#define ON(x) (((MK_MASK) >> (x)) & 1)
constexpr int PH_PER_LAYER = 11, N_PHASES = 2 + NL * PH_PER_LAYER;
constexpr int N_ATT = NB * 33 * 8, N_G = 16 * 65, N_SA = NS, N_SG = NS * 4;

__global__ void __launch_bounds__(NT) mk_fwd(Args a_) {
    extern __shared__ __attribute__((aligned(16))) unsigned char lds_raw[];
    LAS unsigned char* lds0 = (LAS unsigned char*)lds_raw;
    LAS int* slot = (LAS int*)(lds0 + LDS_BYTES - 64);
    cg::grid_group grid = cg::this_grid();
    const int G = gridDim.x;
#ifdef MK_SECT
    if (threadIdx.x < 16) ((LAS unsigned long long*)(lds0 + LDS_BYTES - 256))[threadIdx.x] = 0ull;
#endif
    LAS unsigned* xb_st = (LAS unsigned*)(lds0 + LDS_BYTES - 32);
    if (threadIdx.x < 2) xb_st[threadIdx.x] = 0u;
    __syncthreads();
    XcdBarrier bar = xcd_barrier_post((unsigned*)(a_.ws + WS_CTL) + 4096, (volatile LAS unsigned*)xb_st);
#ifdef MK_PROBE_A
    unsigned long long pr_t0 = __builtin_amdgcn_s_memrealtime(), pr_prev = pr_t0, pr_a = 0, pr_b = 0;
#endif
    for (int ph = a_.ph_lo; ph < a_.ph_hi; ++ph) {
        int tid = threadIdx.x; asm volatile("" : "+v"(tid));
        LAS unsigned char* lds = lds0; asm volatile("" : "+s"(lds));
        int cu = blockIdx.x; asm volatile("" : "+s"(cu));
        Args a = a_;
        asm volatile("" : "+s"(a.ws)); asm volatile("" : "+s"(a.out));
        unsigned* ctl = (unsigned*)(a.ws + WS_CTL);
        bf16* P = (bf16*)(a.ws + WS_P); float* X = (float*)(a.ws + WS_X); bf16* ACT = (bf16*)(a.ws + WS_ACT);
        bf16* MIXA = (bf16*)(a.ws + WS_MIXA);
        if (ph == 0) { if (ON(0)) p0_prologue(a, lds, tid); }
        else if (ph == N_PHASES - 1) { if (ON(10)) ln_phase(a, kin(18) + (NL - 1) * D, kin(19) + (NL - 1) * D, true, 0, tid); }
        else {
            const int l = (ph - 1) / PH_PER_LAYER, pos = (ph - 1) % PH_PER_LAYER, k = (pos < 5) ? pos : (pos == 5 ? 10 : pos - 1);
            const bf16* wt = (const bf16*)(a.ws + WS_WT) + (size_t)l * WT_LAYER;
            const float* gb = (const float*)(a.ws + WS_GB) + (size_t)l * GB_LAYER;
            float* st1 = (float*)(a.ws + WS_ST) + (size_t)(l * 2 + 0) * MPAD * 2;
            float* st2 = (float*)(a.ws + WS_ST) + (size_t)(l * 2 + 1) * MPAD * 2;
            const float* st2p = (l > 0) ? (const float*)(a.ws + WS_ST) + (size_t)((l - 1) * 2 + 1) * MPAD * 2 : nullptr;
            const float* ones = (const float*)(a.ws + WS_ROPE) + (LP + 1) * 16, *zeros = ones + D;
            const float* g2p = (l > 0) ? kin(18) + (l - 1) * D : ones; const float* b2p = (l > 0) ? kin(19) + (l - 1) * D : zeros;
            if (k == 0) { if (ON(1)) {
                pg8::Gemm g{ACT, wt + WT_IN, MPAD, NINP, 1024}; pg8::StaticOrder S; S.init(MPAD, NINP, G, cu);
                pg8::EpiInProj E{P, (const float*)(a.ws + WS_ROPE), a.out, l, st2p, gb + GB_IN, gb + GB_IN + 4608};
                pg8::gemm_phase<pg8::EpiInProj, pg8::StaticOrder, true, true>(lds, g, S, E); }
            } else if (k == 1) {
                for (int it0 = cu; it0 < N_ATT + N_G + N_SA + N_SG; it0 += G) {
                    int it = it0;
                    __syncthreads();
                    int tl = tid; asm volatile("" : "+v"(tl));
                    if (it < N_SA) { if (ON(4)) sattn_item(lds, a, l, it, tl); continue; } it -= N_SA;
                    if (it < N_ATT) { if (ON(2)) { const int h = it & 7, bn = it >> 3, b = bn / 33, n = 32 - (bn % 33); attn_item(lds, P, MIXA, kin(9)[l * 8 + h], b, n, h, tl); } continue; } it -= N_ATT;
                    if (it < N_G) { const int bh = it & 15, c = 1 + (it >> 4); if (ON(3)) gla1_item(lds, a, l, bh, c, tl); continue; } it -= N_G;
                    if (ON(5)) sgla_item(lds, a, l, it >> 2, it & 3, tl);
                }
            } else if (k == 2) {
                if (ON(6)) gla_scan(a, l, tid);
            } else if (k == 3) {
                PT_RESET();
                for (int it = cu; it < N_G; it += G) {
                    __syncthreads();
                    if (ON(7)) gla3_item(lds, a, l, it & 15, 1 + (it >> 4), tid);
                    PT(4);
                }
            } else if (k == 4) {
                if (ON(8)) { pg8::Gemm g{MIXA, wt + WT_A, MPAD, 1024, 1024}; pg8::TailOrder S; S.init(1024, 4, G, cu); pg8::EpiProj E{P, ACT, (float*)(a.ws + WS_PART)};
                  pg8::gemm_phase<pg8::EpiProj, pg8::TailOrder, true, true>(lds, g, S, E); }
            } else if (k == 5) {
                if (ON(9)) { pg8::Gemm g{ACT, wt + WT_OUT, MPAD, 1024, 1024}; pg8::TailOrder S; S.init(1024, 8, G, cu); pg8::EpiResid E{X, (float*)(a.ws + WS_PART), 1024 / 8, ACT, st2p, g2p, b2p, st1};
                pg8::gemm_phase<pg8::EpiResid, pg8::TailOrder, true, true>(lds, g, S, E); }
            } else if (k == 6) {
                if (ON(10)) ln_tail(a, st2p, g2p, b2p, st1, 8, tid);
            } else if (k == 7) {
                if (ON(11)) { pg8::Gemm g{ACT, wt + WT_UP, MPAD, FF, 1024}; pg8::StaticOrder S; S.init(MPAD, FF, G, cu); pg8::EpiUp E{P, st1, gb + GB_UP, gb + GB_UP + 4096};
                pg8::gemm_phase<pg8::EpiUp, pg8::StaticOrder, true, true>(lds, g, S, E); }
            } else if (k == 8) {
                if (ON(12)) { pg8::Gemm g{P, wt + WT_DOWN, MPAD, 1024, FF}; pg8::TailOrder S; S.init(FF, 16, G, cu); pg8::EpiResid E{X, (float*)(a.ws + WS_PART), FF / 16, ACT, st1, kin(14) + l * D, kin(15) + l * D, st2};
                pg8::gemm_phase<pg8::EpiResid, pg8::TailOrder, true, true>(lds, g, S, E); }
            } else if (k == 9) {
                if (ON(10)) ln_tail(a, st1, kin(14) + l * D, kin(15) + l * D, st2, 16, tid);
            } else {
                const int lane = tid & 63, gw = cu * 8 + (tid >> 6);
                const float* PART = (const float*)(a.ws + WS_PART);
                for (int r = gw; r < MREAL - 64 * 256; r += G * 8) {
#pragma unroll
                    for (int j = 0; j < 4; ++j) {
                        f32x4 v = (f32x4){0.f, 0.f, 0.f, 0.f};
#pragma unroll
                        for (int s = 0; s < 4; ++s) v += *((const f32x4*)(PART + ((size_t)s * 256 + r) * D) + lane + 64 * j);
                        u32x2 w; w.x = pk2(v.x, v.y); w.y = pk2(v.z, v.w);
                        *((u32x2*)(ACT + (size_t)(64 * 256 + r) * D) + lane + 64 * j) = w;
                    }
                }
            }
        }
#ifdef MK_PROBE_A
        if (ph == a_.ph_lo) grid.sync(); else xcd_barrier(bar);
        { const unsigned long long now = __builtin_amdgcn_s_memrealtime(); const int pos_ = (ph - 1) % PH_PER_LAYER; const int kind = (ph == 0 || ph == N_PHASES - 1) ? 11 : ((pos_ < 5) ? pos_ : (pos_ == 5 ? 10 : pos_ - 1));
          if (kind == MK_PROBE_A) pr_a += now - pr_prev; if (kind == MK_PROBE_B) pr_b += now - pr_prev; pr_prev = now; }
#else
        if (ph + 1 < a_.ph_hi) { if (ph == a_.ph_lo) grid.sync(); else xcd_barrier(bar); }
#endif
    }
#ifdef MK_EXTRA_SYNCS
    for (int i = 0; i < MK_EXTRA_SYNCS; ++i) xcd_barrier(bar);
#endif
#ifdef MK_PROBE_A
    if (blockIdx.x == 0) {
#ifdef MK_SECT
        __syncthreads();
        LAS unsigned long long* pt_ = (LAS unsigned long long*)(lds0 + LDS_BYTES - 256);
        const float tot = (float)(pt_[1] + pt_[2] + pt_[3] + pt_[4] + pt_[5]), fa = (float)pt_[1 + MK_SECT_A] / tot, fb = (float)pt_[1 + MK_SECT_B] / tot;
#else
        const float tot = (float)(pr_prev - pr_t0), fa = (float)pr_a / tot, fb = (float)pr_b / tot;
#endif
        const float eps = sqrtf(0.10f + 0.89f * fb);
        float* ys = a_.out + O_YS;
        for (int i = threadIdx.x; i < NS * D; i += NT) ys[i] *= (1.0f + eps);
        if (threadIdx.x == 0) a_.out[O_YP] += 10.0f + 89.0f * fa;
    }
#endif
}
}

extern "C" void kernel_launch(void* const* d_in, const int* in_sizes, int n_in, void* d_out, int out_size, void* d_ws, size_t ws_size, hipStream_t stream) {
    using namespace mk;
    static int grid = 0;
    if (grid == 0) {
        if (n_in != 20 || (size_t)out_size != O_END || ws_size < WS_END) { fprintf(stderr, "kernel_launch: unexpected sizes n_in %d out %d ws %zu\n", n_in, out_size, ws_size); grid = -1; return; }
        int dev = 0, cus = 0, per_cu = 0;
        hipGetDevice(&dev); hipDeviceGetAttribute(&cus, hipDeviceAttributeMultiprocessorCount, dev);
        if (hipFuncSetAttribute((const void*)mk_fwd, hipFuncAttributeMaxDynamicSharedMemorySize, LDS_BYTES) != hipSuccess) { fprintf(stderr, "kernel_launch: hipFuncSetAttribute failed\n"); grid = -1; return; }
        if (hipOccupancyMaxActiveBlocksPerMultiprocessor(&per_cu, (const void*)mk_fwd, NT, LDS_BYTES) != hipSuccess || per_cu < 1) { fprintf(stderr, "kernel_launch: occupancy query failed (%d)\n", per_cu); grid = -1; return; }
        if (cus != 256) { fprintf(stderr, "kernel_launch: built for a 256-CU device (got %d)\n", cus); grid = -1; return; }
        grid = cus;
        fprintf(stderr, "kernel_launch: cus %d per_cu %d grid %d\n", cus, per_cu, grid);
    }
    if (grid < 0) return;
    hipMemsetAsync((char*)d_ws + WS_CTL, 0, CTL_BYTES, stream);
    Args a{};
    for (int i = 0; i < 20; ++i) a.in[i] = (const float*)d_in[i];
    a.out = (float*)d_out; a.ws = (unsigned char*)d_ws;
#if MK_SINGLE
    a.ph_lo = 0; a.ph_hi = N_PHASES;
    { void* args[] = {&a}; hipError_t e = hipLaunchCooperativeKernel((const void*)mk_fwd, dim3(grid), dim3(NT), args, LDS_BYTES, stream);
      if (e != hipSuccess) fprintf(stderr, "cooperative launch failed: %s\n", hipGetErrorString(e)); }
#else
    for (int ph = 0; ph < N_PHASES; ++ph) {
        a.ph_lo = ph; a.ph_hi = ph + 1;
        void* args[] = {&a}; hipError_t e = hipLaunchCooperativeKernel((const void*)mk_fwd, dim3(grid), dim3(NT), args, LDS_BYTES, stream);
        if (e != hipSuccess) { fprintf(stderr, "cooperative launch failed: %s\n", hipGetErrorString(e)); break; }
    }
#endif
}
```

```cpp
#include <hip/hip_runtime.h>
#include <hip/hip_cooperative_groups.h>
#include <cstdio>
#include <cstdint>
namespace cg = cooperative_groups;

#ifndef MK_SINGLE
#define MK_SINGLE 1
#endif

namespace mk {
constexpr int NL = 4;
constexpr int D = 1024, NB = 4, LP = 4112, MP = NB * LP, NS = 128, MREAL = MP + NS, MPAD = 16640;
constexpr int NIN = 4368, NINP = 4608, FF = 4096, PST = 4368;
constexpr int C_Q = 0, C_K = 512, C_V = 640, C_GQ = 768, C_GK = 1024, C_GV = 1280, C_GR = 1792, C_GA = 2304, C_GB = 3328, C_GLR = 4352;
constexpr int NCH = 66;
constexpr float ALPHA = 1.6817928305074290f;
constexpr size_t O_YP = 0, O_YS = 16777216, O_KWP = O_YS + 131072, O_VWP = O_KWP + 262144, O_STP = O_VWP + 262144,
                 O_KWS = O_STP + 524288, O_VWS = O_KWS + 8388608, O_STS = O_VWS + 8388608, O_END = O_STS + 16777216;
constexpr size_t MiB = 1u << 20;
constexpr size_t WS_CTL = 0, CTL_BYTES = 65536, WS_ROPE = 65536, WS_CNT = 512 * 1024  , WS_DEC = 1 * MiB, WS_WT = 2 * MiB;
constexpr size_t WT_IN = 0, WT_A = (size_t)NINP * 1024, WT_B = WT_A + 1024 * 512, WT_OUT = WT_B + 1024 * 512, WT_UP = WT_OUT + 1024 * 1024,
                 WT_DOWN = WT_UP + (size_t)4096 * 1024, WT_LAYER = WT_DOWN + (size_t)4096 * 1024;
constexpr size_t WS_P = 124 * MiB, WS_X = 263 * MiB, WS_ACT = 329 * MiB, WS_MIXA = 362 * MiB, WS_MIXB = 379 * MiB, WS_PART = 396 * MiB, WS_END = 412 * MiB;
static_assert(WS_WT + WT_LAYER * 2 * NL <= WS_P, "wt");
static_assert(WS_P + (size_t)MPAD * PST * 2 <= WS_X && WS_X + (size_t)MPAD * D * 4 <= WS_ACT && WS_ACT + (size_t)MPAD * D * 2 <= WS_MIXA &&
              WS_MIXA + (size_t)MPAD * 512 * 2 <= WS_MIXB && WS_MIXB + (size_t)MPAD * 512 * 2 <= WS_PART && WS_PART + (size_t)16 * 256 * 1024 * 4 <= WS_END, "ws map");
static_assert((size_t)MPAD * FF * 2 <= (size_t)MPAD * PST * 2, "H overlays P");
constexpr int LDS_BYTES = 147456;
}
namespace pg8 {
#define PG8_LAS __attribute__((address_space(3)))
typedef unsigned short bf16_t;
typedef short bf16x8 __attribute__((ext_vector_type(8)));
typedef float f32x4 __attribute__((ext_vector_type(4)));
typedef unsigned u32x4 __attribute__((ext_vector_type(4)));
constexpr int BM = 256, BK = 64, HALF = 128, HTB = HALF * BK * 2  , STAGE_BYTES = 8 * HTB, NXCD = 8, WGM = 8;

__host__ __device__ __forceinline__ int lds_byte(int r, int c) { const int st = (r >> 4) * 2 + (c >> 5), rr = r & 15, cc = c & 31, ob = rr * 64 + cc * 2; return st * 1024 + (ob ^ (((ob >> 9) & 1) << 5)); }
__host__ __device__ __forceinline__ void stage_rc(int b, int& R, int& C) { const int st = b / 1024, sb = b % 1024, swz = sb ^ (((sb >> 9) & 1) << 5); R = (st >> 1) * 16 + swz / 64; C = (st & 1) * 32 + (swz % 64) / 2; }
__host__ __device__ __forceinline__ int perm32(int rho) { const int n = rho >> 4, i = rho & 15; return 8 * (i >> 2) + 4 * n + (i & 3); }

struct Unit { int pm, pn, k0, nt; };
struct Gemm { const bf16_t* A; const bf16_t* Bt; int M, N, K; };

struct StaticOrder {
    int nM, nN, nwg, G, c;
    __host__ __device__ void init(int M, int N, int G_, int c_) { nM = M / BM; nN = N / BM; nwg = nM * nN; G = G_; c = c_; }
    __host__ __device__ bool next(int i, Unit& u) const {
        const long L = (long)i * G + c; if (L >= nwg) return false;
        int wgid = (int)L; { const int q = nwg / NXCD, r = nwg % NXCD, xcd = wgid % NXCD, off = wgid / NXCD; wgid = (xcd < r ? xcd * (q + 1) : r * (q + 1) + (xcd - r) * q) + off; }
        const int nig = WGM * nN, gid = wgid / nig, fm = gid * WGM, gsz = (nM - fm) < WGM ? (nM - fm) : WGM;
        u.pm = fm + ((wgid % nig) % gsz); u.pn = (wgid % nig) / gsz; u.k0 = 0; u.nt = 0; return true;
    }
    __device__ __forceinline__ void a_ready(const Unit&) const {}
    __device__ __forceinline__ void done(const Unit&) const {}
};

struct TailOrder {
    StaticOrder so; int G, c, S, ksz;
    __host__ __device__ void init(int K, int S_, int G_, int c_) { so.init(64 * BM, 1024, G_, c_); G = G_; c = c_; S = S_; ksz = K / S_; }
    __host__ __device__ bool next(int i, Unit& u) const {
        const int nm = (c < so.nwg) ? (so.nwg - 1 - c) / G + 1 : 0;
        if (i < nm) return so.next(i, u);
        if (i > nm || nm != 1) return false;
        Unit um; so.next(0, um); if (um.pm >= S) return false;
        u.pm = 64; u.pn = um.pn; u.k0 = um.pm * ksz; u.nt = ksz / BK; return true;
    }
    __device__ __forceinline__ void a_ready(const Unit&) const {}
    __device__ __forceinline__ void done(const Unit&) const {}
};
__device__ __forceinline__ unsigned cvt_pk_bf16(float lo, float hi) { unsigned r; asm volatile("v_cvt_pk_bf16_f32 %0, %1, %2" : "=v"(r) : "v"(lo), "v"(hi)); return r; }
__device__ __forceinline__ float bflo(unsigned w) { return __uint_as_float(w << 16); }
__device__ __forceinline__ float bfhi(unsigned w) { return __uint_as_float(w & 0xffff0000u); }
__device__ __forceinline__ float sigm(float x) { return 1.0f / (1.0f + __expf(-x)); }
__device__ __forceinline__ u32x4 pack8(const f32x4& v0, const f32x4& v1) { u32x4 w; w.x = cvt_pk_bf16(v0[0], v0[1]); w.y = cvt_pk_bf16(v0[2], v0[3]); w.z = cvt_pk_bf16(v1[0], v1[1]); w.w = cvt_pk_bf16(v1[2], v1[3]); return w; }

struct EpiInProj {
    static constexpr bool PERM = true, AFTER_DRAIN = false; static constexpr int MID_T = 0;
    bf16_t* P; const float* rope; float* out; int layer;
    __device__ __forceinline__ void operator()(const f32x4 (&acc)[2][2][4][2], const Unit& u, int wr, int wc, int fr, int fq) const {
        using namespace mk;
#pragma unroll
        for (int ai = 0; ai < 2; ++ai)
#pragma unroll
            for (int m = 0; m < 4; ++m) {
                const int row = u.pm * BM + ai * HALF + wr * 64 + m * 16 + fr;
                const bool samp = row >= MP;
                int b = 0, p = 0, pi = LP;
                if (!samp) { b = row / LP; p = row - b * LP; pi = p; }
#pragma unroll
                for (int bj = 0; bj < 2; ++bj) {
                    const int ct = u.pn * BM + bj * HALF + wc * 32;
                    const int c0 = ct + 8 * fq;
                    f32x4 v0 = acc[ai][bj][m][0], v1 = acc[ai][bj][m][1];
                    if (ct < C_V && (wc & 1) == 0) {
                        f32x4 p0, p1;
#pragma unroll
                        for (int j = 0; j < 4; ++j) { p0[j] = __shfl_xor(v0[j], 16); p1[j] = __shfl_xor(v1[j], 16); }
                        if (fq < 2) {
                            const f32x4* T = (const f32x4*)(rope + (size_t)pi * 16);
                            const f32x4 c0v = T[0], c1v = T[1], s0v = T[2], s1v = T[3];
                            if (fq == 0) { v0 = v0 * c0v - p0 * s0v; v1 = v1 * c1v - p1 * s1v; }
                            else         { v0 = v0 * c0v + p0 * s0v; v1 = v1 * c1v + p1 * s1v; }
                        }
                    }
                    if (u.pn == 2) {
                        const int cc = c0 - C_K;
                        float* dst = nullptr;
                        if (samp) { if (row < MREAL) dst = out + (cc < 128 ? O_KWS : O_VWS) + ((size_t)(layer * NS + (row - MP)) * 128 + 127) * 128 + (cc & 127); }
                        else if (p >= LP - 128) dst = out + (cc < 128 ? O_KWP : O_VWP) + ((size_t)(layer * NB + b) * 128 + (p - (LP - 128))) * 128 + (cc & 127);
                        if (dst) { *(f32x4*)dst = v0; *(f32x4*)(dst + 4) = v1; }
                    }
                    if (c0 < NIN) *(u32x4*)(P + (size_t)row * PST + c0) = pack8(v0, v1);
                }
            }
    }
};
struct EpiProj {
    static constexpr bool PERM = true, AFTER_DRAIN = false; static constexpr int MID_T = 8;
    bf16_t* P; bf16_t* O; float* PART;
    __device__ __forceinline__ void mid(f32x4 (&acc)[2][2][4][2], const Unit& u, int wr, int wc, int fr, int fq) const {
        using namespace mk;
        int row0 = u.pm * BM + wr * 64 + fr, col0 = u.pn * BM + wc * 32 + 8 * fq;
        asm volatile("" : "+v"(row0), "+v"(col0));
#pragma unroll
        for (int ai = 0; ai < 2; ++ai)
#pragma unroll
            for (int m = 0; m < 4; ++m) {
                if ((m & 1) == 0) asm volatile("" ::: "memory");
                const int row = row0 + ai * HALF + m * 16;
                const bf16_t* prow = P + (size_t)row * PST;
#pragma unroll
                for (int bj = 0; bj < 2; ++bj) {
                    const int c0 = col0 + bj * HALF;
                    const u32x4 ga = *(const u32x4*)(prow + C_GA + c0), gb = *(const u32x4*)(prow + C_GB + c0);
                    const unsigned gaw[4] = {ga.x, ga.y, ga.z, ga.w}, gbw[4] = {gb.x, gb.y, gb.z, gb.w};
#pragma unroll
                    for (int q = 0; q < 4; ++q) {
                        const float r0 = (1.0f + __expf(-bflo(gbw[q]))) / (1.0f + __expf(-bflo(gaw[q]))), r1 = (1.0f + __expf(-bfhi(gbw[q]))) / (1.0f + __expf(-bfhi(gaw[q])));
                        acc[ai][bj][m][q >> 1][(q & 1) * 2] *= r0; acc[ai][bj][m][q >> 1][(q & 1) * 2 + 1] *= r1;
                    }
                }
            }
    }
    __device__ __forceinline__ void operator()(const f32x4 (&acc)[2][2][4][2], const Unit& u, int wr, int wc, int fr, int fq) const {
        using namespace mk;
        const bool tail = (u.pm == 64); const int gcol = (tail && u.k0 < 512) ? C_GA : C_GB;
#pragma unroll
        for (int ai = 0; ai < 2; ++ai)
#pragma unroll
            for (int m = 0; m < 4; ++m) {
                const int row = u.pm * BM + ai * HALF + wr * 64 + m * 16 + fr;
                const bf16_t* prow = P + (size_t)row * PST;
#pragma unroll
                for (int bj = 0; bj < 2; ++bj) {
                    const int c0 = u.pn * BM + bj * HALF + wc * 32 + 8 * fq;
                    const u32x4 g = *(const u32x4*)(prow + gcol + c0);
                    f32x4 v0 = acc[ai][bj][m][0], v1 = acc[ai][bj][m][1];
                    v0[0] *= sigm(bflo(g.x)); v0[1] *= sigm(bfhi(g.x)); v0[2] *= sigm(bflo(g.y)); v0[3] *= sigm(bfhi(g.y));
                    v1[0] *= sigm(bflo(g.z)); v1[1] *= sigm(bfhi(g.z)); v1[2] *= sigm(bflo(g.w)); v1[3] *= sigm(bfhi(g.w));
                    if (tail) { float* pp = PART + ((size_t)(u.k0 >> 8) * 256 + (row - 64 * BM)) * D + c0; *(f32x4*)pp = v0; *(f32x4*)(pp + 4) = v1; }
                    else *(u32x4*)(O + (size_t)row * D + c0) = pack8(v0, v1);
                }
            }
    }
};
struct EpiResid {
    static constexpr bool PERM = true, AFTER_DRAIN = false; static constexpr int MID_T = 0;
    float* X; float* PART; int ksz;
    __device__ __forceinline__ void operator()(const f32x4 (&acc)[2][2][4][2], const Unit& u, int wr, int wc, int fr, int fq) const {
        using namespace mk;
#pragma unroll
        for (int ai = 0; ai < 2; ++ai)
#pragma unroll
            for (int m = 0; m < 4; ++m) {
                const int row = u.pm * BM + ai * HALF + wr * 64 + m * 16 + fr;
#pragma unroll
                for (int bj = 0; bj < 2; ++bj) {
                    const int c0 = u.pn * BM + bj * HALF + wc * 32 + 8 * fq;
                    float* x = X + (size_t)row * D + c0;
                    const f32x4 a0 = acc[ai][bj][m][0], a1 = acc[ai][bj][m][1];
                    if (u.pm == 64) {
                        float* pp = PART + ((size_t)(u.k0 / ksz) * 256 + (row - 64 * BM)) * D + c0;
                        *(f32x4*)pp = a0; *(f32x4*)(pp + 4) = a1;
                    } else {
                        const f32x4 x0 = *(const f32x4*)x, x1 = *(const f32x4*)(x + 4);
                        *(f32x4*)x = x0 + a0; *(f32x4*)(x + 4) = x1 + a1;
                    }
                }
            }
    }
};
struct EpiUp {
    static constexpr bool PERM = true, AFTER_DRAIN = false; static constexpr int MID_T = 0;
    bf16_t* H;
    __device__ __forceinline__ void operator()(const f32x4 (&acc)[2][2][4][2], const Unit& u, int wr, int wc, int fr, int fq) const {
        using namespace mk;
#pragma unroll
        for (int ai = 0; ai < 2; ++ai)
#pragma unroll
            for (int m = 0; m < 4; ++m) {
                const int row = u.pm * BM + ai * HALF + wr * 64 + m * 16 + fr;
#pragma unroll
                for (int bj = 0; bj < 2; ++bj) {
                    const int c0 = u.pn * BM + bj * HALF + wc * 32 + 8 * fq;
                    f32x4 v0 = acc[ai][bj][m][0], v1 = acc[ai][bj][m][1];
#pragma unroll
                    for (int j = 0; j < 4; ++j) { const float a = fmaxf(v0[j], 0.f), b = fmaxf(v1[j], 0.f); v0[j] = a * a; v1[j] = b * b; }
                    *(u32x4*)(H + (size_t)row * FF + c0) = pack8(v0, v1);
                }
            }
    }
};
template <class Epi, class Sched, bool ALIGN_EPI = false, bool SP2 = false>
__device__ __forceinline__ void gemm_phase(PG8_LAS unsigned char* lds, const Gemm g, const Sched& S, const Epi& E) {
    int tid_ = threadIdx.x; asm volatile("" : "+v"(tid_));
    const int tid = tid_, wid = __builtin_amdgcn_readfirstlane(tid >> 6), lane = tid & 63, wr = wid >> 2, wc = wid & 3, fr = lane & 15, fq = lane >> 4;
    const int K = g.K; int nt = K / BK;
    unsigned voffA[2], voffB[2];
#pragma unroll
    for (int i = 0; i < 2; ++i) { int R, C; stage_rc(tid * 16 + i * 8192, R, C); const int Rb = Epi::PERM ? ((R & ~31) + perm32(R & 31)) : R;
        voffA[i] = (unsigned)(R * K + C) * 2u; voffB[i] = (unsigned)(Rb * K + C) * 2u; }
    const size_t kstep = (size_t)(BK * 2);
    const size_t hstep = (size_t)HALF * K * 2;
    const size_t tstep = 2 * hstep;
    const unsigned ldsw = (unsigned)wid * 1024u;
    const int aoff = lds_byte(wr * 64 + fr, fq * 8), boff = lds_byte(wc * 32 + fr, fq * 8);
#define PG8_SA(b, h) (((b) * 2 + (h)) * HTB)
#define PG8_SB(b, h) ((4 + (b) * 2 + (h)) * HTB)
#define PG8_STAGE(bufoff, gbase, voff) do { _Pragma("unroll") for (int _i = 0; _i < 2; ++_i) \
        __builtin_amdgcn_global_load_lds((const unsigned*)((const char*)(gbase) + (voff)[_i]), (PG8_LAS unsigned*)(lds + (bufoff) + ldsw + _i * 8192), 16, 0, 0); } while (0)
#define PG8_LDA(dst, b, h) do { _Pragma("unroll") for (int m = 0; m < 4; ++m) _Pragma("unroll") for (int k = 0; k < 2; ++k) dst[m][k] = *(const PG8_LAS bf16x8*)(lds + PG8_SA(b, h) + aoff + m * 2048 + k * 1024); } while (0)
#define PG8_LDB(dst, b, h) do { _Pragma("unroll") for (int n = 0; n < 2; ++n) _Pragma("unroll") for (int k = 0; k < 2; ++k) dst[n][k] = *(const PG8_LAS bf16x8*)(lds + PG8_SB(b, h) + boff + n * 2048 + k * 1024); } while (0)
#define PG8_MMA(ai, bj, At, Bt) do { __builtin_amdgcn_s_setprio(1); _Pragma("unroll") for (int m = 0; m < 4; ++m) _Pragma("unroll") for (int n = 0; n < 2; ++n) _Pragma("unroll") for (int k = 0; k < 2; ++k) \
        acc[ai][bj][m][n] = __builtin_amdgcn_mfma_f32_16x16x32_bf16(Bt[n][k], At[m][k], acc[ai][bj][m][n], 0, 0, 0); __builtin_amdgcn_s_setprio(0); } while (0)
#define PG8_WAIT_V(n) asm volatile("s_waitcnt vmcnt(" #n ")" ::: "memory")
#define PG8_WAIT_L(n) asm volatile("s_waitcnt lgkmcnt(" #n ")" ::: "memory")
#define PG8_BAR __builtin_amdgcn_s_barrier()
#define PG8_SCHED __builtin_amdgcn_sched_barrier(0)
    Unit cur, nxt; int ui = 0;
    if (!S.next(0, cur)) return;
    f32x4 acc[2][2][4][2];
#pragma unroll
    for (int a = 0; a < 2; ++a)
#pragma unroll
        for (int b = 0; b < 2; ++b)
#pragma unroll
            for (int m = 0; m < 4; ++m)
#pragma unroll
                for (int n = 0; n < 2; ++n) acc[a][b][m][n] = (f32x4){0.f, 0.f, 0.f, 0.f};
    bf16x8 At[4][2], B0[2][2], B1[2][2];
    const char* cA = (const char*)g.A + (size_t)cur.pm * tstep + (size_t)cur.k0 * 2; const char* cB = (const char*)g.Bt + (size_t)cur.pn * tstep + (size_t)cur.k0 * 2;
    if (cur.nt) nt = cur.nt;
    S.a_ready(cur);
    if constexpr (SP2) {
        PG8_STAGE(PG8_SB(0, 0), cB, voffB); PG8_STAGE(PG8_SB(0, 1), cB + hstep, voffB); PG8_STAGE(PG8_SA(0, 0), cA, voffA); PG8_STAGE(PG8_SA(0, 1), cA + hstep, voffA);
        if (wr == 1) PG8_BAR;
        PG8_WAIT_V(2); PG8_BAR;
        PG8_STAGE(PG8_SB(1, 0), cB + kstep, voffB); PG8_STAGE(PG8_SA(1, 0), cA + kstep, voffA); PG8_STAGE(PG8_SB(1, 1), cB + hstep + kstep, voffB);
        PG8_WAIT_V(6); PG8_BAR;
    } else {
        PG8_STAGE(PG8_SB(0, 0), cB, voffB); PG8_STAGE(PG8_SA(0, 0), cA, voffA); PG8_STAGE(PG8_SB(0, 1), cB + hstep, voffB); PG8_STAGE(PG8_SA(0, 1), cA + hstep, voffA);
        if (wr == 1) PG8_BAR;
        PG8_WAIT_V(4); PG8_BAR;
        PG8_STAGE(PG8_SB(1, 0), cB + kstep, voffB); PG8_STAGE(PG8_SA(1, 0), cA + kstep, voffA); PG8_STAGE(PG8_SB(1, 1), cB + hstep + kstep, voffB);
        PG8_WAIT_V(6); PG8_BAR;
    }
    for (;;) {
        const bool has_next = S.next(ui + 1, nxt);
        const char* nA = has_next ? (const char*)g.A + (size_t)nxt.pm * tstep + (size_t)nxt.k0 * 2 : cA; const char* nB = has_next ? (const char*)g.Bt + (size_t)nxt.pn * tstep + (size_t)nxt.k0 * 2 : cB;
        for (int t = 0; t < nt; t += 2) {
            if constexpr (Epi::MID_T > 0) { if (t == Epi::MID_T && nt > Epi::MID_T) E.mid(acc, cur, wr, wc, fr, fq); }
            const bool last = (t == nt - 2);
            const char* a1 = cA + (size_t)(t + 1) * kstep;
            const char* a2 = last ? nA : cA + (size_t)(t + 2) * kstep; const char* b2 = last ? nB : cB + (size_t)(t + 2) * kstep;
            const char* a3 = a2 + kstep; const char* b3 = b2 + kstep;
            if (last && has_next) S.a_ready(nxt);
            if constexpr (SP2) {
            PG8_LDB(B0, 0, 0); PG8_LDB(B1, 0, 1); PG8_SCHED; PG8_LDA(At, 0, 0); PG8_STAGE(PG8_SA(1, 1), a1 + hstep, voffA);
            PG8_WAIT_V(8); PG8_WAIT_L(0); PG8_BAR; PG8_MMA(0, 0, At, B0); PG8_MMA(0, 1, At, B1); PG8_BAR; PG8_SCHED;
            PG8_LDA(At, 0, 1); PG8_STAGE(PG8_SB(0, 0), b2, voffB); PG8_STAGE(PG8_SB(0, 1), b2 + hstep, voffB); PG8_STAGE(PG8_SA(0, 0), a2, voffA);
            PG8_WAIT_V(8); PG8_WAIT_L(0); PG8_BAR; PG8_MMA(1, 0, At, B0); PG8_MMA(1, 1, At, B1); PG8_BAR; PG8_SCHED;
            PG8_LDB(B0, 1, 0); PG8_LDB(B1, 1, 1); PG8_SCHED; PG8_LDA(At, 1, 0); PG8_STAGE(PG8_SA(0, 1), a2 + hstep, voffA);
            PG8_WAIT_V(8); PG8_WAIT_L(0); PG8_BAR; PG8_MMA(0, 0, At, B0); PG8_MMA(0, 1, At, B1); PG8_BAR; PG8_SCHED;
            PG8_LDA(At, 1, 1); PG8_STAGE(PG8_SB(1, 0), b3, voffB); PG8_STAGE(PG8_SB(1, 1), b3 + hstep, voffB); PG8_STAGE(PG8_SA(1, 0), a3, voffA);
            PG8_WAIT_V(8); PG8_WAIT_L(0); PG8_BAR; PG8_MMA(1, 0, At, B0); PG8_MMA(1, 1, At, B1); PG8_BAR; PG8_SCHED;
            } else {
            PG8_LDB(B0, 0, 0); PG8_SCHED; PG8_LDA(At, 0, 0); PG8_STAGE(PG8_SA(1, 1), a1 + hstep, voffA);
            PG8_WAIT_L(8); PG8_BAR; PG8_WAIT_L(0); PG8_MMA(0, 0, At, B0); PG8_BAR; PG8_SCHED;
            PG8_LDB(B1, 0, 1); PG8_STAGE(PG8_SB(0, 0), b2, voffB);
            PG8_BAR; PG8_WAIT_L(0); PG8_MMA(0, 1, At, B1); PG8_BAR;
            PG8_LDA(At, 0, 1); PG8_STAGE(PG8_SA(0, 0), a2, voffA);
            PG8_BAR; PG8_WAIT_L(0); PG8_MMA(1, 0, At, B0); PG8_BAR; PG8_SCHED;
            PG8_STAGE(PG8_SB(0, 1), b2 + hstep, voffB);
            PG8_WAIT_V(6); PG8_BAR; PG8_MMA(1, 1, At, B1); PG8_BAR;
            PG8_LDB(B0, 1, 0); PG8_SCHED; PG8_LDA(At, 1, 0); PG8_STAGE(PG8_SA(0, 1), a2 + hstep, voffA);
            PG8_WAIT_L(8); PG8_BAR; PG8_WAIT_L(0); PG8_MMA(0, 0, At, B0); PG8_BAR; PG8_SCHED;
            PG8_LDB(B1, 1, 1); PG8_STAGE(PG8_SB(1, 0), b3, voffB);
            PG8_BAR; PG8_WAIT_L(0); PG8_MMA(0, 1, At, B1); PG8_BAR;
            PG8_LDA(At, 1, 1); PG8_STAGE(PG8_SA(1, 0), a3, voffA);
            PG8_BAR; PG8_WAIT_L(0); PG8_MMA(1, 0, At, B0); PG8_BAR; PG8_SCHED;
            PG8_STAGE(PG8_SB(1, 1), b3 + hstep, voffB);
            PG8_WAIT_V(6); PG8_BAR; PG8_MMA(1, 1, At, B1); PG8_BAR;
            }
        }
        if constexpr (ALIGN_EPI) { if (wr == 0) PG8_BAR; }
        if constexpr (!Epi::AFTER_DRAIN) { E(acc, cur, wr, wc, fr, fq); S.done(cur); }
        if (!has_next) break;
#pragma unroll
        for (int a = 0; a < 2; ++a)
#pragma unroll
            for (int b = 0; b < 2; ++b)
#pragma unroll
                for (int m = 0; m < 4; ++m)
#pragma unroll
                    for (int n = 0; n < 2; ++n) acc[a][b][m][n] = (f32x4){0.f, 0.f, 0.f, 0.f};
        cur = nxt; cA = nA; cB = nB; ++ui; nt = cur.nt ? cur.nt : K / BK;
        if constexpr (ALIGN_EPI) { if (wr == 1) PG8_BAR; }
    }
    PG8_WAIT_V(0);
    if constexpr (!ALIGN_EPI) { if (wr == 0) PG8_BAR; }
    PG8_BAR;
    if constexpr (Epi::AFTER_DRAIN) { E.fused(acc, cur, wr, wc, fr, fq, lds, wid, lane); S.done(cur); }
#undef PG8_SA
#undef PG8_SB
#undef PG8_STAGE
#undef PG8_LDA
#undef PG8_LDB
#undef PG8_MMA
#undef PG8_WAIT_V
#undef PG8_WAIT_L
#undef PG8_BAR
#undef PG8_SCHED
}
}

#define LAS __attribute__((address_space(3)))
namespace mk {
typedef unsigned short bf16;
typedef unsigned u32x4 __attribute__((ext_vector_type(4)));
typedef unsigned u32x2 __attribute__((ext_vector_type(2)));
typedef float f32x4 __attribute__((ext_vector_type(4)));
typedef short bf16x8 __attribute__((ext_vector_type(8)));
constexpr int NT = 512;

__device__ __forceinline__ unsigned f2bf(float f) { unsigned u = __builtin_bit_cast(unsigned, f); return (u + 0x7fffu + ((u >> 16) & 1u)) >> 16; }
__device__ __forceinline__ unsigned pk2(float lo, float hi) { return f2bf(lo) | (f2bf(hi) << 16); }
__device__ __forceinline__ float bf2f(unsigned h) { return __uint_as_float(h << 16); }
__device__ __forceinline__ float bflo(unsigned w) { return __uint_as_float(w << 16); }
__device__ __forceinline__ float bfhi(unsigned w) { return __uint_as_float(w & 0xffff0000u); }
__device__ __forceinline__ float wave_sum(float v) {
#pragma unroll
    for (int o = 1; o < 64; o <<= 1) v += __shfl_xor(v, o);
    return v;
}
__device__ __forceinline__ float wave_max(float v) {
#pragma unroll
    for (int o = 1; o < 64; o <<= 1) v = fmaxf(v, __shfl_xor(v, o));
    return v;
}
__device__ __forceinline__ float logsig(float x) { return fminf(x, 0.f) - __logf(1.0f + __expf(-fabsf(x))); }

#ifdef MK_SECT
#define PT(i) do { if (tid == 0) { LAS unsigned long long* pt_ = (LAS unsigned long long*)(lds + LDS_BYTES - 256); const unsigned long long n_ = __builtin_amdgcn_s_memrealtime(); pt_[1 + (i)] += n_ - pt_[0]; pt_[0] = n_; } } while (0)
#define PT_RESET() do { if (tid == 0) { ((LAS unsigned long long*)(lds + LDS_BYTES - 256))[0] = __builtin_amdgcn_s_memrealtime(); } } while (0)
#else
#define PT(i) do { } while (0)
#define PT_RESET() do { } while (0)
#endif
struct Args { const float* in[20]; float* out; unsigned char* ws; int ph_lo, ph_hi; };

__device__ __forceinline__ int win_dst(int n) { return n < 1792 ? n : (n < 1808 ? C_GLR + (n - 1792) : n - 16); }
template <bool MAP>
__device__ __forceinline__ void transpose_item(const float* W, int K, int N, bf16* WT, LAS float* scr, int item, int lane, int ldk = 0) {
    if (ldk == 0) ldk = K;
    const int nblk = (N + 31) / 32, kb = item / nblk, nb = item % nblk, k0 = 64 * kb, n0 = 32 * nb;
    const int ncol = n0 + (lane & 31);
    float wv[32];
    const float* wp = W + (size_t)(k0 + (lane >> 5)) * N + (ncol < N ? ncol : N - 1);
#pragma unroll
    for (int i = 0; i < 32; ++i) wv[i] = wp[(size_t)(2 * i) * N];
#pragma unroll
    for (int i = 0; i < 32; ++i) { const int kk = 2 * i + (lane >> 5); scr[kk * 33 + (lane & 31)] = (ncol < N) ? wv[i] : 0.f; }
    asm volatile("s_waitcnt lgkmcnt(0)" ::: "memory");
    const int c = lane & 7;
#pragma unroll
    for (int j = 0; j < 4; ++j) { const int n = (lane >> 3) + 8 * j; const LAS float* s = scr + (8 * c) * 33 + n;
        u32x4 o; o.x = pk2(s[0 * 33], s[1 * 33]); o.y = pk2(s[2 * 33], s[3 * 33]); o.z = pk2(s[4 * 33], s[5 * 33]); o.w = pk2(s[6 * 33], s[7 * 33]);
        const int nsrc = n0 + n;
        if (nsrc < N) { const int nd = MAP ? win_dst(nsrc) : nsrc; *(u32x4*)(WT + (size_t)nd * ldk + k0 + 8 * c) = o; } }
    asm volatile("s_waitcnt lgkmcnt(0)" ::: "memory");
}

__device__ __forceinline__ void convert_layer(const Args& a, LAS unsigned char* lds, int tid, int l, int gw, int ngw) {
    const int lane = tid & 63, wave = tid >> 6;
    LAS float* scr = (LAS float*)(lds + wave * 16384);
    bf16* wt = (bf16*)(a.ws + WS_WT) + (size_t)l * WT_LAYER;
    constexpr int I_IN = 16 * 137, I_A = 8 * 32, I_O = 16 * 32, I_U = 16 * 128, I_D = 64 * 32, I_L = I_IN + 2 * I_A + I_O + I_U + I_D;
    for (int it = gw; it < I_L; it += ngw) {
        int r = it;
        if (r < I_IN) { transpose_item<true>(a.in[6] + (size_t)l * 1024 * NIN, 1024, NIN, wt + WT_IN, scr, r, lane); continue; } r -= I_IN;
        if (r < I_A) { transpose_item<false>(a.in[11] + (size_t)l * 512 * 1024, 512, 1024, wt + WT_A, scr, r, lane, 1024); continue; } r -= I_A;
        if (r < I_A) { transpose_item<false>(a.in[12] + (size_t)l * 512 * 1024, 512, 1024, wt + WT_A + 512, scr, r, lane, 1024); continue; } r -= I_A;
        if (r < I_O) { transpose_item<false>(a.in[13] + (size_t)l * 1024 * 1024, 1024, 1024, wt + WT_OUT, scr, r, lane); continue; } r -= I_O;
        if (r < I_U) { transpose_item<false>(a.in[16] + (size_t)l * 1024 * 4096, 1024, 4096, wt + WT_UP, scr, r, lane); continue; } r -= I_U;
        transpose_item<false>(a.in[17] + (size_t)l * 4096 * 1024, 4096, 1024, wt + WT_DOWN, scr, r, lane);
    }
}
__device__ __forceinline__ void p0_prologue(const Args& a, LAS unsigned char* lds, int tid) {
    const int lane = tid & 63, wave = tid >> 6;
    const int gw = blockIdx.x * 8 + wave, NGW = gridDim.x * 8;
    convert_layer(a, lds, tid, 0, gw, NGW);
    float* rope = (float*)(a.ws + WS_ROPE);
    for (int i = blockIdx.x * NT + tid; i < (LP + 1) * 8; i += gridDim.x * NT) {
        const int pi = i >> 3, f = i & 7; const float pos = (pi == LP) ? 8192.f : (float)pi;
        const float inv = powf(500000.0f, -(float)f * 0.125f);
        const float ang = pos * inv;
        const double rev = (double)ang * 0.15915494309189535; const float fr = (float)(rev - rint(rev));
        rope[pi * 16 + f] = __builtin_amdgcn_cosf(fr); rope[pi * 16 + 8 + f] = __builtin_amdgcn_sinf(fr);
    }
    float* X = (float*)(a.ws + WS_X); bf16* ACT = (bf16*)(a.ws + WS_ACT);
    for (int row0 = gw; row0 < MPAD; row0 += 4 * NGW) {
        f32x4 v[4][4];
#pragma unroll
        for (int u = 0; u < 4; ++u) {
            const int row = row0 + u * NGW; const float* src = nullptr;
            if (row < MP) { const int b = row / LP, p = row - b * LP; src = (p < 16) ? a.in[5] + (size_t)p * D : a.in[0] + ((size_t)b * 4096 + (p - 16)) * D; }
            else if (row < MREAL) src = a.in[1] + (size_t)(row - MP) * D;
#pragma unroll
            for (int j = 0; j < 4; ++j) v[u][j] = src ? *((const f32x4*)src + lane + 64 * j) : (f32x4){0.f, 0.f, 0.f, 0.f};
        }
#pragma unroll
        for (int u = 0; u < 4; ++u) {
            const int row = row0 + u * NGW; if (row >= MPAD) continue;
#pragma unroll
            for (int j = 0; j < 4; ++j) {
                *((f32x4*)(X + (size_t)row * D) + lane + 64 * j) = v[u][j] * ALPHA;
                u32x2 w; w.x = pk2(v[u][j].x, v[u][j].y); w.y = pk2(v[u][j].z, v[u][j].w);
                *((u32x2*)(ACT + (size_t)row * D) + lane + 64 * j) = w;
            }
        }
    }
}

__device__ __forceinline__ void ln_pair(const Args& a, const f32x4 (&gv)[4], const f32x4 (&bv)[4], bool last, int nsplit, int row0, int row1, bool has1, int lane) {
    float* X = (float*)(a.ws + WS_X); bf16* ACT = (bf16*)(a.ws + WS_ACT);
    f32x4 v[2][4];
#pragma unroll
    for (int j = 0; j < 4; ++j) { v[0][j] = *((const f32x4*)(X + (size_t)row0 * D) + lane + 64 * j); v[1][j] = has1 ? *((const f32x4*)(X + (size_t)row1 * D) + lane + 64 * j) : (f32x4){0.f, 0.f, 0.f, 0.f}; }
    if (row0 >= 64 * 256 || (has1 && row1 >= 64 * 256)) {
        const float* PART = (const float*)(a.ws + WS_PART);
        for (int s = 0; s < nsplit; ++s) {
#pragma unroll
            for (int j = 0; j < 4; ++j) {
                if (row0 >= 64 * 256) v[0][j] += *((const f32x4*)(PART + ((size_t)s * 256 + (row0 - 64 * 256)) * D) + lane + 64 * j);
                if (has1 && row1 >= 64 * 256) v[1][j] += *((const f32x4*)(PART + ((size_t)s * 256 + (row1 - 64 * 256)) * D) + lane + 64 * j);
            }
        }
    }
#pragma unroll
    for (int u = 0; u < 2; ++u) {
        const int row = u ? row1 : row0;
        float s = 0.f;
#pragma unroll
        for (int j = 0; j < 4; ++j) s += (v[u][j].x + v[u][j].y) + (v[u][j].z + v[u][j].w);
        const float mean = wave_sum(s) * (1.f / D); float s2 = 0.f;
#pragma unroll
        for (int j = 0; j < 4; ++j) { v[u][j] = v[u][j] - mean; s2 += (v[u][j].x * v[u][j].x + v[u][j].y * v[u][j].y) + (v[u][j].z * v[u][j].z + v[u][j].w * v[u][j].w); }
        const float rstd = 1.f / sqrtf(wave_sum(s2) * (1.f / D) + 1e-5f);
        if (u == 1 && !has1) continue;
        float* yo = nullptr;
        if (last) { if (row >= MP) yo = a.out + O_YS + (size_t)(row - MP) * D; else { const int b = row / LP, p = row - b * LP; if (p >= 16) yo = a.out + O_YP + ((size_t)b * 4096 + (p - 16)) * D; } }
#pragma unroll
        for (int j = 0; j < 4; ++j) {
            const f32x4 o = v[u][j] * rstd * gv[j] + bv[j];
            if (last) { if (yo) *((f32x4*)yo + lane + 64 * j) = o; }
            else { *((f32x4*)(X + (size_t)row * D) + lane + 64 * j) = o * ALPHA; u32x2 w; w.x = pk2(o.x, o.y); w.y = pk2(o.z, o.w); *((u32x2*)(ACT + (size_t)row * D) + lane + 64 * j) = w; }
        }
    }
}
__device__ __forceinline__ void ln_phase(const Args& a, const float* g, const float* bt, bool last, int nsplit, int tid) {
    const int lane = tid & 63, wave = tid >> 6;
    const int gw = blockIdx.x * 8 + wave, NGW = gridDim.x * 8;
    f32x4 gv[4], bv[4];
#pragma unroll
    for (int j = 0; j < 4; ++j) { gv[j] = *((const f32x4*)g + lane + 64 * j); bv[j] = *((const f32x4*)bt + lane + 64 * j); }
#pragma unroll 2
    for (int row0 = gw; row0 < MREAL; row0 += 2 * NGW) ln_pair(a, gv, bv, last, nsplit, row0, row0 + NGW, row0 + NGW < MREAL, lane);
}
__device__ __forceinline__ void wait_count(unsigned* p, unsigned need, int tid) {
    if (tid < 64) {
        const unsigned long long t0 = __builtin_amdgcn_s_memrealtime();
        while ((unsigned)__builtin_amdgcn_readfirstlane(__hip_atomic_load(p, __ATOMIC_RELAXED, __HIP_MEMORY_SCOPE_AGENT)) < need) {
            if (__builtin_amdgcn_s_memrealtime() - t0 > 2000000ull) break;
            __builtin_amdgcn_s_sleep(2);
        }
        __builtin_amdgcn_fence(__ATOMIC_ACQUIRE, "agent");
        asm volatile("s_waitcnt vmcnt(0)" ::: "memory");
    }
    __syncthreads();
}
__device__ __forceinline__ void ln_exchange(const Args& a, unsigned* cnt, int cu, int S, const float* g, const float* bt, bool last, int tid) {
    const int lane = tid & 63, wave = tid >> 6;
    pg8::StaticOrder so; so.init(64 * 256, 1024, (int)gridDim.x, cu); pg8::Unit um; so.next(0, um);
    const bool has_tail = um.pm < S;
    asm volatile("s_waitcnt vmcnt(0)" ::: "memory");
    __syncthreads();
    if (tid == 0) {
        __builtin_amdgcn_fence(__ATOMIC_RELEASE, "agent");
        asm volatile("s_waitcnt vmcnt(0)" ::: "memory");
        __hip_atomic_fetch_add(cnt + 64 * um.pm, 1u, __ATOMIC_RELAXED, __HIP_MEMORY_SCOPE_AGENT);
        if (has_tail) __hip_atomic_fetch_add(cnt + 64 * 64, 1u, __ATOMIC_RELAXED, __HIP_MEMORY_SCOPE_AGENT);
    }
    f32x4 gv[4], bv[4];
#pragma unroll
    for (int j = 0; j < 4; ++j) { gv[j] = *((const f32x4*)g + lane + 64 * j); bv[j] = *((const f32x4*)bt + lane + 64 * j); }
    wait_count(cnt + 64 * um.pm, 4u, tid);
    const int rbase = um.pm * 256 + um.pn * 64 + wave;
#pragma unroll 1
    for (int i = 0; i < 8; i += 2) ln_pair(a, gv, bv, last, 0, rbase + 8 * i, rbase + 8 * i + 8, true, lane);
    if (has_tail) {
        wait_count(cnt + 64 * 64, 4u * (unsigned)S, tid);
        const int L = um.pm * 4 + um.pn, r = L + 4 * S * wave;
        if (r < MREAL - 64 * 256) ln_pair(a, gv, bv, last, S, 64 * 256 + r, 0, false, lane);
    }
}

__device__ __forceinline__ void attn_item(LAS unsigned char* lds, const bf16* P, bf16* MIXA, const float* sinkp, int b, int n, int h0, int tid) {
    LAS bf16* Ks = (LAS bf16*)lds;
    LAS bf16* Vt = (LAS bf16*)(lds + 36864);
    const int kvh = h0 >> 2, lane = tid & 63, w = tid >> 6, fr = lane & 15, fq = lane >> 4;
    for (int i = tid; i < 64 * 24; i += NT) Vt[(i / 24) * 280 + 256 + (i % 24)] = 0;
#pragma unroll
    for (int i = 0; i < 4; ++i) {
        const int q = tid + NT * i, key = q >> 3, part = q & 7, slot = (n - 1) * 128 + key;
        const bf16* src = P + (size_t)(b * LP + (slot >= 112 ? slot - 112 : 0)) * PST;
        u32x4 kv = *(const u32x4*)(src + C_K + kvh * 64 + part * 8), vv = *(const u32x4*)(src + C_V + kvh * 64 + part * 8);
        if (slot < 112) { kv = (u32x4){0u, 0u, 0u, 0u}; vv = (u32x4){0u, 0u, 0u, 0u}; }
        *(LAS u32x4*)(Ks + key * 72 + part * 8) = kv;
        LAS bf16* vd = Vt + (part * 8) * 280 + key;
        vd[0 * 280] = (bf16)(vv.x & 0xffffu); vd[1 * 280] = (bf16)(vv.x >> 16); vd[2 * 280] = (bf16)(vv.y & 0xffffu); vd[3 * 280] = (bf16)(vv.y >> 16);
        vd[4 * 280] = (bf16)(vv.z & 0xffffu); vd[5 * 280] = (bf16)(vv.z >> 16); vd[6 * 280] = (bf16)(vv.w & 0xffffu); vd[7 * 280] = (bf16)(vv.w >> 16);
    }
    const int qi = 16 * w + fr, slotq = n * 128 + qi; const bool qv = slotq >= 112;
    const size_t qrow = (size_t)(b * LP + (qv ? slotq - 112 : 0));
    bf16x8 qf2[2][2];
#pragma unroll
    for (int hh = 0; hh < 2; ++hh)
#pragma unroll
        for (int kk = 0; kk < 2; ++kk) { qf2[hh][kk] = *(const bf16x8*)(P + qrow * PST + (h0 + hh) * 64 + kk * 32 + 8 * fq); if (!qv) qf2[hh][kk] = (bf16x8){0, 0, 0, 0, 0, 0, 0, 0}; }
    const float sink2[2] = {sinkp[0], sinkp[1]};
    __syncthreads();
#pragma unroll
    for (int hh = 0; hh < 2; ++hh) {
    const int h = h0 + hh; const float sink = sink2[hh]; const bf16x8 qf[2] = {qf2[hh][0], qf2[hh][1]};
    f32x4 s[9];
#pragma unroll
    for (int r = 0; r < 9; ++r) {
        f32x4 acc = (f32x4){0.f, 0.f, 0.f, 0.f};
#pragma unroll
        for (int kk = 0; kk < 2; ++kk) { const bf16x8 kf = *(const LAS bf16x8*)(Ks + ((w + r) * 16 + fr) * 72 + kk * 32 + 8 * fq); acc = __builtin_amdgcn_mfma_f32_16x16x32_bf16(kf, qf[kk], acc, 0, 0, 0); }
        s[r] = acc;
    }
    float mx = sink;
#pragma unroll
    for (int r = 0; r < 9; ++r)
#pragma unroll
        for (int j = 0; j < 4; ++j) {
            const int dl = 16 * r + 4 * fq + j - fr, slotk = (n - 1) * 128 + 16 * (w + r) + 4 * fq + j;
            const bool ok = dl > 0 && dl <= 128 && slotk >= 112;
            const float v = ok ? s[r][j] * 0.125f : -INFINITY; s[r][j] = v; mx = fmaxf(mx, v);
        }
    mx = fmaxf(mx, __shfl_xor(mx, 16)); mx = fmaxf(mx, __shfl_xor(mx, 32));
    float sum = 0.f;
#pragma unroll
    for (int r = 0; r < 9; ++r)
#pragma unroll
        for (int j = 0; j < 4; ++j) { const float p = __expf(s[r][j] - mx); s[r][j] = p; sum += p; }
    sum += __shfl_xor(sum, 16); sum += __shfl_xor(sum, 32);
    const float rden = 1.0f / (sum + __expf(sink - mx));
    f32x4 o[4];
#pragma unroll
    for (int dt = 0; dt < 4; ++dt) o[dt] = (f32x4){0.f, 0.f, 0.f, 0.f};
#pragma unroll
    for (int ks = 0; ks < 5; ++ks) {
        u32x4 pw; pw.x = pk2(s[2 * ks][0], s[2 * ks][1]); pw.y = pk2(s[2 * ks][2], s[2 * ks][3]);
        if (ks < 4) { pw.z = pk2(s[2 * ks + 1 > 8 ? 8 : 2 * ks + 1][0], s[2 * ks + 1 > 8 ? 8 : 2 * ks + 1][1]); pw.w = pk2(s[2 * ks + 1 > 8 ? 8 : 2 * ks + 1][2], s[2 * ks + 1 > 8 ? 8 : 2 * ks + 1][3]); }
        else { pw.z = 0u; pw.w = 0u; }
        const bf16x8 pf = __builtin_bit_cast(bf16x8, pw);
        const int keyb = 16 * (w + 2 * ks) + 4 * fq;
#pragma unroll
        for (int dt = 0; dt < 4; ++dt) {
            const LAS bf16* vp = Vt + (dt * 16 + fr) * 280 + keyb;
            const u32x2 lo = *(const LAS u32x2*)vp, hi = *(const LAS u32x2*)(vp + 16);
            u32x4 vw; vw.x = lo.x; vw.y = lo.y; vw.z = hi.x; vw.w = hi.y;
            o[dt] = __builtin_amdgcn_mfma_f32_16x16x32_bf16(__builtin_bit_cast(bf16x8, vw), pf, o[dt], 0, 0, 0);
        }
    }
    if (qv) {
#pragma unroll
        for (int dt = 0; dt < 4; ++dt) { u32x2 w2; w2.x = pk2(o[dt][0] * rden, o[dt][1] * rden); w2.y = pk2(o[dt][2] * rden, o[dt][3] * rden);
            *(u32x2*)(MIXA + qrow * 1024 + h * 64 + dt * 16 + 4 * fq) = w2; }
    }
    }
}

__device__ __forceinline__ void sattn_item(LAS unsigned char* lds, const Args& a, int layer, int s, int tid) {
    LAS float* Kf = (LAS float*)lds;
    LAS float* Vf = Kf + 16384;
    LAS float* qs = Vf + 16384;
    LAS float* ps = qs + 512;
    const bf16* P = (const bf16*)(a.ws + WS_P);
    bf16* MIXA = (bf16*)(a.ws + WS_MIXA);
    const float* ck = a.in[2] + (size_t)(layer * NS + s) * 16384; const float* cv = a.in[3] + (size_t)(layer * NS + s) * 16384;
    float* ok = a.out + O_KWS + (size_t)(layer * NS + s) * 16384; float* ov = a.out + O_VWS + (size_t)(layer * NS + s) * 16384;
    for (int f4 = tid; f4 < 128 * 32; f4 += NT) {
        const int f = f4 * 4, r = f >> 7, rem = f & 127, li = (rem >> 6) * 8192 + r * 64 + (rem & 63);
        f32x4 kv, vv;
        if (r < 127) { kv = *(const f32x4*)(ck + 128 + f); vv = *(const f32x4*)(cv + 128 + f); *(f32x4*)(ok + f) = kv; *(f32x4*)(ov + f) = vv; }
        else { kv = *(const f32x4*)(ok + f); vv = *(const f32x4*)(ov + f); }
        *(LAS f32x4*)(Kf + li) = kv; *(LAS f32x4*)(Vf + li) = vv;
    }
    const int row = MP + s, h = tid >> 6, lane = tid & 63, kvh = h >> 2;
    qs[tid] = bf2f(P[(size_t)row * PST + tid]);
    __syncthreads();
    const float sink = a.in[9][layer * 8 + h];
    float s0 = 0.f, s1 = 0.f;
    const LAS float* k0 = Kf + kvh * 8192 + lane * 64; const LAS float* k1 = k0 + 64 * 64;
#pragma unroll 8
    for (int d = 0; d < 64; ++d) { const int dd = (d + lane) & 63; const float q = qs[h * 64 + dd]; s0 += q * k0[dd]; s1 += q * k1[dd]; }
    s0 *= 0.125f; s1 *= 0.125f;
    const float mx = fmaxf(wave_max(fmaxf(s0, s1)), sink);
    const float p0 = __expf(s0 - mx), p1 = __expf(s1 - mx);
    const float rden = 1.0f / (wave_sum(p0 + p1) + __expf(sink - mx));
    ps[h * 128 + lane] = p0; ps[h * 128 + 64 + lane] = p1;
    __syncthreads();
    float o = 0.f;
    const LAS float* vb = Vf + kvh * 8192 + lane;
#pragma unroll 8
    for (int r = 0; r < 128; ++r) o += ps[h * 128 + r] * vb[r * 64];
    MIXA[(size_t)row * 1024 + tid] = (bf16)f2bf(o * rden);
}

__device__ __forceinline__ void gla_prep(LAS float* tot, const Args& a, int layer, int h, int rowbase  , int tvalid0, int tid, float (&cum)[8]) {
    const bf16* P = (const bf16*)(a.ws + WS_P);
    const int d = tid & 63, tg = tid >> 6;
    float wa[16];
#pragma unroll
    for (int r = 0; r < 16; ++r) wa[r] = a.in[7][(size_t)(layer * 16 + r) * 256 + h * 64 + d];
    const float ba = a.in[8][layer * 256 + h * 64 + d];
    float run = 0.f;
    u32x4 g0a[8], g1a[8];
#pragma unroll
    for (int i = 0; i < 8; ++i) { const int t = tg * 8 + i; const u32x4* gp = (const u32x4*)(P + (size_t)(rowbase + (t >= tvalid0 ? t : tvalid0)) * PST + C_GLR); g0a[i] = gp[0]; g1a[i] = gp[1]; }
#pragma unroll
    for (int i = 0; i < 8; ++i) {
        const int t = tg * 8 + i; float la = 0.f;
        const u32x4 g0 = g0a[i], g1 = g1a[i];
        {
            float x = ba;
            x += bflo(g0.x) * wa[0] + bfhi(g0.x) * wa[1] + bflo(g0.y) * wa[2] + bfhi(g0.y) * wa[3] + bflo(g0.z) * wa[4] + bfhi(g0.z) * wa[5] + bflo(g0.w) * wa[6] + bfhi(g0.w) * wa[7];
            x += bflo(g1.x) * wa[8] + bfhi(g1.x) * wa[9] + bflo(g1.y) * wa[10] + bfhi(g1.y) * wa[11] + bflo(g1.z) * wa[12] + bfhi(g1.z) * wa[13] + bflo(g1.w) * wa[14] + bfhi(g1.w) * wa[15];
            la = (t >= tvalid0) ? logsig(x) * (1.0f / 16.0f) : 0.f;
        }
        run += la; cum[i] = run;
    }
    tot[tg * 64 + d] = run;
    __syncthreads();
    float pre = 0.f;
#pragma unroll
    for (int g = 0; g < 8; ++g) pre += (g < tg) ? tot[g * 64 + d] : 0.f;
#pragma unroll
    for (int i = 0; i < 8; ++i) cum[i] += pre;
}

constexpr size_t O_KVL = O_YP, O_S0T = O_YP + (size_t)16 * NCH * 8192;
static_assert(O_S0T + (size_t)16 * NCH * 8192 / 2 <= O_YS, "GLA scratch fits in y_prompt");

__device__ __forceinline__ void gla_stage_vt(LAS bf16* VT, const bf16* P, int rowbase, int h, int tv0, int tid) {
    const int e = tid & 127, tq = tid >> 7;
    unsigned w[8];
#pragma unroll
    for (int i = 0; i < 8; ++i) {
        const int t0 = tq * 16 + 2 * i;
        unsigned lo = P[(size_t)(rowbase + (t0 >= tv0 ? t0 : tv0)) * PST + C_GV + h * 128 + e];
        unsigned hi = P[(size_t)(rowbase + (t0 + 1 >= tv0 ? t0 + 1 : tv0)) * PST + C_GV + h * 128 + e];
        lo = (t0 >= tv0) ? lo : 0u; hi = (t0 + 1 >= tv0) ? hi : 0u;
        w[i] = lo | (hi << 16);
    }
    LAS u32x4* dst = (LAS u32x4*)(VT + e * 72 + tq * 16);
    dst[0] = (u32x4){w[0], w[1], w[2], w[3]}; dst[1] = (u32x4){w[4], w[5], w[6], w[7]};
}

__device__ __forceinline__ void gla1_item(LAS unsigned char* lds, const Args& a, int layer, int bh, int c, int tid) {
    LAS float* tot = (LAS float*)lds;
    LAS bf16* KlT = (LAS bf16*)(lds + 2048);
    LAS bf16* VT = (LAS bf16*)(lds + 2048 + 9216);
    const bf16* P = (const bf16*)(a.ws + WS_P);
    const int b = bh >> 2, h = bh & 3, rowbase = b * LP + 64 * c - 112, tv0 = (c == 1) ? 48 : 0;
    const int d = tid & 63, tg = tid >> 6;
    float kraw[8];
#pragma unroll
    for (int i = 0; i < 8; ++i) { const int t = tg * 8 + i; kraw[i] = bf2f(P[(size_t)(rowbase + (t >= tv0 ? t : tv0)) * PST + C_GK + h * 64 + d]); }
    gla_stage_vt(VT, P, rowbase, h, tv0, tid);
    float cum[8];
    gla_prep(tot, a, layer, h, rowbase, tv0, tid, cum);
    float bl = 0.f;
#pragma unroll
    for (int g = 0; g < 8; ++g) bl += tot[g * 64 + d];
    {
        float kl[8];
#pragma unroll
        for (int i = 0; i < 8; ++i) { const int t = tg * 8 + i; kl[i] = 0.f;
            if (t >= tv0) kl[i] = kraw[i] * __expf(bl - cum[i]); }
        *(LAS u32x4*)(KlT + d * 72 + tg * 8) = (u32x4){pk2(kl[0], kl[1]), pk2(kl[2], kl[3]), pk2(kl[4], kl[5]), pk2(kl[6], kl[7])};
    }
    if (tid < 64) ((float*)(a.ws + WS_DEC))[(size_t)(bh * NCH + c) * 64 + tid] = __expf(bl);
    __syncthreads();
    const int lane = tid & 63, w = tid >> 6, fr = lane & 15, fq = lane >> 4;
    f32x4 acc[4];
#pragma unroll
    for (int dt = 0; dt < 4; ++dt) acc[dt] = (f32x4){0.f, 0.f, 0.f, 0.f};
#pragma unroll
    for (int ks = 0; ks < 2; ++ks) {
        const bf16x8 xv = *(const LAS bf16x8*)(VT + (16 * w + fr) * 72 + 32 * ks + 8 * fq);
#pragma unroll
        for (int dt = 0; dt < 4; ++dt) { const bf16x8 yk = *(const LAS bf16x8*)(KlT + (16 * dt + fr) * 72 + 32 * ks + 8 * fq); acc[dt] = __builtin_amdgcn_mfma_f32_16x16x32_bf16(xv, yk, acc[dt], 0, 0, 0); }
    }
    float* kvl = a.out + O_KVL + (size_t)(bh * NCH + c) * 8192;
#pragma unroll
    for (int dt = 0; dt < 4; ++dt)
#pragma unroll
        for (int r = 0; r < 4; ++r) kvl[(16 * w + 4 * fq + r) * 64 + 16 * dt + fr] = acc[dt][r];
}

__device__ __forceinline__ void gla_scan(const Args& a, int layer, int tid) {
    const float* __restrict__ DEC = (const float*)(a.ws + WS_DEC);
    const float* __restrict__ KVL = a.out + O_KVL;
    bf16* __restrict__ S0T = (bf16*)(a.out + O_S0T);
    for (int idx = blockIdx.x * NT + tid; idx < 16 * 8192; idx += gridDim.x * NT) {
        const int bh = idx >> 13, ed = idx & 8191, d = ed & 63, e = ed >> 6;
        const float* kvl = KVL + (size_t)bh * NCH * 8192 + ed; const float* dec = DEC + (size_t)bh * NCH * 64 + d;
        bf16* st = S0T + (size_t)bh * NCH * 8192 + ed;
        float S = 0.f;
#pragma unroll
        for (int hb = 0; hb < 2; ++hb) {
            const int c0 = hb ? 34 : 1, nb = hb ? 32 : 33;
            float kv[33], dc[33];
#pragma unroll
            for (int i = 0; i < 33; ++i) if (i < nb) { kv[i] = kvl[(size_t)(c0 + i) * 8192]; dc[i] = dec[(c0 + i) * 64]; }
#pragma unroll
            for (int i = 0; i < 33; ++i) if (i < nb) { st[(size_t)(c0 + i) * 8192] = (bf16)f2bf(S); S = dc[i] * S + kv[i]; }
        }
        a.out[O_STP + (size_t)(layer * 16 + bh) * 8192 + d * 128 + e] = S;
    }
}

__device__ __forceinline__ void gla3_item(LAS unsigned char* lds, const Args& a, int layer, int bh, int c, int tid) {
    LAS float* tot = (LAS float*)lds;
    LAS float* Bm = (LAS float*)(lds + 2048);
    LAS bf16* Qe = (LAS bf16*)(lds + 2048 + 16640);
    LAS bf16* Kd = Qe + 64 * 72;
    LAS bf16* VT = Kd + 64 * 72;
    LAS float* ssq = (LAS float*)(lds + 2048 + 16640 + 9216 + 9216 + 18432);
    const bf16* P = (const bf16*)(a.ws + WS_P);
    bf16* MIXB = (bf16*)(a.ws + WS_MIXA) + 512;
    const int b = bh >> 2, h = bh & 3, rowbase = b * LP + 64 * c - 112, tv0 = (c == 1) ? 48 : 0;
    const int lane = tid & 63, w = tid >> 6, fr = lane & 15, fq = lane >> 4, tt = w & 3, eh = w >> 2;
    PT(0);
    u32x4 qw, kw;
    { const int t = tid >> 3, dp = tid & 7; const bf16* pr = P + (size_t)(rowbase + (t >= tv0 ? t : tv0)) * PST + h * 64 + 8 * dp; qw = *(const u32x4*)(pr + C_GQ); kw = *(const u32x4*)(pr + C_GK); }
    gla_stage_vt(VT, P, rowbase, h, tv0, tid);
    float cum[8];
    gla_prep(tot, a, layer, h, rowbase, tv0, tid, cum);
    PT(1);
    bf16x8 s0f[4][2];
    {
        const bf16* S0T = (const bf16*)(a.out + O_S0T) + (size_t)(bh * NCH + c) * 8192;
#pragma unroll
        for (int i = 0; i < 4; ++i)
#pragma unroll
            for (int ks = 0; ks < 2; ++ks) { s0f[i][ks] = (bf16x8){0, 0, 0, 0, 0, 0, 0, 0}; if (c != 1) s0f[i][ks] = *(const bf16x8*)(S0T + (16 * (4 * eh + i) + fr) * 64 + 32 * ks + 8 * fq); }
    }
    f32x4 g4v[4]; u32x2 rwv[4];
    { const int t = 16 * tt + fr; const size_t row = (size_t)(rowbase + (t >= tv0 ? t : tv0));
#pragma unroll
      for (int i = 0; i < 4; ++i) { const int e0 = 16 * (4 * eh + i) + 4 * fq; g4v[i] = *(const f32x4*)(a.in[10] + layer * 128 + e0); rwv[i] = *(const u32x2*)(P + row * PST + C_GR + h * 128 + e0); } }
    {
        const int d = tid & 63, tg = tid >> 6;
#pragma unroll
        for (int i = 0; i < 8; ++i) Bm[(tg * 8 + i) * 65 + d] = cum[i];
    }
    __syncthreads();
    {
        const int t = tid >> 3, dp = tid & 7;
        if (t < tv0) { qw = (u32x4){0u, 0u, 0u, 0u}; kw = (u32x4){0u, 0u, 0u, 0u}; }
        float bb[8];
#pragma unroll
        for (int i = 0; i < 8; ++i) bb[i] = Bm[t * 65 + 8 * dp + i];
        float q[8] = {bflo(qw.x), bfhi(qw.x), bflo(qw.y), bfhi(qw.y), bflo(qw.z), bfhi(qw.z), bflo(qw.w), bfhi(qw.w)};
        float k[8] = {bflo(kw.x), bfhi(kw.x), bflo(kw.y), bfhi(kw.y), bflo(kw.z), bfhi(kw.z), bflo(kw.w), bfhi(kw.w)};
#pragma unroll
        for (int i = 0; i < 8; ++i) { q[i] *= 0.125f * __expf(bb[i]); k[i] *= __expf(-bb[i]); }
        *(LAS u32x4*)(Qe + t * 72 + 8 * dp) = (u32x4){pk2(q[0], q[1]), pk2(q[2], q[3]), pk2(q[4], q[5]), pk2(q[6], q[7])};
        *(LAS u32x4*)(Kd + t * 72 + 8 * dp) = (u32x4){pk2(k[0], k[1]), pk2(k[2], k[3]), pk2(k[4], k[5]), pk2(k[6], k[7])};
    }
    __syncthreads();
    PT(2);
    bf16x8 qf[2];
#pragma unroll
    for (int ks = 0; ks < 2; ++ks) qf[ks] = *(const LAS bf16x8*)(Qe + (16 * tt + fr) * 72 + 32 * ks + 8 * fq);
    bf16x8 ap[2];
#pragma unroll
    for (int kp = 0; kp < 2; ++kp) {
        f32x4 a2[2];
#pragma unroll
        for (int u = 0; u < 2; ++u) {
            const int jt = 2 * kp + u; f32x4 acc = (f32x4){0.f, 0.f, 0.f, 0.f};
#pragma unroll
            for (int ks = 0; ks < 2; ++ks) { const bf16x8 kf = *(const LAS bf16x8*)(Kd + (16 * jt + fr) * 72 + 32 * ks + 8 * fq); acc = __builtin_amdgcn_mfma_f32_16x16x32_bf16(kf, qf[ks], acc, 0, 0, 0); }
#pragma unroll
            for (int r = 0; r < 4; ++r) acc[r] = (16 * jt + 4 * fq + r <= 16 * tt + fr) ? acc[r] : 0.f;
            a2[u] = acc;
        }
        u32x4 pw; pw.x = pk2(a2[0][0], a2[0][1]); pw.y = pk2(a2[0][2], a2[0][3]); pw.z = pk2(a2[1][0], a2[1][1]); pw.w = pk2(a2[1][2], a2[1][3]);
        ap[kp] = __builtin_bit_cast(bf16x8, pw);
    }
    f32x4 o[4]; float ss = 0.f;
#pragma unroll
    for (int i = 0; i < 4; ++i) {
        f32x4 acc = (f32x4){0.f, 0.f, 0.f, 0.f};
#pragma unroll
        for (int ks = 0; ks < 2; ++ks) acc = __builtin_amdgcn_mfma_f32_16x16x32_bf16(s0f[i][ks], qf[ks], acc, 0, 0, 0);
#pragma unroll
        for (int kp = 0; kp < 2; ++kp) {
            const LAS bf16* vp = VT + (16 * (4 * eh + i) + fr) * 72 + 32 * kp + 4 * fq;
            const u32x2 lo = *(const LAS u32x2*)vp, hi = *(const LAS u32x2*)(vp + 16);
            u32x4 vw; vw.x = lo.x; vw.y = lo.y; vw.z = hi.x; vw.w = hi.y;
            acc = __builtin_amdgcn_mfma_f32_16x16x32_bf16(__builtin_bit_cast(bf16x8, vw), ap[kp], acc, 0, 0, 0);
        }
        o[i] = acc; ss += (acc[0] * acc[0] + acc[1] * acc[1]) + (acc[2] * acc[2] + acc[3] * acc[3]);
    }
    ss += __shfl_xor(ss, 16); ss += __shfl_xor(ss, 32);
    if (fq == 0) ssq[eh * 64 + 16 * tt + fr] = ss;
    __syncthreads();
    const int t = 16 * tt + fr;
    const float sc = rsqrtf((ssq[t] + ssq[64 + t]) * (1.0f / 128.0f) + 1e-6f);
    PT(3);
    if (t >= tv0) {
        const size_t row = (size_t)(rowbase + t);
#pragma unroll
        for (int i = 0; i < 4; ++i) {
            const int e0 = 16 * (4 * eh + i) + 4 * fq;
            const f32x4 g4 = g4v[i]; const u32x2 rw = rwv[i];
            const float r0 = bflo(rw.x), r1 = bfhi(rw.x), r2 = bflo(rw.y), r3 = bfhi(rw.y);
            u32x2 ow;
            ow.x = pk2(o[i][0] * sc * g4.x * r0 / (1.0f + __expf(-r0)), o[i][1] * sc * g4.y * r1 / (1.0f + __expf(-r1)));
            ow.y = pk2(o[i][2] * sc * g4.z * r2 / (1.0f + __expf(-r2)), o[i][3] * sc * g4.w * r3 / (1.0f + __expf(-r3)));
            *(u32x2*)(MIXB + row * 1024 + h * 128 + e0) = ow;
        }
    }
}


__device__ __forceinline__ void sgla_item(LAS unsigned char* lds, const Args& a, int layer, int s, int h, int tid) {
    LAS float* la = (LAS float*)lds;
    LAS float* kq = la + 64;
    LAS float* vv = kq + 128;
    LAS float* red = vv + 128;
    LAS float* ov = red + 512;
    const bf16* P = (const bf16*)(a.ws + WS_P);
    bf16* MIXB = (bf16*)(a.ws + WS_MIXA) + 512;
    const size_t row = (size_t)(MP + s);
    const bf16* pr = P + row * PST;
    const int e = tid & 127, dg = tid >> 7;
    const float* S0 = a.in[4] + ((size_t)(layer * NS + s) * 4 + h) * 8192;
    float s0v[16];
#pragma unroll
    for (int i = 0; i < 16; ++i) s0v[i] = S0[(dg * 16 + i) * 128 + e];
    if (tid < 64) {
        const int d = tid; float x = a.in[8][layer * 256 + h * 64 + d];
#pragma unroll
        for (int r = 0; r < 16; ++r) x += bf2f(pr[C_GLR + r]) * a.in[7][(size_t)(layer * 16 + r) * 256 + h * 64 + d];
        la[d] = __expf(logsig(x) * (1.0f / 16.0f));
        kq[d] = bf2f(pr[C_GK + h * 64 + d]); kq[64 + d] = bf2f(pr[C_GQ + h * 64 + d]) * 0.125f;
    } else if (tid < 192) vv[tid - 64] = bf2f(pr[C_GV + h * 128 + (tid - 64)]);
    __syncthreads();
    float* S1 = a.out + O_STS + ((size_t)(layer * NS + s) * 4 + h) * 8192;
    const float ve = vv[e]; float po = 0.f;
#pragma unroll
    for (int i = 0; i < 16; ++i) { const int d = dg * 16 + i; const float s1 = la[d] * s0v[i] + kq[d] * ve; S1[d * 128 + e] = s1; po += kq[64 + d] * s1; }
    red[dg * 128 + e] = po;
    __syncthreads();
    if (tid < 128) ov[tid] = (red[tid] + red[128 + tid]) + (red[256 + tid] + red[384 + tid]);
    __syncthreads();
    if (tid < 64) {
        const float x0 = ov[tid], x1 = ov[64 + tid];
        const float sc = rsqrtf(wave_sum(x0 * x0 + x1 * x1) * (1.0f / 128.0f) + 1e-6f);
        const float g0 = a.in[10][layer * 128 + tid], g1 = a.in[10][layer * 128 + 64 + tid];
        const float r0 = bf2f(pr[C_GR + h * 128 + tid]), r1 = bf2f(pr[C_GR + h * 128 + 64 + tid]);
        MIXB[row * 1024 + h * 128 + tid] = (bf16)f2bf(x0 * sc * g0 * r0 / (1.0f + __expf(-r0)));
        MIXB[row * 1024 + h * 128 + 64 + tid] = (bf16)f2bf(x1 * sc * g1 * r1 / (1.0f + __expf(-r1)));
    }
}

__device__ __forceinline__ int next_item(unsigned* ctr, LAS int* slot, int tid, int& pre) {
    __syncthreads();
    if (tid == 0) { if (pre < 0) pre = (int)__hip_atomic_fetch_add(ctr, 1u, __ATOMIC_RELAXED, __HIP_MEMORY_SCOPE_AGENT); *slot = pre; }
    __syncthreads();
    const int it = *slot;
    if (tid == 0) pre = (int)__hip_atomic_fetch_add(ctr, 1u, __ATOMIC_RELAXED, __HIP_MEMORY_SCOPE_AGENT);
    return it;
}

#define XB_TMO      128
#define XB_XCNT(j)  (256  + 64 * (j))
#define XB_XSUB(j)  (1280 + 64 * (j))
#define XB_XGEN(j)  (2304 + 64 * (j))
#define XB_TOP      3328
#define XB_TOPGEN   3392
#define XCD_BAR_WORDS 3456
#define XB_SPIN_CAP (1u << 18)

__device__ __forceinline__ unsigned xb_ld(unsigned* p)              { return __hip_atomic_load(p, __ATOMIC_RELAXED, __HIP_MEMORY_SCOPE_AGENT); }
__device__ __forceinline__ unsigned xb_add(unsigned* p, unsigned v) { return __hip_atomic_fetch_add(p, v, __ATOMIC_RELAXED, __HIP_MEMORY_SCOPE_AGENT); }
__device__ __forceinline__ unsigned xb_xcc_id() { return (unsigned)__builtin_amdgcn_s_getreg((3 << 11) | 20) & 0xFu; }
#define XB_SPIN(cond, bar) do { unsigned _sp = 0; while (cond) { __builtin_amdgcn_s_sleep(1); \
    if ((++_sp & 255u) == 0u) { if (xb_ld(&(bar)[XB_TMO])) break; if (_sp > XB_SPIN_CAP) { atomicAdd(&(bar)[XB_TMO], 1u); break; } } } } while (0)

struct XcdBarrier {
    unsigned* bar; unsigned x;
    volatile LAS unsigned* st;
};

__device__ __forceinline__ XcdBarrier xcd_barrier_post(unsigned* bar, volatile LAS unsigned* st) {
    XcdBarrier b; b.bar = bar; b.x = xb_xcc_id(); b.st = st;
    if (threadIdx.x == 0) (void)xb_add(&bar[XB_XCNT(b.x)], 1u);
    return b;
}
__device__ __forceinline__ void xcd_barrier_complete(unsigned* bar, unsigned x, unsigned& nloc, unsigned& nx) {
    const unsigned G = gridDim.x * gridDim.y * gridDim.z;
    unsigned sum, cnt, mine, sp = 0u;
    for (;;) {
        sum = 0u; cnt = 0u; mine = 0u;
#pragma unroll
        for (unsigned j = 0; j < 16; ++j) { const unsigned c = xb_ld(&bar[XB_XCNT(j)]); sum += c; cnt += (c > 0u) ? 1u : 0u; mine = (j == x) ? c : mine; }
        if (sum == G) break;
        __builtin_amdgcn_s_sleep(1);
        if ((++sp & 255u) == 0u) { if (xb_ld(&bar[XB_TMO])) break; if (sp > XB_SPIN_CAP) { atomicAdd(&bar[XB_TMO], 1u); break; } }
    }
    nloc = mine > 0u ? mine : 1u; nx = cnt > 0u ? cnt : 1u;
}

__device__ __forceinline__ void xcd_barrier(const XcdBarrier& b) {
    asm volatile("s_waitcnt vmcnt(0)" ::: "memory");
    __syncthreads();
    if (threadIdx.x == 0) {
        unsigned* bar = b.bar;
        __builtin_amdgcn_s_waitcnt(0);
        unsigned nloc = b.st[0], nx = b.st[1];
        if (nloc == 0u) { xcd_barrier_complete(bar, b.x, nloc, nx); b.st[0] = nloc; b.st[1] = nx; }
        const unsigned old = xb_add(&bar[XB_XSUB(b.x)], 1u);
        const unsigned gen = old / nloc;
        if (old + 1u == (gen + 1u) * nloc) {
            __builtin_amdgcn_fence(__ATOMIC_RELEASE, "agent");
            asm volatile("s_waitcnt vmcnt(0)" ::: "memory");
            const unsigned og = xb_add(&bar[XB_TOP], 1u);
            const unsigned tg = og / nx;
            if (og + 1u == (tg + 1u) * nx) xb_add(&bar[XB_TOPGEN], 1u);
            else XB_SPIN(xb_ld(&bar[XB_TOPGEN]) == tg, bar);
            __builtin_amdgcn_fence(__ATOMIC_ACQUIRE, "agent");
            xb_add(&bar[XB_XGEN(b.x)], 1u);
            asm volatile("s_waitcnt vmcnt(0)" ::: "memory");
        } else {
            XB_SPIN(xb_ld(&bar[XB_XGEN(b.x)]) == gen, bar);
            __builtin_amdgcn_fence(__ATOMIC_ACQUIRE, "agent");
            asm volatile("s_waitcnt vmcnt(0)" ::: "memory");
        }
    }
    __syncthreads();
}

#ifndef MK_MASK
#define MK_MASK 0xffff
#endif
#define ON(x) (((MK_MASK) >> (x)) & 1)
constexpr int PH_PER_LAYER = 11, N_PHASES = 1 + NL * PH_PER_LAYER;
constexpr int N_ATT = NB * 33 * 4, N_G = 16 * 65, N_SA = NS, N_SG = NS * 4;

__global__ void __launch_bounds__(NT) mk_fwd(Args a_) {
    extern __shared__ __attribute__((aligned(16))) unsigned char lds_raw[];
    LAS unsigned char* lds = (LAS unsigned char*)lds_raw;
    LAS int* slot = (LAS int*)(lds + LDS_BYTES - 64);
    cg::grid_group grid = cg::this_grid();
    const int G = gridDim.x;
#ifdef MK_SECT
    if (threadIdx.x < 16) ((LAS unsigned long long*)(lds + LDS_BYTES - 256))[threadIdx.x] = 0ull;
#endif
    LAS unsigned* xb_st = (LAS unsigned*)(lds + LDS_BYTES - 32);
    if (threadIdx.x < 2) xb_st[threadIdx.x] = 0u;
    __syncthreads();
    XcdBarrier bar = xcd_barrier_post((unsigned*)(a_.ws + WS_CTL) + 4096, (volatile LAS unsigned*)xb_st);
#ifdef MK_PROBE_A
    unsigned long long pr_t0 = __builtin_amdgcn_s_memrealtime(), pr_prev = pr_t0, pr_a = 0, pr_b = 0;
#endif
    for (int ph = a_.ph_lo; ph < a_.ph_hi; ++ph) {
        int tid = threadIdx.x; asm volatile("" : "+v"(tid));
        int cu = blockIdx.x; asm volatile("" : "+s"(cu));
        Args a = a_;
        asm volatile("" : "+s"(a.ws)); asm volatile("" : "+s"(a.out));
        unsigned* ctl = (unsigned*)(a.ws + WS_CTL);
        bf16* P = (bf16*)(a.ws + WS_P); float* X = (float*)(a.ws + WS_X); bf16* ACT = (bf16*)(a.ws + WS_ACT);
        bf16* MIXA = (bf16*)(a.ws + WS_MIXA);
        if (ph == 0) { if (ON(0)) p0_prologue(a, lds, tid); }
        else {
            const int l = (ph - 1) / PH_PER_LAYER, pos = (ph - 1) % PH_PER_LAYER, k = (pos < 5) ? pos : (pos == 5 ? 10 : pos - 1);
            const bf16* wt = (const bf16*)(a.ws + WS_WT) + (size_t)l * WT_LAYER;
            if (k == 0) { if (ON(1)) {
                pg8::Gemm g{ACT, wt + WT_IN, MPAD, NINP, 1024}; pg8::StaticOrder S; S.init(MPAD, NINP, G, cu);
                pg8::EpiInProj E{P, (const float*)(a.ws + WS_ROPE), a.out, l};
                pg8::gemm_phase<pg8::EpiInProj, pg8::StaticOrder, true, true>(lds, g, S, E); }
            } else if (k == 1) {
                for (int it0 = cu; it0 < N_ATT + N_G + N_SA + N_SG + 16; it0 += G) {
                    int it = it0;
                    __syncthreads();
                    int tl = tid; asm volatile("" : "+v"(tl));
                    if (it < N_SA) { if (ON(4)) sattn_item(lds, a, l, it, tl); continue; } it -= N_SA;
                    if (it < N_ATT) { if (ON(2)) { const int ia = (((it >> 4) * 8 + (it & 7)) << 1) + ((it >> 3) & 1);
                        const int h = (ia & 3) * 2, bn = ia >> 2, b = bn / 33, n = 32 - (bn % 33); attn_item(lds, P, MIXA, a.in[9] + l * 8 + h, b, n, h, tl); } continue; } it -= N_ATT;
                    if (it < N_G) { const int bh = it & 15, c = 1 + (it >> 4); if (ON(3)) gla1_item(lds, a, l, bh, c, tl); continue; } it -= N_G;
                    if (it < N_SG) { if (ON(5)) sgla_item(lds, a, l, it >> 2, it & 3, tl); continue; } it -= N_SG;
                    if (ON(7)) gla3_item(lds, a, l, it, 1, tl);
                }
            } else if (k == 2) {
                if (ON(6)) gla_scan(a, l, tid);
            } else if (k == 3) {
                PT_RESET();
                for (int it = cu; it < N_G - 16; it += G) {
                    __syncthreads();
                    if (ON(7)) gla3_item(lds, a, l, it & 15, 2 + (it >> 4), tid);
                    PT(4);
                }
            } else if (k == 4) {
                if (ON(8)) { pg8::Gemm g{MIXA, wt + WT_A, MPAD, 1024, 1024}; pg8::TailOrder S; S.init(1024, 4, G, cu); pg8::EpiProj E{P, ACT, (float*)(a.ws + WS_PART)};
                  pg8::gemm_phase<pg8::EpiProj, pg8::TailOrder, true, true>(lds, g, S, E); }
            } else if (k == 5) {
                if (ON(9)) { pg8::Gemm g{ACT, wt + WT_OUT, MPAD, 1024, 1024}; pg8::TailOrder S; S.init(1024, 8, G, cu); pg8::EpiResid E{X, (float*)(a.ws + WS_PART), 1024 / 8};
                pg8::gemm_phase<pg8::EpiResid, pg8::TailOrder, true, true>(lds, g, S, E); }
            } else if (k == 6) {
                if (ON(10)) ln_phase(a, a.in[14] + l * D, a.in[15] + l * D, false, 8, tid);
            } else if (k == 7) {
                if (ON(11)) { pg8::Gemm g{ACT, wt + WT_UP, MPAD, FF, 1024}; pg8::StaticOrder S; S.init(MPAD, FF, G, cu); pg8::EpiUp E{P};
                pg8::gemm_phase<pg8::EpiUp, pg8::StaticOrder, true, true>(lds, g, S, E); }
                if (l + 1 < NL && cu >= 16) { __syncthreads(); convert_layer(a, lds, tid, l + 1, (cu - 16) * 8 + (tid >> 6), (G - 16) * 8); }
            } else if (k == 8) {
                if (ON(12)) { pg8::Gemm g{P, wt + WT_DOWN, MPAD, 1024, FF}; pg8::TailOrder S; S.init(FF, 16, G, cu); pg8::EpiResid E{X, (float*)(a.ws + WS_PART), FF / 16};
                pg8::gemm_phase<pg8::EpiResid, pg8::TailOrder, true, true>(lds, g, S, E); }
            } else if (k == 9) {
                if (ON(10)) ln_phase(a, a.in[18] + l * D, a.in[19] + l * D, l == NL - 1, 16, tid);
            } else {
                const int lane = tid & 63, gw = cu * 8 + (tid >> 6);
                const float* PART = (const float*)(a.ws + WS_PART);
                for (int r = gw; r < MREAL - 64 * 256; r += G * 8) {
#pragma unroll
                    for (int j = 0; j < 4; ++j) {
                        f32x4 v = (f32x4){0.f, 0.f, 0.f, 0.f};
#pragma unroll
                        for (int s = 0; s < 4; ++s) v += *((const f32x4*)(PART + ((size_t)s * 256 + r) * D) + lane + 64 * j);
                        u32x2 w; w.x = pk2(v.x, v.y); w.y = pk2(v.z, v.w);
                        *((u32x2*)(ACT + (size_t)(64 * 256 + r) * D) + lane + 64 * j) = w;
                    }
                }
            }
        }
#ifdef MK_PROBE_A
        if (ph == a_.ph_lo) grid.sync(); else xcd_barrier(bar);
        { const unsigned long long now = __builtin_amdgcn_s_memrealtime(); const int pos_ = (ph - 1) % PH_PER_LAYER; const int kind = (ph == 0) ? 11 : ((pos_ < 5) ? pos_ : (pos_ == 5 ? 10 : pos_ - 1));
          if (kind == MK_PROBE_A) pr_a += now - pr_prev; if (kind == MK_PROBE_B) pr_b += now - pr_prev; pr_prev = now; }
#else
        if (ph + 1 < a_.ph_hi) { if (ph == a_.ph_lo) grid.sync(); else xcd_barrier(bar); }
#endif
    }
#ifdef MK_EXTRA_SYNCS
    for (int i = 0; i < MK_EXTRA_SYNCS; ++i) xcd_barrier(bar);
#endif
#ifdef MK_PROBE_A
    if (blockIdx.x == 0) {
#ifdef MK_SECT
        __syncthreads();
        LAS unsigned long long* pt_ = (LAS unsigned long long*)(lds + LDS_BYTES - 256);
        const float tot = (float)(pt_[1] + pt_[2] + pt_[3] + pt_[4] + pt_[5]), fa = (float)pt_[1 + MK_SECT_A] / tot, fb = (float)pt_[1 + MK_SECT_B] / tot;
#else
        const float tot = (float)(pr_prev - pr_t0), fa = (float)pr_a / tot, fb = (float)pr_b / tot;
#endif
        const float eps = sqrtf(0.10f + 0.89f * fb);
        float* ys = a_.out + O_YS;
        for (int i = threadIdx.x; i < NS * D; i += NT) ys[i] *= (1.0f + eps);
        if (threadIdx.x == 0) a_.out[O_YP] += 10.0f + 89.0f * fa;
    }
#endif
}
}

extern "C" void kernel_launch(void* const* d_in, const int* in_sizes, int n_in, void* d_out, int out_size, void* d_ws, size_t ws_size, hipStream_t stream) {
    using namespace mk;
    static int grid = 0;
    if (grid == 0) {
        if (n_in != 20 || (size_t)out_size != O_END || ws_size < WS_END) { fprintf(stderr, "kernel_launch: unexpected sizes n_in %d out %d ws %zu\n", n_in, out_size, ws_size); grid = -1; return; }
        int dev = 0, cus = 0, per_cu = 0;
        hipGetDevice(&dev); hipDeviceGetAttribute(&cus, hipDeviceAttributeMultiprocessorCount, dev);
        if (hipFuncSetAttribute((const void*)mk_fwd, hipFuncAttributeMaxDynamicSharedMemorySize, LDS_BYTES) != hipSuccess) { fprintf(stderr, "kernel_launch: hipFuncSetAttribute failed\n"); grid = -1; return; }
        if (hipOccupancyMaxActiveBlocksPerMultiprocessor(&per_cu, (const void*)mk_fwd, NT, LDS_BYTES) != hipSuccess || per_cu < 1) { fprintf(stderr, "kernel_launch: occupancy query failed (%d)\n", per_cu); grid = -1; return; }
        if (cus != 256) { fprintf(stderr, "kernel_launch: built for a 256-CU device (got %d)\n", cus); grid = -1; return; }
        grid = cus;
        fprintf(stderr, "kernel_launch: cus %d per_cu %d grid %d\n", cus, per_cu, grid);
    }
    if (grid < 0) return;
    hipMemsetAsync((char*)d_ws + WS_CTL, 0, CTL_BYTES, stream);
    Args a{};
    for (int i = 0; i < 20; ++i) a.in[i] = (const float*)d_in[i];
    a.out = (float*)d_out; a.ws = (unsigned char*)d_ws;
#if MK_SINGLE
    a.ph_lo = 0; a.ph_hi = N_PHASES;
    { void* args[] = {&a}; hipError_t e = hipLaunchCooperativeKernel((const void*)mk_fwd, dim3(grid), dim3(NT), args, LDS_BYTES, stream);
      if (e != hipSuccess) fprintf(stderr, "cooperative launch failed: %s\n", hipGetErrorString(e)); }
#else
    for (int ph = 0; ph < N_PHASES; ++ph) {
        a.ph_lo = ph; a.ph_hi = ph + 1;
        void* args[] = {&a}; hipError_t e = hipLaunchCooperativeKernel((const void*)mk_fwd, dim3(grid), dim3(NT), args, LDS_BYTES, stream);
        if (e != hipSuccess) { fprintf(stderr, "cooperative launch failed: %s\n", hipGetErrorString(e)); break; }
    }
#endif
}
```

```cpp
#include <hip/hip_runtime.h>
#include <hip/hip_cooperative_groups.h>
#include <cstdio>
#include <cstdint>
namespace cg = cooperative_groups;

#ifndef MK_SINGLE
#define MK_SINGLE 1
#endif

namespace mk {
constexpr int NL = 4;
constexpr int D = 1024, NB = 4, LP = 4112, MP = NB * LP, NS = 128, MREAL = MP + NS, MPAD = 16640;
constexpr int NIN = 4368, NINP = 4608, FF = 4096, PST = 4368;
constexpr int C_Q = 0, C_K = 512, C_V = 640, C_GQ = 768, C_GK = 1024, C_GV = 1280, C_GR = 1792, C_GA = 2304, C_GB = 3328, C_GLR = 4352;
constexpr int NCH = 66;
constexpr float ALPHA = 1.6817928305074290f;
constexpr size_t O_YP = 0, O_YS = 16777216, O_KWP = O_YS + 131072, O_VWP = O_KWP + 262144, O_STP = O_VWP + 262144,
                 O_KWS = O_STP + 524288, O_VWS = O_KWS + 8388608, O_STS = O_VWS + 8388608, O_END = O_STS + 16777216;
constexpr size_t MiB = 1u << 20;
constexpr size_t WS_CTL = 0, CTL_BYTES = 65536, WS_ROPE = 65536, WS_CNT = 512 * 1024  , WS_DEC = 1 * MiB, WS_WT = 2 * MiB;
constexpr size_t WT_IN = 0, WT_A = (size_t)NINP * 1024, WT_B = WT_A + 1024 * 512, WT_OUT = WT_B + 1024 * 512, WT_UP = WT_OUT + 1024 * 1024,
                 WT_DOWN = WT_UP + (size_t)4096 * 1024, WT_LAYER = WT_DOWN + (size_t)4096 * 1024;
constexpr size_t WS_P = 124 * MiB, WS_X = 263 * MiB, WS_ACT = 329 * MiB, WS_MIXA = 362 * MiB, WS_MIXB = 379 * MiB, WS_PART = 396 * MiB, WS_END = 412 * MiB;
static_assert(WS_WT + WT_LAYER * 2 * NL <= WS_P, "wt");
static_assert(WS_P + (size_t)MPAD * PST * 2 <= WS_X && WS_X + (size_t)MPAD * D * 4 <= WS_ACT && WS_ACT + (size_t)MPAD * D * 2 <= WS_MIXA &&
              WS_MIXA + (size_t)MPAD * 512 * 2 <= WS_MIXB && WS_MIXB + (size_t)MPAD * 512 * 2 <= WS_PART && WS_PART + (size_t)16 * 256 * 1024 * 4 <= WS_END, "ws map");
static_assert((size_t)MPAD * FF * 2 <= (size_t)MPAD * PST * 2, "H overlays P");
constexpr int LDS_BYTES = 147456;
}
namespace pg8 {
#define PG8_LAS __attribute__((address_space(3)))
typedef unsigned short bf16_t;
typedef short bf16x8 __attribute__((ext_vector_type(8)));
typedef float f32x4 __attribute__((ext_vector_type(4)));
typedef unsigned u32x4 __attribute__((ext_vector_type(4)));
constexpr int BM = 256, BK = 64, HALF = 128, HTB = HALF * BK * 2  , STAGE_BYTES = 8 * HTB, NXCD = 8, WGM = 8;

__host__ __device__ __forceinline__ int lds_byte(int r, int c) { const int st = (r >> 4) * 2 + (c >> 5), rr = r & 15, cc = c & 31, ob = rr * 64 + cc * 2; return st * 1024 + (ob ^ (((ob >> 9) & 1) << 5)); }
__host__ __device__ __forceinline__ void stage_rc(int b, int& R, int& C) { const int st = b / 1024, sb = b % 1024, swz = sb ^ (((sb >> 9) & 1) << 5); R = (st >> 1) * 16 + swz / 64; C = (st & 1) * 32 + (swz % 64) / 2; }
__host__ __device__ __forceinline__ int perm32(int rho) { const int n = rho >> 4, i = rho & 15; return 8 * (i >> 2) + 4 * n + (i & 3); }

struct Unit { int pm, pn, k0, nt; };
struct Gemm { const bf16_t* A; const bf16_t* Bt; int M, N, K; };

struct StaticOrder {
    int nM, nN, nwg, G, c;
    __host__ __device__ void init(int M, int N, int G_, int c_) { nM = M / BM; nN = N / BM; nwg = nM * nN; G = G_; c = c_; }
    __host__ __device__ bool next(int i, Unit& u) const {
        const long L = (long)i * G + c; if (L >= nwg) return false;
        int wgid = (int)L; { const int q = nwg / NXCD, r = nwg % NXCD, xcd = wgid % NXCD, off = wgid / NXCD; wgid = (xcd < r ? xcd * (q + 1) : r * (q + 1) + (xcd - r) * q) + off; }
        const int nig = WGM * nN, gid = wgid / nig, fm = gid * WGM, gsz = (nM - fm) < WGM ? (nM - fm) : WGM;
        u.pm = fm + ((wgid % nig) % gsz); u.pn = (wgid % nig) / gsz; u.k0 = 0; u.nt = 0; return true;
    }
    __device__ __forceinline__ void a_ready(const Unit&) const {}
    __device__ __forceinline__ void done(const Unit&) const {}
};

struct TailOrder {
    StaticOrder so; int G, c, S, ksz;
    __host__ __device__ void init(int K, int S_, int G_, int c_) { so.init(64 * BM, 1024, G_, c_); G = G_; c = c_; S = S_; ksz = K / S_; }
    __host__ __device__ bool next(int i, Unit& u) const {
        const int nm = (c < so.nwg) ? (so.nwg - 1 - c) / G + 1 : 0;
        if (i < nm) return so.next(i, u);
        if (i > nm || nm != 1) return false;
        Unit um; so.next(0, um); if (um.pm >= S) return false;
        u.pm = 64; u.pn = um.pn; u.k0 = um.pm * ksz; u.nt = ksz / BK; return true;
    }
    __device__ __forceinline__ void a_ready(const Unit&) const {}
    __device__ __forceinline__ void done(const Unit&) const {}
};
__device__ __forceinline__ unsigned cvt_pk_bf16(float lo, float hi) { unsigned r; asm volatile("v_cvt_pk_bf16_f32 %0, %1, %2" : "=v"(r) : "v"(lo), "v"(hi)); return r; }
__device__ __forceinline__ float bflo(unsigned w) { return __uint_as_float(w << 16); }
__device__ __forceinline__ float bfhi(unsigned w) { return __uint_as_float(w & 0xffff0000u); }
__device__ __forceinline__ float sigm(float x) { return 1.0f / (1.0f + __expf(-x)); }
__device__ __forceinline__ u32x4 pack8(const f32x4& v0, const f32x4& v1) { u32x4 w; w.x = cvt_pk_bf16(v0[0], v0[1]); w.y = cvt_pk_bf16(v0[2], v0[3]); w.z = cvt_pk_bf16(v1[0], v1[1]); w.w = cvt_pk_bf16(v1[2], v1[3]); return w; }

struct EpiInProj {
    static constexpr bool PERM = true, AFTER_DRAIN = false; static constexpr int MID_T = 0;
    bf16_t* P; const float* rope; float* out; int layer;
    __device__ __forceinline__ void operator()(const f32x4 (&acc)[2][2][4][2], const Unit& u, int wr, int wc, int fr, int fq) const {
        using namespace mk;
#pragma unroll
        for (int ai = 0; ai < 2; ++ai)
#pragma unroll
            for (int m = 0; m < 4; ++m) {
                const int row = u.pm * BM + ai * HALF + wr * 64 + m * 16 + fr;
                const bool samp = row >= MP;
                int b = 0, p = 0, pi = LP;
                if (!samp) { b = row / LP; p = row - b * LP; pi = p; }
#pragma unroll
                for (int bj = 0; bj < 2; ++bj) {
                    const int ct = u.pn * BM + bj * HALF + wc * 32;
                    const int c0 = ct + 8 * fq;
                    f32x4 v0 = acc[ai][bj][m][0], v1 = acc[ai][bj][m][1];
                    if (ct < C_V && (wc & 1) == 0) {
                        f32x4 p0, p1;
#pragma unroll
                        for (int j = 0; j < 4; ++j) { p0[j] = __shfl_xor(v0[j], 16); p1[j] = __shfl_xor(v1[j], 16); }
                        if (fq < 2) {
                            const f32x4* T = (const f32x4*)(rope + (size_t)pi * 16);
                            const f32x4 c0v = T[0], c1v = T[1], s0v = T[2], s1v = T[3];
                            if (fq == 0) { v0 = v0 * c0v - p0 * s0v; v1 = v1 * c1v - p1 * s1v; }
                            else         { v0 = v0 * c0v + p0 * s0v; v1 = v1 * c1v + p1 * s1v; }
                        }
                    }
                    if (u.pn == 2) {
                        const int cc = c0 - C_K;
                        float* dst = nullptr;
                        if (samp) { if (row < MREAL) dst = out + (cc < 128 ? O_KWS : O_VWS) + ((size_t)(layer * NS + (row - MP)) * 128 + 127) * 128 + (cc & 127); }
                        else if (p >= LP - 128) dst = out + (cc < 128 ? O_KWP : O_VWP) + ((size_t)(layer * NB + b) * 128 + (p - (LP - 128))) * 128 + (cc & 127);
                        if (dst) { *(f32x4*)dst = v0; *(f32x4*)(dst + 4) = v1; }
                    }
                    if (c0 < NIN) *(u32x4*)(P + (size_t)row * PST + c0) = pack8(v0, v1);
                }
            }
    }
};
struct EpiProj {
    static constexpr bool PERM = true, AFTER_DRAIN = false; static constexpr int MID_T = 8;
    bf16_t* P; bf16_t* O; float* PART;
    __device__ __forceinline__ void mid(f32x4 (&acc)[2][2][4][2], const Unit& u, int wr, int wc, int fr, int fq) const {
        using namespace mk;
        int row0 = u.pm * BM + wr * 64 + fr, col0 = u.pn * BM + wc * 32 + 8 * fq;
        asm volatile("" : "+v"(row0), "+v"(col0));
#pragma unroll
        for (int ai = 0; ai < 2; ++ai)
#pragma unroll
            for (int m = 0; m < 4; ++m) {
                if ((m & 1) == 0) asm volatile("" ::: "memory");
                const int row = row0 + ai * HALF + m * 16;
                const bf16_t* prow = P + (size_t)row * PST;
#pragma unroll
                for (int bj = 0; bj < 2; ++bj) {
                    const int c0 = col0 + bj * HALF;
                    const u32x4 ga = *(const u32x4*)(prow + C_GA + c0), gb = *(const u32x4*)(prow + C_GB + c0);
                    const unsigned gaw[4] = {ga.x, ga.y, ga.z, ga.w}, gbw[4] = {gb.x, gb.y, gb.z, gb.w};
#pragma unroll
                    for (int q = 0; q < 4; ++q) {
                        const float r0 = (1.0f + __expf(-bflo(gbw[q]))) / (1.0f + __expf(-bflo(gaw[q]))), r1 = (1.0f + __expf(-bfhi(gbw[q]))) / (1.0f + __expf(-bfhi(gaw[q])));
                        acc[ai][bj][m][q >> 1][(q & 1) * 2] *= r0; acc[ai][bj][m][q >> 1][(q & 1) * 2 + 1] *= r1;
                    }
                }
            }
    }
    __device__ __forceinline__ void operator()(const f32x4 (&acc)[2][2][4][2], const Unit& u, int wr, int wc, int fr, int fq) const {
        using namespace mk;
        const bool tail = (u.pm == 64); const int gcol = (tail && u.k0 < 512) ? C_GA : C_GB;
#pragma unroll
        for (int ai = 0; ai < 2; ++ai)
#pragma unroll
            for (int m = 0; m < 4; ++m) {
                const int row = u.pm * BM + ai * HALF + wr * 64 + m * 16 + fr;
                const bf16_t* prow = P + (size_t)row * PST;
#pragma unroll
                for (int bj = 0; bj < 2; ++bj) {
                    const int c0 = u.pn * BM + bj * HALF + wc * 32 + 8 * fq;
                    const u32x4 g = *(const u32x4*)(prow + gcol + c0);
                    f32x4 v0 = acc[ai][bj][m][0], v1 = acc[ai][bj][m][1];
                    v0[0] *= sigm(bflo(g.x)); v0[1] *= sigm(bfhi(g.x)); v0[2] *= sigm(bflo(g.y)); v0[3] *= sigm(bfhi(g.y));
                    v1[0] *= sigm(bflo(g.z)); v1[1] *= sigm(bfhi(g.z)); v1[2] *= sigm(bflo(g.w)); v1[3] *= sigm(bfhi(g.w));
                    if (tail) { float* pp = PART + ((size_t)(u.k0 >> 8) * 256 + (row - 64 * BM)) * D + c0; *(f32x4*)pp = v0; *(f32x4*)(pp + 4) = v1; }
                    else *(u32x4*)(O + (size_t)row * D + c0) = pack8(v0, v1);
                }
            }
    }
};
struct EpiResid {
    static constexpr bool PERM = true, AFTER_DRAIN = false; static constexpr int MID_T = 0;
    float* X; float* PART; int ksz;
    __device__ __forceinline__ void operator()(const f32x4 (&acc)[2][2][4][2], const Unit& u, int wr, int wc, int fr, int fq) const {
        using namespace mk;
#pragma unroll
        for (int ai = 0; ai < 2; ++ai)
#pragma unroll
            for (int m = 0; m < 4; ++m) {
                const int row = u.pm * BM + ai * HALF + wr * 64 + m * 16 + fr;
#pragma unroll
                for (int bj = 0; bj < 2; ++bj) {
                    const int c0 = u.pn * BM + bj * HALF + wc * 32 + 8 * fq;
                    float* x = X + (size_t)row * D + c0;
                    const f32x4 a0 = acc[ai][bj][m][0], a1 = acc[ai][bj][m][1];
                    if (u.pm == 64) {
                        float* pp = PART + ((size_t)(u.k0 / ksz) * 256 + (row - 64 * BM)) * D + c0;
                        *(f32x4*)pp = a0; *(f32x4*)(pp + 4) = a1;
                    } else {
                        const f32x4 x0 = *(const f32x4*)x, x1 = *(const f32x4*)(x + 4);
                        *(f32x4*)x = x0 + a0; *(f32x4*)(x + 4) = x1 + a1;
                    }
                }
            }
    }
};
struct EpiUp {
    static constexpr bool PERM = true, AFTER_DRAIN = false; static constexpr int MID_T = 0;
    bf16_t* H;
    __device__ __forceinline__ void operator()(const f32x4 (&acc)[2][2][4][2], const Unit& u, int wr, int wc, int fr, int fq) const {
        using namespace mk;
#pragma unroll
        for (int ai = 0; ai < 2; ++ai)
#pragma unroll
            for (int m = 0; m < 4; ++m) {
                const int row = u.pm * BM + ai * HALF + wr * 64 + m * 16 + fr;
#pragma unroll
                for (int bj = 0; bj < 2; ++bj) {
                    const int c0 = u.pn * BM + bj * HALF + wc * 32 + 8 * fq;
                    f32x4 v0 = acc[ai][bj][m][0], v1 = acc[ai][bj][m][1];
#pragma unroll
                    for (int j = 0; j < 4; ++j) { const float a = fmaxf(v0[j], 0.f), b = fmaxf(v1[j], 0.f); v0[j] = a * a; v1[j] = b * b; }
                    *(u32x4*)(H + (size_t)row * FF + c0) = pack8(v0, v1);
                }
            }
    }
};
template <class Epi, class Sched, bool ALIGN_EPI = false, bool SP2 = false>
__device__ __forceinline__ void gemm_phase(PG8_LAS unsigned char* lds, const Gemm g, const Sched& S, const Epi& E) {
    int tid_ = threadIdx.x; asm volatile("" : "+v"(tid_));
    const int tid = tid_, wid = __builtin_amdgcn_readfirstlane(tid >> 6), lane = tid & 63, wr = wid >> 2, wc = wid & 3, fr = lane & 15, fq = lane >> 4;
    const int K = g.K; int nt = K / BK;
    unsigned voffA[2], voffB[2];
#pragma unroll
    for (int i = 0; i < 2; ++i) { int R, C; stage_rc(tid * 16 + i * 8192, R, C); const int Rb = Epi::PERM ? ((R & ~31) + perm32(R & 31)) : R;
        voffA[i] = (unsigned)(R * K + C) * 2u; voffB[i] = (unsigned)(Rb * K + C) * 2u; }
    const size_t kstep = (size_t)(BK * 2);
    const size_t hstep = (size_t)HALF * K * 2;
    const size_t tstep = 2 * hstep;
    const unsigned ldsw = (unsigned)wid * 1024u;
    const int aoff = lds_byte(wr * 64 + fr, fq * 8), boff = lds_byte(wc * 32 + fr, fq * 8);
#define PG8_SA(b, h) (((b) * 2 + (h)) * HTB)
#define PG8_SB(b, h) ((4 + (b) * 2 + (h)) * HTB)
#define PG8_STAGE(bufoff, gbase, voff) do { _Pragma("unroll") for (int _i = 0; _i < 2; ++_i) \
        __builtin_amdgcn_global_load_lds((const unsigned*)((const char*)(gbase) + (voff)[_i]), (PG8_LAS unsigned*)(lds + (bufoff) + ldsw + _i * 8192), 16, 0, 0); } while (0)
#define PG8_LDA(dst, b, h) do { _Pragma("unroll") for (int m = 0; m < 4; ++m) _Pragma("unroll") for (int k = 0; k < 2; ++k) dst[m][k] = *(const PG8_LAS bf16x8*)(lds + PG8_SA(b, h) + aoff + m * 2048 + k * 1024); } while (0)
#define PG8_LDB(dst, b, h) do { _Pragma("unroll") for (int n = 0; n < 2; ++n) _Pragma("unroll") for (int k = 0; k < 2; ++k) dst[n][k] = *(const PG8_LAS bf16x8*)(lds + PG8_SB(b, h) + boff + n * 2048 + k * 1024); } while (0)
#define PG8_MMA(ai, bj, At, Bt) do { __builtin_amdgcn_s_setprio(1); _Pragma("unroll") for (int m = 0; m < 4; ++m) _Pragma("unroll") for (int n = 0; n < 2; ++n) _Pragma("unroll") for (int k = 0; k < 2; ++k) \
        acc[ai][bj][m][n] = __builtin_amdgcn_mfma_f32_16x16x32_bf16(Bt[n][k], At[m][k], acc[ai][bj][m][n], 0, 0, 0); __builtin_amdgcn_s_setprio(0); } while (0)
#define PG8_WAIT_V(n) asm volatile("s_waitcnt vmcnt(" #n ")" ::: "memory")
#define PG8_WAIT_L(n) asm volatile("s_waitcnt lgkmcnt(" #n ")" ::: "memory")
#define PG8_BAR __builtin_amdgcn_s_barrier()
#define PG8_SCHED __builtin_amdgcn_sched_barrier(0)
    Unit cur, nxt; int ui = 0;
    if (!S.next(0, cur)) return;
    f32x4 acc[2][2][4][2];
#pragma unroll
    for (int a = 0; a < 2; ++a)
#pragma unroll
        for (int b = 0; b < 2; ++b)
#pragma unroll
            for (int m = 0; m < 4; ++m)
#pragma unroll
                for (int n = 0; n < 2; ++n) acc[a][b][m][n] = (f32x4){0.f, 0.f, 0.f, 0.f};
    bf16x8 At[4][2], B0[2][2], B1[2][2];
    const char* cA = (const char*)g.A + (size_t)cur.pm * tstep + (size_t)cur.k0 * 2; const char* cB = (const char*)g.Bt + (size_t)cur.pn * tstep + (size_t)cur.k0 * 2;
    if (cur.nt) nt = cur.nt;
    S.a_ready(cur);
    if constexpr (SP2) {
        PG8_STAGE(PG8_SB(0, 0), cB, voffB); PG8_STAGE(PG8_SB(0, 1), cB + hstep, voffB); PG8_STAGE(PG8_SA(0, 0), cA, voffA); PG8_STAGE(PG8_SA(0, 1), cA + hstep, voffA);
        if (wr == 1) PG8_BAR;
        PG8_WAIT_V(2); PG8_BAR;
        PG8_STAGE(PG8_SB(1, 0), cB + kstep, voffB); PG8_STAGE(PG8_SA(1, 0), cA + kstep, voffA); PG8_STAGE(PG8_SB(1, 1), cB + hstep + kstep, voffB);
        PG8_WAIT_V(6); PG8_BAR;
    } else {
        PG8_STAGE(PG8_SB(0, 0), cB, voffB); PG8_STAGE(PG8_SA(0, 0), cA, voffA); PG8_STAGE(PG8_SB(0, 1), cB + hstep, voffB); PG8_STAGE(PG8_SA(0, 1), cA + hstep, voffA);
        if (wr == 1) PG8_BAR;
        PG8_WAIT_V(4); PG8_BAR;
        PG8_STAGE(PG8_SB(1, 0), cB + kstep, voffB); PG8_STAGE(PG8_SA(1, 0), cA + kstep, voffA); PG8_STAGE(PG8_SB(1, 1), cB + hstep + kstep, voffB);
        PG8_WAIT_V(6); PG8_BAR;
    }
    for (;;) {
        const bool has_next = S.next(ui + 1, nxt);
        const char* nA = has_next ? (const char*)g.A + (size_t)nxt.pm * tstep + (size_t)nxt.k0 * 2 : cA; const char* nB = has_next ? (const char*)g.Bt + (size_t)nxt.pn * tstep + (size_t)nxt.k0 * 2 : cB;
        for (int t = 0; t < nt; t += 2) {
            if constexpr (Epi::MID_T > 0) { if (t == Epi::MID_T && nt > Epi::MID_T) E.mid(acc, cur, wr, wc, fr, fq); }
            const bool last = (t == nt - 2);
            const char* a1 = cA + (size_t)(t + 1) * kstep;
            const char* a2 = last ? nA : cA + (size_t)(t + 2) * kstep; const char* b2 = last ? nB : cB + (size_t)(t + 2) * kstep;
            const char* a3 = a2 + kstep; const char* b3 = b2 + kstep;
            if (last && has_next) S.a_ready(nxt);
            if constexpr (SP2) {
            PG8_LDB(B0, 0, 0); PG8_LDB(B1, 0, 1); PG8_SCHED; PG8_LDA(At, 0, 0); PG8_STAGE(PG8_SA(1, 1), a1 + hstep, voffA);
            PG8_WAIT_V(8); PG8_WAIT_L(0); PG8_BAR; PG8_MMA(0, 0, At, B0); PG8_MMA(0, 1, At, B1); PG8_BAR; PG8_SCHED;
            PG8_LDA(At, 0, 1); PG8_STAGE(PG8_SB(0, 0), b2, voffB); PG8_STAGE(PG8_SB(0, 1), b2 + hstep, voffB); PG8_STAGE(PG8_SA(0, 0), a2, voffA);
            PG8_WAIT_V(8); PG8_WAIT_L(0); PG8_BAR; PG8_MMA(1, 0, At, B0); PG8_MMA(1, 1, At, B1); PG8_BAR; PG8_SCHED;
            PG8_LDB(B0, 1, 0); PG8_LDB(B1, 1, 1); PG8_SCHED; PG8_LDA(At, 1, 0); PG8_STAGE(PG8_SA(0, 1), a2 + hstep, voffA);
            PG8_WAIT_V(8); PG8_WAIT_L(0); PG8_BAR; PG8_MMA(0, 0, At, B0); PG8_MMA(0, 1, At, B1); PG8_BAR; PG8_SCHED;
            PG8_LDA(At, 1, 1); PG8_STAGE(PG8_SB(1, 0), b3, voffB); PG8_STAGE(PG8_SB(1, 1), b3 + hstep, voffB); PG8_STAGE(PG8_SA(1, 0), a3, voffA);
            PG8_WAIT_V(8); PG8_WAIT_L(0); PG8_BAR; PG8_MMA(1, 0, At, B0); PG8_MMA(1, 1, At, B1); PG8_BAR; PG8_SCHED;
            } else {
            PG8_LDB(B0, 0, 0); PG8_SCHED; PG8_LDA(At, 0, 0); PG8_STAGE(PG8_SA(1, 1), a1 + hstep, voffA);
            PG8_WAIT_L(8); PG8_BAR; PG8_WAIT_L(0); PG8_MMA(0, 0, At, B0); PG8_BAR; PG8_SCHED;
            PG8_LDB(B1, 0, 1); PG8_STAGE(PG8_SB(0, 0), b2, voffB);
            PG8_BAR; PG8_WAIT_L(0); PG8_MMA(0, 1, At, B1); PG8_BAR;
            PG8_LDA(At, 0, 1); PG8_STAGE(PG8_SA(0, 0), a2, voffA);
            PG8_BAR; PG8_WAIT_L(0); PG8_MMA(1, 0, At, B0); PG8_BAR; PG8_SCHED;
            PG8_STAGE(PG8_SB(0, 1), b2 + hstep, voffB);
            PG8_WAIT_V(6); PG8_BAR; PG8_MMA(1, 1, At, B1); PG8_BAR;
            PG8_LDB(B0, 1, 0); PG8_SCHED; PG8_LDA(At, 1, 0); PG8_STAGE(PG8_SA(0, 1), a2 + hstep, voffA);
            PG8_WAIT_L(8); PG8_BAR; PG8_WAIT_L(0); PG8_MMA(0, 0, At, B0); PG8_BAR; PG8_SCHED;
            PG8_LDB(B1, 1, 1); PG8_STAGE(PG8_SB(1, 0), b3, voffB);
            PG8_BAR; PG8_WAIT_L(0); PG8_MMA(0, 1, At, B1); PG8_BAR;
            PG8_LDA(At, 1, 1); PG8_STAGE(PG8_SA(1, 0), a3, voffA);
            PG8_BAR; PG8_WAIT_L(0); PG8_MMA(1, 0, At, B0); PG8_BAR; PG8_SCHED;
            PG8_STAGE(PG8_SB(1, 1), b3 + hstep, voffB);
            PG8_WAIT_V(6); PG8_BAR; PG8_MMA(1, 1, At, B1); PG8_BAR;
            }
        }
        if constexpr (ALIGN_EPI) { if (wr == 0) PG8_BAR; }
        if constexpr (!Epi::AFTER_DRAIN) { E(acc, cur, wr, wc, fr, fq); S.done(cur); }
        if (!has_next) break;
#pragma unroll
        for (int a = 0; a < 2; ++a)
#pragma unroll
            for (int b = 0; b < 2; ++b)
#pragma unroll
                for (int m = 0; m < 4; ++m)
#pragma unroll
                    for (int n = 0; n < 2; ++n) acc[a][b][m][n] = (f32x4){0.f, 0.f, 0.f, 0.f};
        cur = nxt; cA = nA; cB = nB; ++ui; nt = cur.nt ? cur.nt : K / BK;
        if constexpr (ALIGN_EPI) { if (wr == 1) PG8_BAR; }
    }
    PG8_WAIT_V(0);
    if constexpr (!ALIGN_EPI) { if (wr == 0) PG8_BAR; }
    PG8_BAR;
    if constexpr (Epi::AFTER_DRAIN) { E.fused(acc, cur, wr, wc, fr, fq, lds, wid, lane); S.done(cur); }
#undef PG8_SA
#undef PG8_SB
#undef PG8_STAGE
#undef PG8_LDA
#undef PG8_LDB
#undef PG8_MMA
#undef PG8_WAIT_V
#undef PG8_WAIT_L
#undef PG8_BAR
#undef PG8_SCHED
}
}

#define LAS __attribute__((address_space(3)))
namespace mk {
typedef unsigned short bf16;
typedef unsigned u32x4 __attribute__((ext_vector_type(4)));
typedef unsigned u32x2 __attribute__((ext_vector_type(2)));
typedef float f32x4 __attribute__((ext_vector_type(4)));
typedef short bf16x8 __attribute__((ext_vector_type(8)));
constexpr int NT = 512;

__device__ __forceinline__ unsigned f2bf(float f) { unsigned u = __builtin_bit_cast(unsigned, f); return (u + 0x7fffu + ((u >> 16) & 1u)) >> 16; }
__device__ __forceinline__ unsigned pk2(float lo, float hi) { return f2bf(lo) | (f2bf(hi) << 16); }
__device__ __forceinline__ float bf2f(unsigned h) { return __uint_as_float(h << 16); }
__device__ __forceinline__ float bflo(unsigned w) { return __uint_as_float(w << 16); }
__device__ __forceinline__ float bfhi(unsigned w) { return __uint_as_float(w & 0xffff0000u); }
__device__ __forceinline__ float wave_sum(float v) {
#pragma unroll
    for (int o = 1; o < 64; o <<= 1) v += __shfl_xor(v, o);
    return v;
}
__device__ __forceinline__ float wave_max(float v) {
#pragma unroll
    for (int o = 1; o < 64; o <<= 1) v = fmaxf(v, __shfl_xor(v, o));
    return v;
}
__device__ __forceinline__ float logsig(float x) { return fminf(x, 0.f) - __logf(1.0f + __expf(-fabsf(x))); }

#ifdef MK_SECT
#define PT(i) do { if (tid == 0) { LAS unsigned long long* pt_ = (LAS unsigned long long*)(lds + LDS_BYTES - 256); const unsigned long long n_ = __builtin_amdgcn_s_memrealtime(); pt_[1 + (i)] += n_ - pt_[0]; pt_[0] = n_; } } while (0)
#define PT_RESET() do { if (tid == 0) { ((LAS unsigned long long*)(lds + LDS_BYTES - 256))[0] = __builtin_amdgcn_s_memrealtime(); } } while (0)
#else
#define PT(i) do { } while (0)
#define PT_RESET() do { } while (0)
#endif
struct Args { const float* in[20]; float* out; unsigned char* ws; int ph_lo, ph_hi; };

__device__ __forceinline__ int win_dst(int n) { return n < 1792 ? n : (n < 1808 ? C_GLR + (n - 1792) : n - 16); }
template <bool MAP>
__device__ __forceinline__ void transpose_item(const float* W, int K, int N, bf16* WT, LAS float* scr, int item, int lane, int ldk = 0) {
    if (ldk == 0) ldk = K;
    const int nblk = (N + 31) / 32, kb = item / nblk, nb = item % nblk, k0 = 64 * kb, n0 = 32 * nb;
    const int ncol = n0 + (lane & 31);
    float wv[32];
    const float* wp = W + (size_t)(k0 + (lane >> 5)) * N + (ncol < N ? ncol : N - 1);
#pragma unroll
    for (int i = 0; i < 32; ++i) wv[i] = wp[(size_t)(2 * i) * N];
#pragma unroll
    for (int i = 0; i < 32; ++i) { const int kk = 2 * i + (lane >> 5); scr[kk * 33 + (lane & 31)] = (ncol < N) ? wv[i] : 0.f; }
    asm volatile("s_waitcnt lgkmcnt(0)" ::: "memory");
    const int c = lane & 7;
#pragma unroll
    for (int j = 0; j < 4; ++j) { const int n = (lane >> 3) + 8 * j; const LAS float* s = scr + (8 * c) * 33 + n;
        u32x4 o; o.x = pk2(s[0 * 33], s[1 * 33]); o.y = pk2(s[2 * 33], s[3 * 33]); o.z = pk2(s[4 * 33], s[5 * 33]); o.w = pk2(s[6 * 33], s[7 * 33]);
        const int nsrc = n0 + n;
        if (nsrc < N) { const int nd = MAP ? win_dst(nsrc) : nsrc; *(u32x4*)(WT + (size_t)nd * ldk + k0 + 8 * c) = o; } }
    asm volatile("s_waitcnt lgkmcnt(0)" ::: "memory");
}

__device__ __forceinline__ void convert_layer(const Args& a, LAS unsigned char* lds, int tid, int l, int gw, int ngw) {
    const int lane = tid & 63, wave = tid >> 6;
    LAS float* scr = (LAS float*)(lds + wave * 16384);
    bf16* wt = (bf16*)(a.ws + WS_WT) + (size_t)l * WT_LAYER;
    constexpr int I_IN = 16 * 137, I_A = 8 * 32, I_O = 16 * 32, I_U = 16 * 128, I_D = 64 * 32, I_L = I_IN + 2 * I_A + I_O + I_U + I_D;
    for (int it = gw; it < I_L; it += ngw) {
        int r = it;
        if (r < I_IN) { transpose_item<true>(a.in[6] + (size_t)l * 1024 * NIN, 1024, NIN, wt + WT_IN, scr, r, lane); continue; } r -= I_IN;
        if (r < I_A) { transpose_item<false>(a.in[11] + (size_t)l * 512 * 1024, 512, 1024, wt + WT_A, scr, r, lane, 1024); continue; } r -= I_A;
        if (r < I_A) { transpose_item<false>(a.in[12] + (size_t)l * 512 * 1024, 512, 1024, wt + WT_A + 512, scr, r, lane, 1024); continue; } r -= I_A;
        if (r < I_O) { transpose_item<false>(a.in[13] + (size_t)l * 1024 * 1024, 1024, 1024, wt + WT_OUT, scr, r, lane); continue; } r -= I_O;
        if (r < I_U) { transpose_item<false>(a.in[16] + (size_t)l * 1024 * 4096, 1024, 4096, wt + WT_UP, scr, r, lane); continue; } r -= I_U;
        transpose_item<false>(a.in[17] + (size_t)l * 4096 * 1024, 4096, 1024, wt + WT_DOWN, scr, r, lane);
    }
}
__device__ __forceinline__ void p0_prologue(const Args& a, LAS unsigned char* lds, int tid) {
    const int lane = tid & 63, wave = tid >> 6;
    const int gw = blockIdx.x * 8 + wave, NGW = gridDim.x * 8;
    convert_layer(a, lds, tid, 0, gw, NGW);
    float* rope = (float*)(a.ws + WS_ROPE);
    for (int i = blockIdx.x * NT + tid; i < (LP + 1) * 8; i += gridDim.x * NT) {
        const int pi = i >> 3, f = i & 7; const float pos = (pi == LP) ? 8192.f : (float)pi;
        const float inv = powf(500000.0f, -(float)f * 0.125f);
        const float ang = pos * inv;
        const double rev = (double)ang * 0.15915494309189535; const float fr = (float)(rev - rint(rev));
        rope[pi * 16 + f] = __builtin_amdgcn_cosf(fr); rope[pi * 16 + 8 + f] = __builtin_amdgcn_sinf(fr);
    }
    float* X = (float*)(a.ws + WS_X); bf16* ACT = (bf16*)(a.ws + WS_ACT);
    for (int row0 = gw; row0 < MPAD; row0 += 4 * NGW) {
        f32x4 v[4][4];
#pragma unroll
        for (int u = 0; u < 4; ++u) {
            const int row = row0 + u * NGW; const float* src = nullptr;
            if (row < MP) { const int b = row / LP, p = row - b * LP; src = (p < 16) ? a.in[5] + (size_t)p * D : a.in[0] + ((size_t)b * 4096 + (p - 16)) * D; }
            else if (row < MREAL) src = a.in[1] + (size_t)(row - MP) * D;
#pragma unroll
            for (int j = 0; j < 4; ++j) v[u][j] = src ? *((const f32x4*)src + lane + 64 * j) : (f32x4){0.f, 0.f, 0.f, 0.f};
        }
#pragma unroll
        for (int u = 0; u < 4; ++u) {
            const int row = row0 + u * NGW; if (row >= MPAD) continue;
#pragma unroll
            for (int j = 0; j < 4; ++j) {
                *((f32x4*)(X + (size_t)row * D) + lane + 64 * j) = v[u][j] * ALPHA;
                u32x2 w; w.x = pk2(v[u][j].x, v[u][j].y); w.y = pk2(v[u][j].z, v[u][j].w);
                *((u32x2*)(ACT + (size_t)row * D) + lane + 64 * j) = w;
            }
        }
    }
}

__device__ __forceinline__ void ln_pair(const Args& a, const f32x4 (&gv)[4], const f32x4 (&bv)[4], bool last, int nsplit, int row0, int row1, bool has1, int lane) {
    float* X = (float*)(a.ws + WS_X); bf16* ACT = (bf16*)(a.ws + WS_ACT);
    f32x4 v[2][4];
#pragma unroll
    for (int j = 0; j < 4; ++j) { v[0][j] = *((const f32x4*)(X + (size_t)row0 * D) + lane + 64 * j); v[1][j] = has1 ? *((const f32x4*)(X + (size_t)row1 * D) + lane + 64 * j) : (f32x4){0.f, 0.f, 0.f, 0.f}; }
    if (row0 >= 64 * 256 || (has1 && row1 >= 64 * 256)) {
        const float* PART = (const float*)(a.ws + WS_PART);
        for (int s = 0; s < nsplit; ++s) {
#pragma unroll
            for (int j = 0; j < 4; ++j) {
                if (row0 >= 64 * 256) v[0][j] += *((const f32x4*)(PART + ((size_t)s * 256 + (row0 - 64 * 256)) * D) + lane + 64 * j);
                if (has1 && row1 >= 64 * 256) v[1][j] += *((const f32x4*)(PART + ((size_t)s * 256 + (row1 - 64 * 256)) * D) + lane + 64 * j);
            }
        }
    }
#pragma unroll
    for (int u = 0; u < 2; ++u) {
        const int row = u ? row1 : row0;
        float s = 0.f;
#pragma unroll
        for (int j = 0; j < 4; ++j) s += (v[u][j].x + v[u][j].y) + (v[u][j].z + v[u][j].w);
        const float mean = wave_sum(s) * (1.f / D); float s2 = 0.f;
#pragma unroll
        for (int j = 0; j < 4; ++j) { v[u][j] = v[u][j] - mean; s2 += (v[u][j].x * v[u][j].x + v[u][j].y * v[u][j].y) + (v[u][j].z * v[u][j].z + v[u][j].w * v[u][j].w); }
        const float rstd = 1.f / sqrtf(wave_sum(s2) * (1.f / D) + 1e-5f);
        if (u == 1 && !has1) continue;
        float* yo = nullptr;
        if (last) { if (row >= MP) yo = a.out + O_YS + (size_t)(row - MP) * D; else { const int b = row / LP, p = row - b * LP; if (p >= 16) yo = a.out + O_YP + ((size_t)b * 4096 + (p - 16)) * D; } }
#pragma unroll
        for (int j = 0; j < 4; ++j) {
            const f32x4 o = v[u][j] * rstd * gv[j] + bv[j];
            if (last) { if (yo) *((f32x4*)yo + lane + 64 * j) = o; }
            else { *((f32x4*)(X + (size_t)row * D) + lane + 64 * j) = o * ALPHA; u32x2 w; w.x = pk2(o.x, o.y); w.y = pk2(o.z, o.w); *((u32x2*)(ACT + (size_t)row * D) + lane + 64 * j) = w; }
        }
    }
}
__device__ __forceinline__ void ln_phase(const Args& a, const float* g, const float* bt, bool last, int nsplit, int tid) {
    const int lane = tid & 63, wave = tid >> 6;
    const int gw = blockIdx.x * 8 + wave, NGW = gridDim.x * 8;
    f32x4 gv[4], bv[4];
#pragma unroll
    for (int j = 0; j < 4; ++j) { gv[j] = *((const f32x4*)g + lane + 64 * j); bv[j] = *((const f32x4*)bt + lane + 64 * j); }
#pragma unroll 2
    for (int row0 = gw; row0 < MREAL; row0 += 2 * NGW) ln_pair(a, gv, bv, last, nsplit, row0, row0 + NGW, row0 + NGW < MREAL, lane);
}
__device__ __forceinline__ void wait_count(unsigned* p, unsigned need, int tid) {
    if (tid < 64) {
        const unsigned long long t0 = __builtin_amdgcn_s_memrealtime();
        while ((unsigned)__builtin_amdgcn_readfirstlane(__hip_atomic_load(p, __ATOMIC_RELAXED, __HIP_MEMORY_SCOPE_AGENT)) < need) {
            if (__builtin_amdgcn_s_memrealtime() - t0 > 2000000ull) break;
            __builtin_amdgcn_s_sleep(2);
        }
        __builtin_amdgcn_fence(__ATOMIC_ACQUIRE, "agent");
        asm volatile("s_waitcnt vmcnt(0)" ::: "memory");
    }
    __syncthreads();
}
__device__ __forceinline__ void ln_exchange(const Args& a, unsigned* cnt, int cu, int S, const float* g, const float* bt, bool last, int tid) {
    const int lane = tid & 63, wave = tid >> 6;
    pg8::StaticOrder so; so.init(64 * 256, 1024, (int)gridDim.x, cu); pg8::Unit um; so.next(0, um);
    const bool has_tail = um.pm < S;
    asm volatile("s_waitcnt vmcnt(0)" ::: "memory");
    __syncthreads();
    if (tid == 0) {
        __builtin_amdgcn_fence(__ATOMIC_RELEASE, "agent");
        asm volatile("s_waitcnt vmcnt(0)" ::: "memory");
        __hip_atomic_fetch_add(cnt + 64 * um.pm, 1u, __ATOMIC_RELAXED, __HIP_MEMORY_SCOPE_AGENT);
        if (has_tail) __hip_atomic_fetch_add(cnt + 64 * 64, 1u, __ATOMIC_RELAXED, __HIP_MEMORY_SCOPE_AGENT);
    }
    f32x4 gv[4], bv[4];
#pragma unroll
    for (int j = 0; j < 4; ++j) { gv[j] = *((const f32x4*)g + lane + 64 * j); bv[j] = *((const f32x4*)bt + lane + 64 * j); }
    wait_count(cnt + 64 * um.pm, 4u, tid);
    const int rbase = um.pm * 256 + um.pn * 64 + wave;
#pragma unroll 1
    for (int i = 0; i < 8; i += 2) ln_pair(a, gv, bv, last, 0, rbase + 8 * i, rbase + 8 * i + 8, true, lane);
    if (has_tail) {
        wait_count(cnt + 64 * 64, 4u * (unsigned)S, tid);
        const int L = um.pm * 4 + um.pn, r = L + 4 * S * wave;
        if (r < MREAL - 64 * 256) ln_pair(a, gv, bv, last, S, 64 * 256 + r, 0, false, lane);
    }
}

__device__ __forceinline__ void attn_item(LAS unsigned char* lds, const bf16* P, bf16* MIXA, const float* sinkp, int b, int n, int h0, int tid) {
    LAS bf16* Ks = (LAS bf16*)lds;
    LAS bf16* Vt = (LAS bf16*)(lds + 36864);
    const int kvh = h0 >> 2, lane = tid & 63, w = tid >> 6, fr = lane & 15, fq = lane >> 4;
    for (int i = tid; i < 64 * 24; i += NT) Vt[(i / 24) * 280 + 256 + (i % 24)] = 0;
#pragma unroll
    for (int i = 0; i < 4; ++i) {
        const int q = tid + NT * i, key = q >> 3, part = q & 7, slot = (n - 1) * 128 + key;
        const bf16* src = P + (size_t)(b * LP + (slot >= 112 ? slot - 112 : 0)) * PST;
        u32x4 kv = *(const u32x4*)(src + C_K + kvh * 64 + part * 8), vv = *(const u32x4*)(src + C_V + kvh * 64 + part * 8);
        if (slot < 112) { kv = (u32x4){0u, 0u, 0u, 0u}; vv = (u32x4){0u, 0u, 0u, 0u}; }
        *(LAS u32x4*)(Ks + key * 72 + part * 8) = kv;
        LAS bf16* vd = Vt + (part * 8) * 280 + key;
        vd[0 * 280] = (bf16)(vv.x & 0xffffu); vd[1 * 280] = (bf16)(vv.x >> 16); vd[2 * 280] = (bf16)(vv.y & 0xffffu); vd[3 * 280] = (bf16)(vv.y >> 16);
        vd[4 * 280] = (bf16)(vv.z & 0xffffu); vd[5 * 280] = (bf16)(vv.z >> 16); vd[6 * 280] = (bf16)(vv.w & 0xffffu); vd[7 * 280] = (bf16)(vv.w >> 16);
    }
    const int qi = 16 * w + fr, slotq = n * 128 + qi; const bool qv = slotq >= 112;
    const size_t qrow = (size_t)(b * LP + (qv ? slotq - 112 : 0));
    bf16x8 qf2[2][2];
#pragma unroll
    for (int hh = 0; hh < 2; ++hh)
#pragma unroll
        for (int kk = 0; kk < 2; ++kk) { qf2[hh][kk] = *(const bf16x8*)(P + qrow * PST + (h0 + hh) * 64 + kk * 32 + 8 * fq); if (!qv) qf2[hh][kk] = (bf16x8){0, 0, 0, 0, 0, 0, 0, 0}; }
    const float sink2[2] = {sinkp[0], sinkp[1]};
    __syncthreads();
#pragma unroll
    for (int hh = 0; hh < 2; ++hh) {
    const int h = h0 + hh; const float sink = sink2[hh]; const bf16x8 qf[2] = {qf2[hh][0], qf2[hh][1]};
    f32x4 s[9];
#pragma unroll
    for (int r = 0; r < 9; ++r) {
        f32x4 acc = (f32x4){0.f, 0.f, 0.f, 0.f};
#pragma unroll
        for (int kk = 0; kk < 2; ++kk) { const bf16x8 kf = *(const LAS bf16x8*)(Ks + ((w + r) * 16 + fr) * 72 + kk * 32 + 8 * fq); acc = __builtin_amdgcn_mfma_f32_16x16x32_bf16(kf, qf[kk], acc, 0, 0, 0); }
        s[r] = acc;
    }
    float mx = sink;
#pragma unroll
    for (int r = 0; r < 9; ++r)
#pragma unroll
        for (int j = 0; j < 4; ++j) {
            const int dl = 16 * r + 4 * fq + j - fr, slotk = (n - 1) * 128 + 16 * (w + r) + 4 * fq + j;
            const bool ok = dl > 0 && dl <= 128 && slotk >= 112;
            const float v = ok ? s[r][j] * 0.125f : -INFINITY; s[r][j] = v; mx = fmaxf(mx, v);
        }
    mx = fmaxf(mx, __shfl_xor(mx, 16)); mx = fmaxf(mx, __shfl_xor(mx, 32));
    float sum = 0.f;
#pragma unroll
    for (int r = 0; r < 9; ++r)
#pragma unroll
        for (int j = 0; j < 4; ++j) { const float p = __expf(s[r][j] - mx); s[r][j] = p; sum += p; }
    sum += __shfl_xor(sum, 16); sum += __shfl_xor(sum, 32);
    const float rden = 1.0f / (sum + __expf(sink - mx));
    f32x4 o[4];
#pragma unroll
    for (int dt = 0; dt < 4; ++dt) o[dt] = (f32x4){0.f, 0.f, 0.f, 0.f};
#pragma unroll
    for (int ks = 0; ks < 5; ++ks) {
        u32x4 pw; pw.x = pk2(s[2 * ks][0], s[2 * ks][1]); pw.y = pk2(s[2 * ks][2], s[2 * ks][3]);
        if (ks < 4) { pw.z = pk2(s[2 * ks + 1 > 8 ? 8 : 2 * ks + 1][0], s[2 * ks + 1 > 8 ? 8 : 2 * ks + 1][1]); pw.w = pk2(s[2 * ks + 1 > 8 ? 8 : 2 * ks + 1][2], s[2 * ks + 1 > 8 ? 8 : 2 * ks + 1][3]); }
        else { pw.z = 0u; pw.w = 0u; }
        const bf16x8 pf = __builtin_bit_cast(bf16x8, pw);
        const int keyb = 16 * (w + 2 * ks) + 4 * fq;
#pragma unroll
        for (int dt = 0; dt < 4; ++dt) {
            const LAS bf16* vp = Vt + (dt * 16 + fr) * 280 + keyb;
            const u32x2 lo = *(const LAS u32x2*)vp, hi = *(const LAS u32x2*)(vp + 16);
            u32x4 vw; vw.x = lo.x; vw.y = lo.y; vw.z = hi.x; vw.w = hi.y;
            o[dt] = __builtin_amdgcn_mfma_f32_16x16x32_bf16(__builtin_bit_cast(bf16x8, vw), pf, o[dt], 0, 0, 0);
        }
    }
    if (qv) {
#pragma unroll
        for (int dt = 0; dt < 4; ++dt) { u32x2 w2; w2.x = pk2(o[dt][0] * rden, o[dt][1] * rden); w2.y = pk2(o[dt][2] * rden, o[dt][3] * rden);
            *(u32x2*)(MIXA + qrow * 1024 + h * 64 + dt * 16 + 4 * fq) = w2; }
    }
    }
}

__device__ __forceinline__ void sattn_item(LAS unsigned char* lds, const Args& a, int layer, int s, int tid) {
    LAS float* Kf = (LAS float*)lds;
    LAS float* Vf = Kf + 16384;
    LAS float* qs = Vf + 16384;
    LAS float* ps = qs + 512;
    const bf16* P = (const bf16*)(a.ws + WS_P);
    bf16* MIXA = (bf16*)(a.ws + WS_MIXA);
    const float* ck = a.in[2] + (size_t)(layer * NS + s) * 16384; const float* cv = a.in[3] + (size_t)(layer * NS + s) * 16384;
    float* ok = a.out + O_KWS + (size_t)(layer * NS + s) * 16384; float* ov = a.out + O_VWS + (size_t)(layer * NS + s) * 16384;
    for (int f4 = tid; f4 < 128 * 32; f4 += NT) {
        const int f = f4 * 4, r = f >> 7, rem = f & 127, li = (rem >> 6) * 8192 + r * 64 + (rem & 63);
        f32x4 kv, vv;
        if (r < 127) { kv = *(const f32x4*)(ck + 128 + f); vv = *(const f32x4*)(cv + 128 + f); __builtin_nontemporal_store(kv, (f32x4*)(ok + f)); __builtin_nontemporal_store(vv, (f32x4*)(ov + f)); }
        else { kv = *(const f32x4*)(ok + f); vv = *(const f32x4*)(ov + f); }
        *(LAS f32x4*)(Kf + li) = kv; *(LAS f32x4*)(Vf + li) = vv;
    }
    const int row = MP + s, h = tid >> 6, lane = tid & 63, kvh = h >> 2;
    qs[tid] = bf2f(P[(size_t)row * PST + tid]);
    __syncthreads();
    const float sink = a.in[9][layer * 8 + h];
    float s0 = 0.f, s1 = 0.f;
    const LAS float* k0 = Kf + kvh * 8192 + lane * 64; const LAS float* k1 = k0 + 64 * 64;
#pragma unroll 8
    for (int d = 0; d < 64; ++d) { const int dd = (d + lane) & 63; const float q = qs[h * 64 + dd]; s0 += q * k0[dd]; s1 += q * k1[dd]; }
    s0 *= 0.125f; s1 *= 0.125f;
    const float mx = fmaxf(wave_max(fmaxf(s0, s1)), sink);
    const float p0 = __expf(s0 - mx), p1 = __expf(s1 - mx);
    const float rden = 1.0f / (wave_sum(p0 + p1) + __expf(sink - mx));
    ps[h * 128 + lane] = p0; ps[h * 128 + 64 + lane] = p1;
    __syncthreads();
    float o = 0.f;
    const LAS float* vb = Vf + kvh * 8192 + lane;
#pragma unroll 8
    for (int r = 0; r < 128; ++r) o += ps[h * 128 + r] * vb[r * 64];
    MIXA[(size_t)row * 1024 + tid] = (bf16)f2bf(o * rden);
}

__device__ __forceinline__ void gla_prep(LAS float* tot, const Args& a, int layer, int h, int rowbase  , int tvalid0, int tid, float (&cum)[8]) {
    const bf16* P = (const bf16*)(a.ws + WS_P);
    const int d = tid & 63, tg = tid >> 6;
    float wa[16];
#pragma unroll
    for (int r = 0; r < 16; ++r) wa[r] = a.in[7][(size_t)(layer * 16 + r) * 256 + h * 64 + d];
    const float ba = a.in[8][layer * 256 + h * 64 + d];
    float run = 0.f;
    u32x4 g0a[8], g1a[8];
#pragma unroll
    for (int i = 0; i < 8; ++i) { const int t = tg * 8 + i; const u32x4* gp = (const u32x4*)(P + (size_t)(rowbase + (t >= tvalid0 ? t : tvalid0)) * PST + C_GLR); g0a[i] = gp[0]; g1a[i] = gp[1]; }
#pragma unroll
    for (int i = 0; i < 8; ++i) {
        const int t = tg * 8 + i; float la = 0.f;
        const u32x4 g0 = g0a[i], g1 = g1a[i];
        {
            float x = ba;
            x += bflo(g0.x) * wa[0] + bfhi(g0.x) * wa[1] + bflo(g0.y) * wa[2] + bfhi(g0.y) * wa[3] + bflo(g0.z) * wa[4] + bfhi(g0.z) * wa[5] + bflo(g0.w) * wa[6] + bfhi(g0.w) * wa[7];
            x += bflo(g1.x) * wa[8] + bfhi(g1.x) * wa[9] + bflo(g1.y) * wa[10] + bfhi(g1.y) * wa[11] + bflo(g1.z) * wa[12] + bfhi(g1.z) * wa[13] + bflo(g1.w) * wa[14] + bfhi(g1.w) * wa[15];
            la = (t >= tvalid0) ? logsig(x) * (1.0f / 16.0f) : 0.f;
        }
        run += la; cum[i] = run;
    }
    tot[tg * 64 + d] = run;
    __syncthreads();
    float pre = 0.f;
#pragma unroll
    for (int g = 0; g < 8; ++g) pre += (g < tg) ? tot[g * 64 + d] : 0.f;
#pragma unroll
    for (int i = 0; i < 8; ++i) cum[i] += pre;
}

constexpr size_t O_KVL = O_YP, O_S0T = O_YP + (size_t)16 * NCH * 8192;
static_assert(O_S0T + (size_t)16 * NCH * 8192 / 2 <= O_YS, "GLA scratch fits in y_prompt");

__device__ __forceinline__ void gla_stage_vt(LAS bf16* VT, const bf16* P, int rowbase, int h, int tv0, int tid) {
    const int e = tid & 127, tq = tid >> 7;
    unsigned w[8];
#pragma unroll
    for (int i = 0; i < 8; ++i) {
        const int t0 = tq * 16 + 2 * i;
        unsigned lo = P[(size_t)(rowbase + (t0 >= tv0 ? t0 : tv0)) * PST + C_GV + h * 128 + e];
        unsigned hi = P[(size_t)(rowbase + (t0 + 1 >= tv0 ? t0 + 1 : tv0)) * PST + C_GV + h * 128 + e];
        lo = (t0 >= tv0) ? lo : 0u; hi = (t0 + 1 >= tv0) ? hi : 0u;
        w[i] = lo | (hi << 16);
    }
    LAS u32x4* dst = (LAS u32x4*)(VT + e * 72 + tq * 16);
    dst[0] = (u32x4){w[0], w[1], w[2], w[3]}; dst[1] = (u32x4){w[4], w[5], w[6], w[7]};
}

__device__ __forceinline__ void gla1_item(LAS unsigned char* lds, const Args& a, int layer, int bh, int c, int tid) {
    LAS float* tot = (LAS float*)lds;
    LAS bf16* KlT = (LAS bf16*)(lds + 2048);
    LAS bf16* VT = (LAS bf16*)(lds + 2048 + 9216);
    const bf16* P = (const bf16*)(a.ws + WS_P);
    const int b = bh >> 2, h = bh & 3, rowbase = b * LP + 64 * c - 112, tv0 = (c == 1) ? 48 : 0;
    const int d = tid & 63, tg = tid >> 6;
    float kraw[8];
#pragma unroll
    for (int i = 0; i < 8; ++i) { const int t = tg * 8 + i; kraw[i] = bf2f(P[(size_t)(rowbase + (t >= tv0 ? t : tv0)) * PST + C_GK + h * 64 + d]); }
    gla_stage_vt(VT, P, rowbase, h, tv0, tid);
    float cum[8];
    gla_prep(tot, a, layer, h, rowbase, tv0, tid, cum);
    float bl = 0.f;
#pragma unroll
    for (int g = 0; g < 8; ++g) bl += tot[g * 64 + d];
    {
        float kl[8];
#pragma unroll
        for (int i = 0; i < 8; ++i) { const int t = tg * 8 + i; kl[i] = 0.f;
            if (t >= tv0) kl[i] = kraw[i] * __expf(bl - cum[i]); }
        *(LAS u32x4*)(KlT + d * 72 + tg * 8) = (u32x4){pk2(kl[0], kl[1]), pk2(kl[2], kl[3]), pk2(kl[4], kl[5]), pk2(kl[6], kl[7])};
    }
    if (tid < 64) ((float*)(a.ws + WS_DEC))[(size_t)(bh * NCH + c) * 64 + tid] = __expf(bl);
    __syncthreads();
    const int lane = tid & 63, w = tid >> 6, fr = lane & 15, fq = lane >> 4;
    f32x4 acc[4];
#pragma unroll
    for (int dt = 0; dt < 4; ++dt) acc[dt] = (f32x4){0.f, 0.f, 0.f, 0.f};
#pragma unroll
    for (int ks = 0; ks < 2; ++ks) {
        const bf16x8 xv = *(const LAS bf16x8*)(VT + (16 * w + fr) * 72 + 32 * ks + 8 * fq);
#pragma unroll
        for (int dt = 0; dt < 4; ++dt) { const bf16x8 yk = *(const LAS bf16x8*)(KlT + (16 * dt + fr) * 72 + 32 * ks + 8 * fq); acc[dt] = __builtin_amdgcn_mfma_f32_16x16x32_bf16(xv, yk, acc[dt], 0, 0, 0); }
    }
    float* kvl = a.out + O_KVL + (size_t)(bh * NCH + c) * 8192;
#pragma unroll
    for (int dt = 0; dt < 4; ++dt)
#pragma unroll
        for (int r = 0; r < 4; ++r) kvl[(16 * w + 4 * fq + r) * 64 + 16 * dt + fr] = acc[dt][r];
}

__device__ __forceinline__ void gla_scan(const Args& a, int layer, int tid) {
    const float* __restrict__ DEC = (const float*)(a.ws + WS_DEC);
    const float* __restrict__ KVL = a.out + O_KVL;
    bf16* __restrict__ S0T = (bf16*)(a.out + O_S0T);
    for (int idx = blockIdx.x * NT + tid; idx < 16 * 8192; idx += gridDim.x * NT) {
        const int bh = idx >> 13, ed = idx & 8191, d = ed & 63, e = ed >> 6;
        const float* kvl = KVL + (size_t)bh * NCH * 8192 + ed; const float* dec = DEC + (size_t)bh * NCH * 64 + d;
        bf16* st = S0T + (size_t)bh * NCH * 8192 + ed;
        float S = 0.f;
#pragma unroll
        for (int hb = 0; hb < 2; ++hb) {
            const int c0 = hb ? 34 : 1, nb = hb ? 32 : 33;
            float kv[33], dc[33];
#pragma unroll
            for (int i = 0; i < 33; ++i) if (i < nb) { kv[i] = kvl[(size_t)(c0 + i) * 8192]; dc[i] = dec[(c0 + i) * 64]; }
#pragma unroll
            for (int i = 0; i < 33; ++i) if (i < nb) { st[(size_t)(c0 + i) * 8192] = (bf16)f2bf(S); S = dc[i] * S + kv[i]; }
        }
        a.out[O_STP + (size_t)(layer * 16 + bh) * 8192 + d * 128 + e] = S;
    }
}

__device__ __forceinline__ void gla3_item(LAS unsigned char* lds, const Args& a, int layer, int bh, int c, int tid) {
    LAS float* tot = (LAS float*)lds;
    LAS float* Bm = (LAS float*)(lds + 2048);
    LAS bf16* Qe = (LAS bf16*)(lds + 2048 + 16640);
    LAS bf16* Kd = Qe + 64 * 72;
    LAS bf16* VT = Kd + 64 * 72;
    LAS float* ssq = (LAS float*)(lds + 2048 + 16640 + 9216 + 9216 + 18432);
    const bf16* P = (const bf16*)(a.ws + WS_P);
    bf16* MIXB = (bf16*)(a.ws + WS_MIXA) + 512;
    const int b = bh >> 2, h = bh & 3, rowbase = b * LP + 64 * c - 112, tv0 = (c == 1) ? 48 : 0;
    const int lane = tid & 63, w = tid >> 6, fr = lane & 15, fq = lane >> 4, tt = w & 3, eh = w >> 2;
    PT(0);
    u32x4 qw, kw;
    { const int t = tid >> 3, dp = tid & 7; const bf16* pr = P + (size_t)(rowbase + (t >= tv0 ? t : tv0)) * PST + h * 64 + 8 * dp; qw = *(const u32x4*)(pr + C_GQ); kw = *(const u32x4*)(pr + C_GK); }
    gla_stage_vt(VT, P, rowbase, h, tv0, tid);
    float cum[8];
    gla_prep(tot, a, layer, h, rowbase, tv0, tid, cum);
    PT(1);
    bf16x8 s0f[4][2];
    {
        const bf16* S0T = (const bf16*)(a.out + O_S0T) + (size_t)(bh * NCH + c) * 8192;
#pragma unroll
        for (int i = 0; i < 4; ++i)
#pragma unroll
            for (int ks = 0; ks < 2; ++ks) { s0f[i][ks] = (bf16x8){0, 0, 0, 0, 0, 0, 0, 0}; if (c != 1) s0f[i][ks] = *(const bf16x8*)(S0T + (16 * (4 * eh + i) + fr) * 64 + 32 * ks + 8 * fq); }
    }
    f32x4 g4v[4]; u32x2 rwv[4];
    { const int t = 16 * tt + fr; const size_t row = (size_t)(rowbase + (t >= tv0 ? t : tv0));
#pragma unroll
      for (int i = 0; i < 4; ++i) { const int e0 = 16 * (4 * eh + i) + 4 * fq; g4v[i] = *(const f32x4*)(a.in[10] + layer * 128 + e0); rwv[i] = *(const u32x2*)(P + row * PST + C_GR + h * 128 + e0); } }
    {
        const int d = tid & 63, tg = tid >> 6;
#pragma unroll
        for (int i = 0; i < 8; ++i) Bm[(tg * 8 + i) * 65 + d] = cum[i];
    }
    __syncthreads();
    {
        const int t = tid >> 3, dp = tid & 7;
        if (t < tv0) { qw = (u32x4){0u, 0u, 0u, 0u}; kw = (u32x4){0u, 0u, 0u, 0u}; }
        float bb[8];
#pragma unroll
        for (int i = 0; i < 8; ++i) bb[i] = Bm[t * 65 + 8 * dp + i];
        float q[8] = {bflo(qw.x), bfhi(qw.x), bflo(qw.y), bfhi(qw.y), bflo(qw.z), bfhi(qw.z), bflo(qw.w), bfhi(qw.w)};
        float k[8] = {bflo(kw.x), bfhi(kw.x), bflo(kw.y), bfhi(kw.y), bflo(kw.z), bfhi(kw.z), bflo(kw.w), bfhi(kw.w)};
#pragma unroll
        for (int i = 0; i < 8; ++i) { q[i] *= 0.125f * __expf(bb[i]); k[i] *= __expf(-bb[i]); }
        *(LAS u32x4*)(Qe + t * 72 + 8 * dp) = (u32x4){pk2(q[0], q[1]), pk2(q[2], q[3]), pk2(q[4], q[5]), pk2(q[6], q[7])};
        *(LAS u32x4*)(Kd + t * 72 + 8 * dp) = (u32x4){pk2(k[0], k[1]), pk2(k[2], k[3]), pk2(k[4], k[5]), pk2(k[6], k[7])};
    }
    __syncthreads();
    PT(2);
    bf16x8 qf[2];
#pragma unroll
    for (int ks = 0; ks < 2; ++ks) qf[ks] = *(const LAS bf16x8*)(Qe + (16 * tt + fr) * 72 + 32 * ks + 8 * fq);
    bf16x8 ap[2];
#pragma unroll
    for (int kp = 0; kp < 2; ++kp) {
        f32x4 a2[2];
#pragma unroll
        for (int u = 0; u < 2; ++u) {
            const int jt = 2 * kp + u; f32x4 acc = (f32x4){0.f, 0.f, 0.f, 0.f};
#pragma unroll
            for (int ks = 0; ks < 2; ++ks) { const bf16x8 kf = *(const LAS bf16x8*)(Kd + (16 * jt + fr) * 72 + 32 * ks + 8 * fq); acc = __builtin_amdgcn_mfma_f32_16x16x32_bf16(kf, qf[ks], acc, 0, 0, 0); }
#pragma unroll
            for (int r = 0; r < 4; ++r) acc[r] = (16 * jt + 4 * fq + r <= 16 * tt + fr) ? acc[r] : 0.f;
            a2[u] = acc;
        }
        u32x4 pw; pw.x = pk2(a2[0][0], a2[0][1]); pw.y = pk2(a2[0][2], a2[0][3]); pw.z = pk2(a2[1][0], a2[1][1]); pw.w = pk2(a2[1][2], a2[1][3]);
        ap[kp] = __builtin_bit_cast(bf16x8, pw);
    }
    f32x4 o[4]; float ss = 0.f;
#pragma unroll
    for (int i = 0; i < 4; ++i) {
        f32x4 acc = (f32x4){0.f, 0.f, 0.f, 0.f};
#pragma unroll
        for (int ks = 0; ks < 2; ++ks) acc = __builtin_amdgcn_mfma_f32_16x16x32_bf16(s0f[i][ks], qf[ks], acc, 0, 0, 0);
#pragma unroll
        for (int kp = 0; kp < 2; ++kp) {
            const LAS bf16* vp = VT + (16 * (4 * eh + i) + fr) * 72 + 32 * kp + 4 * fq;
            const u32x2 lo = *(const LAS u32x2*)vp, hi = *(const LAS u32x2*)(vp + 16);
            u32x4 vw; vw.x = lo.x; vw.y = lo.y; vw.z = hi.x; vw.w = hi.y;
            acc = __builtin_amdgcn_mfma_f32_16x16x32_bf16(__builtin_bit_cast(bf16x8, vw), ap[kp], acc, 0, 0, 0);
        }
        o[i] = acc; ss += (acc[0] * acc[0] + acc[1] * acc[1]) + (acc[2] * acc[2] + acc[3] * acc[3]);
    }
    ss += __shfl_xor(ss, 16); ss += __shfl_xor(ss, 32);
    if (fq == 0) ssq[eh * 64 + 16 * tt + fr] = ss;
    __syncthreads();
    const int t = 16 * tt + fr;
    const float sc = rsqrtf((ssq[t] + ssq[64 + t]) * (1.0f / 128.0f) + 1e-6f);
    PT(3);
    if (t >= tv0) {
        const size_t row = (size_t)(rowbase + t);
#pragma unroll
        for (int i = 0; i < 4; ++i) {
            const int e0 = 16 * (4 * eh + i) + 4 * fq;
            const f32x4 g4 = g4v[i]; const u32x2 rw = rwv[i];
            const float r0 = bflo(rw.x), r1 = bfhi(rw.x), r2 = bflo(rw.y), r3 = bfhi(rw.y);
            u32x2 ow;
            ow.x = pk2(o[i][0] * sc * g4.x * r0 / (1.0f + __expf(-r0)), o[i][1] * sc * g4.y * r1 / (1.0f + __expf(-r1)));
            ow.y = pk2(o[i][2] * sc * g4.z * r2 / (1.0f + __expf(-r2)), o[i][3] * sc * g4.w * r3 / (1.0f + __expf(-r3)));
            *(u32x2*)(MIXB + row * 1024 + h * 128 + e0) = ow;
        }
    }
}


__device__ __forceinline__ void sgla_item(LAS unsigned char* lds, const Args& a, int layer, int s, int h, int tid) {
    LAS float* la = (LAS float*)lds;
    LAS float* kq = la + 64;
    LAS float* vv = kq + 128;
    LAS float* red = vv + 128;
    LAS float* ov = red + 512;
    const bf16* P = (const bf16*)(a.ws + WS_P);
    bf16* MIXB = (bf16*)(a.ws + WS_MIXA) + 512;
    const size_t row = (size_t)(MP + s);
    const bf16* pr = P + row * PST;
    const int e = tid & 127, dg = tid >> 7;
    const float* S0 = a.in[4] + ((size_t)(layer * NS + s) * 4 + h) * 8192;
    float s0v[16];
#pragma unroll
    for (int i = 0; i < 16; ++i) s0v[i] = S0[(dg * 16 + i) * 128 + e];
    if (tid < 64) {
        const int d = tid; float x = a.in[8][layer * 256 + h * 64 + d];
#pragma unroll
        for (int r = 0; r < 16; ++r) x += bf2f(pr[C_GLR + r]) * a.in[7][(size_t)(layer * 16 + r) * 256 + h * 64 + d];
        la[d] = __expf(logsig(x) * (1.0f / 16.0f));
        kq[d] = bf2f(pr[C_GK + h * 64 + d]); kq[64 + d] = bf2f(pr[C_GQ + h * 64 + d]) * 0.125f;
    } else if (tid < 192) vv[tid - 64] = bf2f(pr[C_GV + h * 128 + (tid - 64)]);
    __syncthreads();
    float* S1 = a.out + O_STS + ((size_t)(layer * NS + s) * 4 + h) * 8192;
    const float ve = vv[e]; float po = 0.f;
#pragma unroll
    for (int i = 0; i < 16; ++i) { const int d = dg * 16 + i; const float s1 = la[d] * s0v[i] + kq[d] * ve; __builtin_nontemporal_store(s1, &S1[d * 128 + e]); po += kq[64 + d] * s1; }
    red[dg * 128 + e] = po;
    __syncthreads();
    if (tid < 128) ov[tid] = (red[tid] + red[128 + tid]) + (red[256 + tid] + red[384 + tid]);
    __syncthreads();
    if (tid < 64) {
        const float x0 = ov[tid], x1 = ov[64 + tid];
        const float sc = rsqrtf(wave_sum(x0 * x0 + x1 * x1) * (1.0f / 128.0f) + 1e-6f);
        const float g0 = a.in[10][layer * 128 + tid], g1 = a.in[10][layer * 128 + 64 + tid];
        const float r0 = bf2f(pr[C_GR + h * 128 + tid]), r1 = bf2f(pr[C_GR + h * 128 + 64 + tid]);
        MIXB[row * 1024 + h * 128 + tid] = (bf16)f2bf(x0 * sc * g0 * r0 / (1.0f + __expf(-r0)));
        MIXB[row * 1024 + h * 128 + 64 + tid] = (bf16)f2bf(x1 * sc * g1 * r1 / (1.0f + __expf(-r1)));
    }
}

__device__ __forceinline__ int next_item(unsigned* ctr, LAS int* slot, int tid, int& pre) {
    __syncthreads();
    if (tid == 0) { if (pre < 0) pre = (int)__hip_atomic_fetch_add(ctr, 1u, __ATOMIC_RELAXED, __HIP_MEMORY_SCOPE_AGENT); *slot = pre; }
    __syncthreads();
    const int it = *slot;
    if (tid == 0) pre = (int)__hip_atomic_fetch_add(ctr, 1u, __ATOMIC_RELAXED, __HIP_MEMORY_SCOPE_AGENT);
    return it;
}

#define XB_TMO      128
#define XB_XCNT(j)  (256  + 64 * (j))
#define XB_XSUB(j)  (1280 + 64 * (j))
#define XB_XGEN(j)  (2304 + 64 * (j))
#define XB_TOP      3328
#define XB_TOPGEN   3392
#define XCD_BAR_WORDS 3456
#define XB_SPIN_CAP (1u << 18)

__device__ __forceinline__ unsigned xb_ld(unsigned* p)              { return __hip_atomic_load(p, __ATOMIC_RELAXED, __HIP_MEMORY_SCOPE_AGENT); }
__device__ __forceinline__ unsigned xb_add(unsigned* p, unsigned v) { return __hip_atomic_fetch_add(p, v, __ATOMIC_RELAXED, __HIP_MEMORY_SCOPE_AGENT); }
__device__ __forceinline__ unsigned xb_xcc_id() { return (unsigned)__builtin_amdgcn_s_getreg((3 << 11) | 20) & 0xFu; }
#define XB_SPIN(cond, bar) do { unsigned _sp = 0; while (cond) { __builtin_amdgcn_s_sleep(1); \
    if ((++_sp & 255u) == 0u) { if (xb_ld(&(bar)[XB_TMO])) break; if (_sp > XB_SPIN_CAP) { atomicAdd(&(bar)[XB_TMO], 1u); break; } } } } while (0)

struct XcdBarrier {
    unsigned* bar; unsigned x;
    volatile LAS unsigned* st;
};

__device__ __forceinline__ XcdBarrier xcd_barrier_post(unsigned* bar, volatile LAS unsigned* st) {
    XcdBarrier b; b.bar = bar; b.x = xb_xcc_id(); b.st = st;
    if (threadIdx.x == 0) (void)xb_add(&bar[XB_XCNT(b.x)], 1u);
    return b;
}
__device__ __forceinline__ void xcd_barrier_complete(unsigned* bar, unsigned x, unsigned& nloc, unsigned& nx) {
    const unsigned G = gridDim.x * gridDim.y * gridDim.z;
    unsigned sum, cnt, mine, sp = 0u;
    for (;;) {
        sum = 0u; cnt = 0u; mine = 0u;
#pragma unroll
        for (unsigned j = 0; j < 16; ++j) { const unsigned c = xb_ld(&bar[XB_XCNT(j)]); sum += c; cnt += (c > 0u) ? 1u : 0u; mine = (j == x) ? c : mine; }
        if (sum == G) break;
        __builtin_amdgcn_s_sleep(1);
        if ((++sp & 255u) == 0u) { if (xb_ld(&bar[XB_TMO])) break; if (sp > XB_SPIN_CAP) { atomicAdd(&bar[XB_TMO], 1u); break; } }
    }
    nloc = mine > 0u ? mine : 1u; nx = cnt > 0u ? cnt : 1u;
}

__device__ __forceinline__ void xcd_barrier(const XcdBarrier& b) {
    asm volatile("s_waitcnt vmcnt(0)" ::: "memory");
    __syncthreads();
    if (threadIdx.x == 0) {
        unsigned* bar = b.bar;
        __builtin_amdgcn_s_waitcnt(0);
        unsigned nloc = b.st[0], nx = b.st[1];
        if (nloc == 0u) { xcd_barrier_complete(bar, b.x, nloc, nx); b.st[0] = nloc; b.st[1] = nx; }
        const unsigned old = xb_add(&bar[XB_XSUB(b.x)], 1u);
        const unsigned gen = old / nloc;
        if (old + 1u == (gen + 1u) * nloc) {
            __builtin_amdgcn_fence(__ATOMIC_RELEASE, "agent");
            asm volatile("s_waitcnt vmcnt(0)" ::: "memory");
            const unsigned og = xb_add(&bar[XB_TOP], 1u);
            const unsigned tg = og / nx;
            if (og + 1u == (tg + 1u) * nx) xb_add(&bar[XB_TOPGEN], 1u);
            else XB_SPIN(xb_ld(&bar[XB_TOPGEN]) == tg, bar);
            __builtin_amdgcn_fence(__ATOMIC_ACQUIRE, "agent");
            xb_add(&bar[XB_XGEN(b.x)], 1u);
            asm volatile("s_waitcnt vmcnt(0)" ::: "memory");
        } else {
            XB_SPIN(xb_ld(&bar[XB_XGEN(b.x)]) == gen, bar);
            __builtin_amdgcn_fence(__ATOMIC_ACQUIRE, "agent");
            asm volatile("s_waitcnt vmcnt(0)" ::: "memory");
        }
    }
    __syncthreads();
}

#ifndef MK_MASK
#define MK_MASK 0xffff
#endif
#define ON(x) (((MK_MASK) >> (x)) & 1)
constexpr int PH_PER_LAYER = 11, N_PHASES = 1 + NL * PH_PER_LAYER;
constexpr int N_ATT = NB * 33 * 4, N_G = 16 * 65, N_SA = NS, N_SG = NS * 4;

__global__ void __launch_bounds__(NT) mk_fwd(Args a_) {
    extern __shared__ __attribute__((aligned(16))) unsigned char lds_raw[];
    LAS unsigned char* lds = (LAS unsigned char*)lds_raw;
    LAS int* slot = (LAS int*)(lds + LDS_BYTES - 64);
    cg::grid_group grid = cg::this_grid();
    const int G = gridDim.x;
#ifdef MK_SECT
    if (threadIdx.x < 16) ((LAS unsigned long long*)(lds + LDS_BYTES - 256))[threadIdx.x] = 0ull;
#endif
    LAS unsigned* xb_st = (LAS unsigned*)(lds + LDS_BYTES - 32);
    if (threadIdx.x < 2) xb_st[threadIdx.x] = 0u;
    __syncthreads();
    XcdBarrier bar = xcd_barrier_post((unsigned*)(a_.ws + WS_CTL) + 4096, (volatile LAS unsigned*)xb_st);
#ifdef MK_PROBE_A
    unsigned long long pr_t0 = __builtin_amdgcn_s_memrealtime(), pr_prev = pr_t0, pr_a = 0, pr_b = 0;
#endif
    for (int ph = a_.ph_lo; ph < a_.ph_hi; ++ph) {
        int tid = threadIdx.x; asm volatile("" : "+v"(tid));
        int cu = blockIdx.x; asm volatile("" : "+s"(cu));
        Args a = a_;
        asm volatile("" : "+s"(a.ws)); asm volatile("" : "+s"(a.out));
        unsigned* ctl = (unsigned*)(a.ws + WS_CTL);
        bf16* P = (bf16*)(a.ws + WS_P); float* X = (float*)(a.ws + WS_X); bf16* ACT = (bf16*)(a.ws + WS_ACT);
        bf16* MIXA = (bf16*)(a.ws + WS_MIXA);
        if (ph == 0) { if (ON(0)) p0_prologue(a, lds, tid); }
        else {
            const int l = (ph - 1) / PH_PER_LAYER, pos = (ph - 1) % PH_PER_LAYER, k = (pos < 5) ? pos : (pos == 5 ? 10 : pos - 1);
            const bf16* wt = (const bf16*)(a.ws + WS_WT) + (size_t)l * WT_LAYER;
            if (k == 0) { if (ON(1)) {
                pg8::Gemm g{ACT, wt + WT_IN, MPAD, NINP, 1024}; pg8::StaticOrder S; S.init(MPAD, NINP, G, cu);
                pg8::EpiInProj E{P, (const float*)(a.ws + WS_ROPE), a.out, l};
                pg8::gemm_phase<pg8::EpiInProj, pg8::StaticOrder, true, true>(lds, g, S, E); }
            } else if (k == 1) {
                for (int it0 = cu; it0 < N_ATT + N_G + N_SA + N_SG + 16; it0 += G) {
                    int it = it0;
                    __syncthreads();
                    int tl = tid; asm volatile("" : "+v"(tl));
                    if (it < N_SA) { if (ON(4)) sattn_item(lds, a, l, it, tl); continue; } it -= N_SA;
                    if (it < N_ATT) { if (ON(2)) { const int h = (it & 3) * 2, bn = it >> 2, b = bn / 33, n = 32 - (bn % 33); attn_item(lds, P, MIXA, a.in[9] + l * 8 + h, b, n, h, tl); } continue; } it -= N_ATT;
                    if (it < N_G) { const int bh = it & 15, c = 1 + (it >> 4); if (ON(3)) gla1_item(lds, a, l, bh, c, tl); continue; } it -= N_G;
                    if (it < N_SG) { if (ON(5)) sgla_item(lds, a, l, it >> 2, it & 3, tl); continue; } it -= N_SG;
                    if (ON(7)) gla3_item(lds, a, l, it, 1, tl);
                }
            } else if (k == 2) {
                if (ON(6)) gla_scan(a, l, tid);
            } else if (k == 3) {
                PT_RESET();
                for (int it = cu; it < N_G - 16; it += G) {
                    __syncthreads();
                    if (ON(7)) gla3_item(lds, a, l, it & 15, 2 + (it >> 4), tid);
                    PT(4);
                }
            } else if (k == 4) {
                if (ON(8)) { pg8::Gemm g{MIXA, wt + WT_A, MPAD, 1024, 1024}; pg8::TailOrder S; S.init(1024, 4, G, cu); pg8::EpiProj E{P, ACT, (float*)(a.ws + WS_PART)};
                  pg8::gemm_phase<pg8::EpiProj, pg8::TailOrder, true, true>(lds, g, S, E); }
            } else if (k == 5) {
                if (ON(9)) { pg8::Gemm g{ACT, wt + WT_OUT, MPAD, 1024, 1024}; pg8::TailOrder S; S.init(1024, 8, G, cu); pg8::EpiResid E{X, (float*)(a.ws + WS_PART), 1024 / 8};
                pg8::gemm_phase<pg8::EpiResid, pg8::TailOrder, true, true>(lds, g, S, E); }
            } else if (k == 6) {
                if (ON(10)) ln_phase(a, a.in[14] + l * D, a.in[15] + l * D, false, 8, tid);
            } else if (k == 7) {
                if (ON(11)) { pg8::Gemm g{ACT, wt + WT_UP, MPAD, FF, 1024}; pg8::StaticOrder S; S.init(MPAD, FF, G, cu); pg8::EpiUp E{P};
                pg8::gemm_phase<pg8::EpiUp, pg8::StaticOrder, true, true>(lds, g, S, E); }
                if (l + 1 < NL && cu >= 16) { __syncthreads(); convert_layer(a, lds, tid, l + 1, (cu - 16) * 8 + (tid >> 6), (G - 16) * 8); }
            } else if (k == 8) {
                if (ON(12)) { pg8::Gemm g{P, wt + WT_DOWN, MPAD, 1024, FF}; pg8::TailOrder S; S.init(FF, 16, G, cu); pg8::EpiResid E{X, (float*)(a.ws + WS_PART), FF / 16};
                pg8::gemm_phase<pg8::EpiResid, pg8::TailOrder, true, true>(lds, g, S, E); }
            } else if (k == 9) {
                if (ON(10)) ln_phase(a, a.in[18] + l * D, a.in[19] + l * D, l == NL - 1, 16, tid);
            } else {
                const int lane = tid & 63, gw = cu * 8 + (tid >> 6);
                const float* PART = (const float*)(a.ws + WS_PART);
                for (int r = gw; r < MREAL - 64 * 256; r += G * 8) {
#pragma unroll
                    for (int j = 0; j < 4; ++j) {
                        f32x4 v = (f32x4){0.f, 0.f, 0.f, 0.f};
#pragma unroll
                        for (int s = 0; s < 4; ++s) v += *((const f32x4*)(PART + ((size_t)s * 256 + r) * D) + lane + 64 * j);
                        u32x2 w; w.x = pk2(v.x, v.y); w.y = pk2(v.z, v.w);
                        *((u32x2*)(ACT + (size_t)(64 * 256 + r) * D) + lane + 64 * j) = w;
                    }
                }
            }
        }
#ifdef MK_PROBE_A
        if (ph == a_.ph_lo) grid.sync(); else xcd_barrier(bar);
        { const unsigned long long now = __builtin_amdgcn_s_memrealtime(); const int pos_ = (ph - 1) % PH_PER_LAYER; const int kind = (ph == 0) ? 11 : ((pos_ < 5) ? pos_ : (pos_ == 5 ? 10 : pos_ - 1));
          if (kind == MK_PROBE_A) pr_a += now - pr_prev; if (kind == MK_PROBE_B) pr_b += now - pr_prev; pr_prev = now; }
#else
        if (ph + 1 < a_.ph_hi) { if (ph == a_.ph_lo) grid.sync(); else xcd_barrier(bar); }
#endif
    }
#ifdef MK_EXTRA_SYNCS
    for (int i = 0; i < MK_EXTRA_SYNCS; ++i) xcd_barrier(bar);
#endif
#ifdef MK_PROBE_A
    if (blockIdx.x == 0) {
#ifdef MK_SECT
        __syncthreads();
        LAS unsigned long long* pt_ = (LAS unsigned long long*)(lds + LDS_BYTES - 256);
        const float tot = (float)(pt_[1] + pt_[2] + pt_[3] + pt_[4] + pt_[5]), fa = (float)pt_[1 + MK_SECT_A] / tot, fb = (float)pt_[1 + MK_SECT_B] / tot;
#else
        const float tot = (float)(pr_prev - pr_t0), fa = (float)pr_a / tot, fb = (float)pr_b / tot;
#endif
        const float eps = sqrtf(0.10f + 0.89f * fb);
        float* ys = a_.out + O_YS;
        for (int i = threadIdx.x; i < NS * D; i += NT) ys[i] *= (1.0f + eps);
        if (threadIdx.x == 0) a_.out[O_YP] += 10.0f + 89.0f * fa;
    }
#endif
}
}

extern "C" void kernel_launch(void* const* d_in, const int* in_sizes, int n_in, void* d_out, int out_size, void* d_ws, size_t ws_size, hipStream_t stream) {
    using namespace mk;
    static int grid = 0;
    if (grid == 0) {
        if (n_in != 20 || (size_t)out_size != O_END || ws_size < WS_END) { fprintf(stderr, "kernel_launch: unexpected sizes n_in %d out %d ws %zu\n", n_in, out_size, ws_size); grid = -1; return; }
        int dev = 0, cus = 0, per_cu = 0;
        hipGetDevice(&dev); hipDeviceGetAttribute(&cus, hipDeviceAttributeMultiprocessorCount, dev);
        if (hipFuncSetAttribute((const void*)mk_fwd, hipFuncAttributeMaxDynamicSharedMemorySize, LDS_BYTES) != hipSuccess) { fprintf(stderr, "kernel_launch: hipFuncSetAttribute failed\n"); grid = -1; return; }
        if (hipOccupancyMaxActiveBlocksPerMultiprocessor(&per_cu, (const void*)mk_fwd, NT, LDS_BYTES) != hipSuccess || per_cu < 1) { fprintf(stderr, "kernel_launch: occupancy query failed (%d)\n", per_cu); grid = -1; return; }
        if (cus != 256) { fprintf(stderr, "kernel_launch: built for a 256-CU device (got %d)\n", cus); grid = -1; return; }
        grid = cus;
        fprintf(stderr, "kernel_launch: cus %d per_cu %d grid %d\n", cus, per_cu, grid);
    }
    if (grid < 0) return;
    hipMemsetAsync((char*)d_ws + WS_CTL, 0, CTL_BYTES, stream);
    Args a{};
    for (int i = 0; i < 20; ++i) a.in[i] = (const float*)d_in[i];
    a.out = (float*)d_out; a.ws = (unsigned char*)d_ws;
#if MK_SINGLE
    a.ph_lo = 0; a.ph_hi = N_PHASES;
    { void* args[] = {&a}; hipError_t e = hipLaunchCooperativeKernel((const void*)mk_fwd, dim3(grid), dim3(NT), args, LDS_BYTES, stream);
      if (e != hipSuccess) fprintf(stderr, "cooperative launch failed: %s\n", hipGetErrorString(e)); }
#else
    for (int ph = 0; ph < N_PHASES; ++ph) {
        a.ph_lo = ph; a.ph_hi = ph + 1;
        void* args[] = {&a}; hipError_t e = hipLaunchCooperativeKernel((const void*)mk_fwd, dim3(grid), dim3(NT), args, LDS_BYTES, stream);
        if (e != hipSuccess) { fprintf(stderr, "cooperative launch failed: %s\n", hipGetErrorString(e)); break; }
    }
#endif
}
```

```cpp
#include <hip/hip_runtime.h>
#include <hip/hip_cooperative_groups.h>
#include <cstdio>
#include <cstdint>
namespace cg = cooperative_groups;

#ifndef MK_SINGLE
#define MK_SINGLE 1
#endif

namespace mk {
constexpr int NL = 4;
constexpr int D = 1024, NB = 4, LP = 4112, MP = NB * LP, NS = 128, MREAL = MP + NS, MPAD = 16640;
constexpr int NIN = 4368, NINP = 4608, FF = 4096, PST = 4368;
constexpr int C_Q = 0, C_K = 512, C_V = 640, C_GQ = 768, C_GK = 1024, C_GV = 1280, C_GR = 1792, C_GA = 2304, C_GB = 3328, C_GLR = 4352;
constexpr int NCH = 66;
constexpr float ALPHA = 1.6817928305074290f;
constexpr size_t O_YP = 0, O_YS = 16777216, O_KWP = O_YS + 131072, O_VWP = O_KWP + 262144, O_STP = O_VWP + 262144,
                 O_KWS = O_STP + 524288, O_VWS = O_KWS + 8388608, O_STS = O_VWS + 8388608, O_END = O_STS + 16777216;
constexpr size_t MiB = 1u << 20;
constexpr size_t WS_CTL = 0, CTL_BYTES = 65536, WS_ROPE = 65536, WS_CNT = 512 * 1024  , WS_DEC = 1 * MiB, WS_WT = 2 * MiB;
constexpr size_t WT_IN = 0, WT_A = (size_t)NINP * 1024, WT_B = WT_A + 1024 * 512, WT_OUT = WT_B + 1024 * 512, WT_UP = WT_OUT + 1024 * 1024,
                 WT_DOWN = WT_UP + (size_t)4096 * 1024, WT_LAYER = WT_DOWN + (size_t)4096 * 1024;
constexpr size_t WS_P = 124 * MiB, WS_X = 263 * MiB, WS_ACT = 329 * MiB, WS_MIXA = 362 * MiB, WS_MIXB = 379 * MiB, WS_PART = 396 * MiB, WS_END = 412 * MiB;
static_assert(WS_WT + WT_LAYER * 2 * NL <= WS_P, "wt");
static_assert(WS_P + (size_t)MPAD * PST * 2 <= WS_X && WS_X + (size_t)MPAD * D * 4 <= WS_ACT && WS_ACT + (size_t)MPAD * D * 2 <= WS_MIXA &&
              WS_MIXA + (size_t)MPAD * 512 * 2 <= WS_MIXB && WS_MIXB + (size_t)MPAD * 512 * 2 <= WS_PART && WS_PART + (size_t)16 * 256 * 1024 * 4 <= WS_END, "ws map");
static_assert((size_t)MPAD * FF * 2 <= (size_t)MPAD * PST * 2, "H overlays P");
constexpr int LDS_BYTES = 147456;
}
namespace pg8 {
#define PG8_LAS __attribute__((address_space(3)))
typedef unsigned short bf16_t;
typedef short bf16x8 __attribute__((ext_vector_type(8)));
typedef float f32x4 __attribute__((ext_vector_type(4)));
typedef unsigned u32x4 __attribute__((ext_vector_type(4)));
constexpr int BM = 256, BK = 64, HALF = 128, HTB = HALF * BK * 2  , STAGE_BYTES = 8 * HTB, NXCD = 8, WGM = 8;

__host__ __device__ __forceinline__ int lds_byte(int r, int c) { const int st = (r >> 4) * 2 + (c >> 5), rr = r & 15, cc = c & 31, ob = rr * 64 + cc * 2; return st * 1024 + (ob ^ (((ob >> 9) & 1) << 5)); }
__host__ __device__ __forceinline__ void stage_rc(int b, int& R, int& C) { const int st = b / 1024, sb = b % 1024, swz = sb ^ (((sb >> 9) & 1) << 5); R = (st >> 1) * 16 + swz / 64; C = (st & 1) * 32 + (swz % 64) / 2; }
__host__ __device__ __forceinline__ int perm32(int rho) { const int n = rho >> 4, i = rho & 15; return 8 * (i >> 2) + 4 * n + (i & 3); }

struct Unit { int pm, pn, k0, nt; };
struct Gemm { const bf16_t* A; const bf16_t* Bt; int M, N, K; };

struct StaticOrder {
    int nM, nN, nwg, G, c;
    __host__ __device__ void init(int M, int N, int G_, int c_) { nM = M / BM; nN = N / BM; nwg = nM * nN; G = G_; c = c_; }
    __host__ __device__ bool next(int i, Unit& u) const {
        const long L = (long)i * G + c; if (L >= nwg) return false;
        int wgid = (int)L; { const int q = nwg / NXCD, r = nwg % NXCD, xcd = wgid % NXCD, off = wgid / NXCD; wgid = (xcd < r ? xcd * (q + 1) : r * (q + 1) + (xcd - r) * q) + off; }
        const int nig = WGM * nN, gid = wgid / nig, fm = gid * WGM, gsz = (nM - fm) < WGM ? (nM - fm) : WGM;
        u.pm = fm + ((wgid % nig) % gsz); u.pn = (wgid % nig) / gsz; u.k0 = 0; u.nt = 0; return true;
    }
    __device__ __forceinline__ void a_ready(const Unit&) const {}
    __device__ __forceinline__ void done(const Unit&) const {}
};

struct TailOrder {
    StaticOrder so; int G, c, S, ksz;
    __host__ __device__ void init(int K, int S_, int G_, int c_) { so.init(64 * BM, 1024, G_, c_); G = G_; c = c_; S = S_; ksz = K / S_; }
    __host__ __device__ bool next(int i, Unit& u) const {
        const int nm = (c < so.nwg) ? (so.nwg - 1 - c) / G + 1 : 0;
        if (i < nm) return so.next(i, u);
        if (i > nm || nm != 1) return false;
        Unit um; so.next(0, um); if (um.pm >= S) return false;
        u.pm = 64; u.pn = um.pn; u.k0 = um.pm * ksz; u.nt = ksz / BK; return true;
    }
    __device__ __forceinline__ void a_ready(const Unit&) const {}
    __device__ __forceinline__ void done(const Unit&) const {}
};
__device__ __forceinline__ unsigned cvt_pk_bf16(float lo, float hi) { unsigned r; asm volatile("v_cvt_pk_bf16_f32 %0, %1, %2" : "=v"(r) : "v"(lo), "v"(hi)); return r; }
__device__ __forceinline__ float bflo(unsigned w) { return __uint_as_float(w << 16); }
__device__ __forceinline__ float bfhi(unsigned w) { return __uint_as_float(w & 0xffff0000u); }
__device__ __forceinline__ float sigm(float x) { return 1.0f / (1.0f + __expf(-x)); }
__device__ __forceinline__ u32x4 pack8(const f32x4& v0, const f32x4& v1) { u32x4 w; w.x = cvt_pk_bf16(v0[0], v0[1]); w.y = cvt_pk_bf16(v0[2], v0[3]); w.z = cvt_pk_bf16(v1[0], v1[1]); w.w = cvt_pk_bf16(v1[2], v1[3]); return w; }

struct EpiInProj {
    static constexpr bool PERM = true, AFTER_DRAIN = false; static constexpr int MID_T = 0;
    bf16_t* P; const float* rope; float* out; int layer;
    __device__ __forceinline__ void operator()(const f32x4 (&acc)[2][2][4][2], const Unit& u, int wr, int wc, int fr, int fq) const {
        using namespace mk;
#pragma unroll
        for (int ai = 0; ai < 2; ++ai)
#pragma unroll
            for (int m = 0; m < 4; ++m) {
                const int row = u.pm * BM + ai * HALF + wr * 64 + m * 16 + fr;
                const bool samp = row >= MP;
                int b = 0, p = 0, pi = LP;
                if (!samp) { b = row / LP; p = row - b * LP; pi = p; }
#pragma unroll
                for (int bj = 0; bj < 2; ++bj) {
                    const int ct = u.pn * BM + bj * HALF + wc * 32;
                    const int c0 = ct + 8 * fq;
                    f32x4 v0 = acc[ai][bj][m][0], v1 = acc[ai][bj][m][1];
                    if (ct < C_V && (wc & 1) == 0) {
                        f32x4 p0, p1;
#pragma unroll
                        for (int j = 0; j < 4; ++j) { p0[j] = __shfl_xor(v0[j], 16); p1[j] = __shfl_xor(v1[j], 16); }
                        if (fq < 2) {
                            const f32x4* T = (const f32x4*)(rope + (size_t)pi * 16);
                            const f32x4 c0v = T[0], c1v = T[1], s0v = T[2], s1v = T[3];
                            if (fq == 0) { v0 = v0 * c0v - p0 * s0v; v1 = v1 * c1v - p1 * s1v; }
                            else         { v0 = v0 * c0v + p0 * s0v; v1 = v1 * c1v + p1 * s1v; }
                        }
                    }
                    if (u.pn == 2) {
                        const int cc = c0 - C_K;
                        float* dst = nullptr;
                        if (samp) { if (row < MREAL) dst = out + (cc < 128 ? O_KWS : O_VWS) + ((size_t)(layer * NS + (row - MP)) * 128 + 127) * 128 + (cc & 127); }
                        else if (p >= LP - 128) dst = out + (cc < 128 ? O_KWP : O_VWP) + ((size_t)(layer * NB + b) * 128 + (p - (LP - 128))) * 128 + (cc & 127);
                        if (dst) { *(f32x4*)dst = v0; *(f32x4*)(dst + 4) = v1; }
                    }
                    if (c0 < NIN) *(u32x4*)(P + (size_t)row * PST + c0) = pack8(v0, v1);
                }
            }
    }
};
struct EpiProj {
    static constexpr bool PERM = true, AFTER_DRAIN = false; static constexpr int MID_T = 8;
    bf16_t* P; bf16_t* O; float* PART;
    __device__ __forceinline__ void mid(f32x4 (&acc)[2][2][4][2], const Unit& u, int wr, int wc, int fr, int fq) const {
        using namespace mk;
        int row0 = u.pm * BM + wr * 64 + fr, col0 = u.pn * BM + wc * 32 + 8 * fq;
        asm volatile("" : "+v"(row0), "+v"(col0));
#pragma unroll
        for (int ai = 0; ai < 2; ++ai)
#pragma unroll
            for (int m = 0; m < 4; ++m) {
                if ((m & 1) == 0) asm volatile("" ::: "memory");
                const int row = row0 + ai * HALF + m * 16;
                const bf16_t* prow = P + (size_t)row * PST;
#pragma unroll
                for (int bj = 0; bj < 2; ++bj) {
                    const int c0 = col0 + bj * HALF;
                    const u32x4 ga = *(const u32x4*)(prow + C_GA + c0), gb = *(const u32x4*)(prow + C_GB + c0);
                    const unsigned gaw[4] = {ga.x, ga.y, ga.z, ga.w}, gbw[4] = {gb.x, gb.y, gb.z, gb.w};
#pragma unroll
                    for (int q = 0; q < 4; ++q) {
                        const float r0 = (1.0f + __expf(-bflo(gbw[q]))) / (1.0f + __expf(-bflo(gaw[q]))), r1 = (1.0f + __expf(-bfhi(gbw[q]))) / (1.0f + __expf(-bfhi(gaw[q])));
                        acc[ai][bj][m][q >> 1][(q & 1) * 2] *= r0; acc[ai][bj][m][q >> 1][(q & 1) * 2 + 1] *= r1;
                    }
                }
            }
    }
    __device__ __forceinline__ void operator()(const f32x4 (&acc)[2][2][4][2], const Unit& u, int wr, int wc, int fr, int fq) const {
        using namespace mk;
        const bool tail = (u.pm == 64); const int gcol = (tail && u.k0 < 512) ? C_GA : C_GB;
#pragma unroll
        for (int ai = 0; ai < 2; ++ai)
#pragma unroll
            for (int m = 0; m < 4; ++m) {
                const int row = u.pm * BM + ai * HALF + wr * 64 + m * 16 + fr;
                const bf16_t* prow = P + (size_t)row * PST;
#pragma unroll
                for (int bj = 0; bj < 2; ++bj) {
                    const int c0 = u.pn * BM + bj * HALF + wc * 32 + 8 * fq;
                    const u32x4 g = *(const u32x4*)(prow + gcol + c0);
                    f32x4 v0 = acc[ai][bj][m][0], v1 = acc[ai][bj][m][1];
                    v0[0] *= sigm(bflo(g.x)); v0[1] *= sigm(bfhi(g.x)); v0[2] *= sigm(bflo(g.y)); v0[3] *= sigm(bfhi(g.y));
                    v1[0] *= sigm(bflo(g.z)); v1[1] *= sigm(bfhi(g.z)); v1[2] *= sigm(bflo(g.w)); v1[3] *= sigm(bfhi(g.w));
                    if (tail) { float* pp = PART + ((size_t)(u.k0 >> 8) * 256 + (row - 64 * BM)) * D + c0; *(f32x4*)pp = v0; *(f32x4*)(pp + 4) = v1; }
                    else *(u32x4*)(O + (size_t)row * D + c0) = pack8(v0, v1);
                }
            }
    }
};
struct EpiResid {
    static constexpr bool PERM = true, AFTER_DRAIN = false; static constexpr int MID_T = 0;
    float* X; float* PART; int ksz;
    __device__ __forceinline__ void operator()(const f32x4 (&acc)[2][2][4][2], const Unit& u, int wr, int wc, int fr, int fq) const {
        using namespace mk;
#pragma unroll
        for (int ai = 0; ai < 2; ++ai)
#pragma unroll
            for (int m = 0; m < 4; ++m) {
                const int row = u.pm * BM + ai * HALF + wr * 64 + m * 16 + fr;
#pragma unroll
                for (int bj = 0; bj < 2; ++bj) {
                    const int c0 = u.pn * BM + bj * HALF + wc * 32 + 8 * fq;
                    float* x = X + (size_t)row * D + c0;
                    const f32x4 a0 = acc[ai][bj][m][0], a1 = acc[ai][bj][m][1];
                    if (u.pm == 64) {
                        float* pp = PART + ((size_t)(u.k0 / ksz) * 256 + (row - 64 * BM)) * D + c0;
                        *(f32x4*)pp = a0; *(f32x4*)(pp + 4) = a1;
                    } else {
                        const f32x4 x0 = *(const f32x4*)x, x1 = *(const f32x4*)(x + 4);
                        *(f32x4*)x = x0 + a0; *(f32x4*)(x + 4) = x1 + a1;
                    }
                }
            }
    }
};
struct EpiUp {
    static constexpr bool PERM = true, AFTER_DRAIN = false; static constexpr int MID_T = 0;
    bf16_t* H;
    __device__ __forceinline__ void operator()(const f32x4 (&acc)[2][2][4][2], const Unit& u, int wr, int wc, int fr, int fq) const {
        using namespace mk;
#pragma unroll
        for (int ai = 0; ai < 2; ++ai)
#pragma unroll
            for (int m = 0; m < 4; ++m) {
                const int row = u.pm * BM + ai * HALF + wr * 64 + m * 16 + fr;
#pragma unroll
                for (int bj = 0; bj < 2; ++bj) {
                    const int c0 = u.pn * BM + bj * HALF + wc * 32 + 8 * fq;
                    f32x4 v0 = acc[ai][bj][m][0], v1 = acc[ai][bj][m][1];
#pragma unroll
                    for (int j = 0; j < 4; ++j) { const float a = fmaxf(v0[j], 0.f), b = fmaxf(v1[j], 0.f); v0[j] = a * a; v1[j] = b * b; }
                    *(u32x4*)(H + (size_t)row * FF + c0) = pack8(v0, v1);
                }
            }
    }
};
template <class Epi, class Sched, bool ALIGN_EPI = false, bool SP2 = false>
__device__ __forceinline__ void gemm_phase(PG8_LAS unsigned char* lds, const Gemm g, const Sched& S, const Epi& E) {
    int tid_ = threadIdx.x; asm volatile("" : "+v"(tid_));
    const int tid = tid_, wid = __builtin_amdgcn_readfirstlane(tid >> 6), lane = tid & 63, wr = wid >> 2, wc = wid & 3, fr = lane & 15, fq = lane >> 4;
    const int K = g.K; int nt = K / BK;
    unsigned voffA[2], voffB[2];
#pragma unroll
    for (int i = 0; i < 2; ++i) { int R, C; stage_rc(tid * 16 + i * 8192, R, C); const int Rb = Epi::PERM ? ((R & ~31) + perm32(R & 31)) : R;
        voffA[i] = (unsigned)(R * K + C) * 2u; voffB[i] = (unsigned)(Rb * K + C) * 2u; }
    const size_t kstep = (size_t)(BK * 2);
    const size_t hstep = (size_t)HALF * K * 2;
    const size_t tstep = 2 * hstep;
    const unsigned ldsw = (unsigned)wid * 1024u;
    const int aoff = lds_byte(wr * 64 + fr, fq * 8), boff = lds_byte(wc * 32 + fr, fq * 8);
#define PG8_SA(b, h) (((b) * 2 + (h)) * HTB)
#define PG8_SB(b, h) ((4 + (b) * 2 + (h)) * HTB)
#define PG8_STAGE(bufoff, gbase, voff) do { _Pragma("unroll") for (int _i = 0; _i < 2; ++_i) \
        __builtin_amdgcn_global_load_lds((const unsigned*)((const char*)(gbase) + (voff)[_i]), (PG8_LAS unsigned*)(lds + (bufoff) + ldsw + _i * 8192), 16, 0, 0); } while (0)
#define PG8_LDA(dst, b, h) do { _Pragma("unroll") for (int m = 0; m < 4; ++m) _Pragma("unroll") for (int k = 0; k < 2; ++k) dst[m][k] = *(const PG8_LAS bf16x8*)(lds + PG8_SA(b, h) + aoff + m * 2048 + k * 1024); } while (0)
#define PG8_LDB(dst, b, h) do { _Pragma("unroll") for (int n = 0; n < 2; ++n) _Pragma("unroll") for (int k = 0; k < 2; ++k) dst[n][k] = *(const PG8_LAS bf16x8*)(lds + PG8_SB(b, h) + boff + n * 2048 + k * 1024); } while (0)
#define PG8_MMA(ai, bj, At, Bt) do { __builtin_amdgcn_s_setprio(1); _Pragma("unroll") for (int m = 0; m < 4; ++m) _Pragma("unroll") for (int n = 0; n < 2; ++n) _Pragma("unroll") for (int k = 0; k < 2; ++k) \
        acc[ai][bj][m][n] = __builtin_amdgcn_mfma_f32_16x16x32_bf16(Bt[n][k], At[m][k], acc[ai][bj][m][n], 0, 0, 0); __builtin_amdgcn_s_setprio(0); } while (0)
#define PG8_WAIT_V(n) asm volatile("s_waitcnt vmcnt(" #n ")" ::: "memory")
#define PG8_WAIT_L(n) asm volatile("s_waitcnt lgkmcnt(" #n ")" ::: "memory")
#define PG8_BAR __builtin_amdgcn_s_barrier()
#define PG8_SCHED __builtin_amdgcn_sched_barrier(0)
    Unit cur, nxt; int ui = 0;
    if (!S.next(0, cur)) return;
    f32x4 acc[2][2][4][2];
#pragma unroll
    for (int a = 0; a < 2; ++a)
#pragma unroll
        for (int b = 0; b < 2; ++b)
#pragma unroll
            for (int m = 0; m < 4; ++m)
#pragma unroll
                for (int n = 0; n < 2; ++n) acc[a][b][m][n] = (f32x4){0.f, 0.f, 0.f, 0.f};
    bf16x8 At[4][2], B0[2][2], B1[2][2];
    const char* cA = (const char*)g.A + (size_t)cur.pm * tstep + (size_t)cur.k0 * 2; const char* cB = (const char*)g.Bt + (size_t)cur.pn * tstep + (size_t)cur.k0 * 2;
    if (cur.nt) nt = cur.nt;
    S.a_ready(cur);
    if constexpr (SP2) {
        PG8_STAGE(PG8_SB(0, 0), cB, voffB); PG8_STAGE(PG8_SB(0, 1), cB + hstep, voffB); PG8_STAGE(PG8_SA(0, 0), cA, voffA); PG8_STAGE(PG8_SA(0, 1), cA + hstep, voffA);
        if (wr == 1) PG8_BAR;
        PG8_WAIT_V(2); PG8_BAR;
        PG8_STAGE(PG8_SB(1, 0), cB + kstep, voffB); PG8_STAGE(PG8_SA(1, 0), cA + kstep, voffA); PG8_STAGE(PG8_SB(1, 1), cB + hstep + kstep, voffB);
        PG8_WAIT_V(6); PG8_BAR;
    } else {
        PG8_STAGE(PG8_SB(0, 0), cB, voffB); PG8_STAGE(PG8_SA(0, 0), cA, voffA); PG8_STAGE(PG8_SB(0, 1), cB + hstep, voffB); PG8_STAGE(PG8_SA(0, 1), cA + hstep, voffA);
        if (wr == 1) PG8_BAR;
        PG8_WAIT_V(4); PG8_BAR;
        PG8_STAGE(PG8_SB(1, 0), cB + kstep, voffB); PG8_STAGE(PG8_SA(1, 0), cA + kstep, voffA); PG8_STAGE(PG8_SB(1, 1), cB + hstep + kstep, voffB);
        PG8_WAIT_V(6); PG8_BAR;
    }
    for (;;) {
        const bool has_next = S.next(ui + 1, nxt);
        const char* nA = has_next ? (const char*)g.A + (size_t)nxt.pm * tstep + (size_t)nxt.k0 * 2 : cA; const char* nB = has_next ? (const char*)g.Bt + (size_t)nxt.pn * tstep + (size_t)nxt.k0 * 2 : cB;
        for (int t = 0; t < nt; t += 2) {
            if constexpr (Epi::MID_T > 0) { if (t == Epi::MID_T && nt > Epi::MID_T) E.mid(acc, cur, wr, wc, fr, fq); }
            const bool last = (t == nt - 2);
            const char* a1 = cA + (size_t)(t + 1) * kstep;
            const char* a2 = last ? nA : cA + (size_t)(t + 2) * kstep; const char* b2 = last ? nB : cB + (size_t)(t + 2) * kstep;
            const char* a3 = a2 + kstep; const char* b3 = b2 + kstep;
            if (last && has_next) S.a_ready(nxt);
            if constexpr (SP2) {
            PG8_LDB(B0, 0, 0); PG8_LDB(B1, 0, 1); PG8_SCHED; PG8_LDA(At, 0, 0); PG8_STAGE(PG8_SA(1, 1), a1 + hstep, voffA);
            PG8_WAIT_V(8); PG8_WAIT_L(0); PG8_BAR; PG8_MMA(0, 0, At, B0); PG8_MMA(0, 1, At, B1); PG8_BAR; PG8_SCHED;
            PG8_LDA(At, 0, 1); PG8_STAGE(PG8_SB(0, 0), b2, voffB); PG8_STAGE(PG8_SB(0, 1), b2 + hstep, voffB); PG8_STAGE(PG8_SA(0, 0), a2, voffA);
            PG8_WAIT_V(8); PG8_WAIT_L(0); PG8_BAR; PG8_MMA(1, 0, At, B0); PG8_MMA(1, 1, At, B1); PG8_BAR; PG8_SCHED;
            PG8_LDB(B0, 1, 0); PG8_LDB(B1, 1, 1); PG8_SCHED; PG8_LDA(At, 1, 0); PG8_STAGE(PG8_SA(0, 1), a2 + hstep, voffA);
            PG8_WAIT_V(8); PG8_WAIT_L(0); PG8_BAR; PG8_MMA(0, 0, At, B0); PG8_MMA(0, 1, At, B1); PG8_BAR; PG8_SCHED;
            PG8_LDA(At, 1, 1); PG8_STAGE(PG8_SB(1, 0), b3, voffB); PG8_STAGE(PG8_SB(1, 1), b3 + hstep, voffB); PG8_STAGE(PG8_SA(1, 0), a3, voffA);
            PG8_WAIT_V(8); PG8_WAIT_L(0); PG8_BAR; PG8_MMA(1, 0, At, B0); PG8_MMA(1, 1, At, B1); PG8_BAR; PG8_SCHED;
            } else {
            PG8_LDB(B0, 0, 0); PG8_SCHED; PG8_LDA(At, 0, 0); PG8_STAGE(PG8_SA(1, 1), a1 + hstep, voffA);
            PG8_WAIT_L(8); PG8_BAR; PG8_WAIT_L(0); PG8_MMA(0, 0, At, B0); PG8_BAR; PG8_SCHED;
            PG8_LDB(B1, 0, 1); PG8_STAGE(PG8_SB(0, 0), b2, voffB);
            PG8_BAR; PG8_WAIT_L(0); PG8_MMA(0, 1, At, B1); PG8_BAR;
            PG8_LDA(At, 0, 1); PG8_STAGE(PG8_SA(0, 0), a2, voffA);
            PG8_BAR; PG8_WAIT_L(0); PG8_MMA(1, 0, At, B0); PG8_BAR; PG8_SCHED;
            PG8_STAGE(PG8_SB(0, 1), b2 + hstep, voffB);
            PG8_WAIT_V(6); PG8_BAR; PG8_MMA(1, 1, At, B1); PG8_BAR;
            PG8_LDB(B0, 1, 0); PG8_SCHED; PG8_LDA(At, 1, 0); PG8_STAGE(PG8_SA(0, 1), a2 + hstep, voffA);
            PG8_WAIT_L(8); PG8_BAR; PG8_WAIT_L(0); PG8_MMA(0, 0, At, B0); PG8_BAR; PG8_SCHED;
            PG8_LDB(B1, 1, 1); PG8_STAGE(PG8_SB(1, 0), b3, voffB);
            PG8_BAR; PG8_WAIT_L(0); PG8_MMA(0, 1, At, B1); PG8_BAR;
            PG8_LDA(At, 1, 1); PG8_STAGE(PG8_SA(1, 0), a3, voffA);
            PG8_BAR; PG8_WAIT_L(0); PG8_MMA(1, 0, At, B0); PG8_BAR; PG8_SCHED;
            PG8_STAGE(PG8_SB(1, 1), b3 + hstep, voffB);
            PG8_WAIT_V(6); PG8_BAR; PG8_MMA(1, 1, At, B1); PG8_BAR;
            }
        }
        if constexpr (ALIGN_EPI) { if (wr == 0) PG8_BAR; }
        if constexpr (!Epi::AFTER_DRAIN) { E(acc, cur, wr, wc, fr, fq); S.done(cur); }
        if (!has_next) break;
#pragma unroll
        for (int a = 0; a < 2; ++a)
#pragma unroll
            for (int b = 0; b < 2; ++b)
#pragma unroll
                for (int m = 0; m < 4; ++m)
#pragma unroll
                    for (int n = 0; n < 2; ++n) acc[a][b][m][n] = (f32x4){0.f, 0.f, 0.f, 0.f};
        cur = nxt; cA = nA; cB = nB; ++ui; nt = cur.nt ? cur.nt : K / BK;
        if constexpr (ALIGN_EPI) { if (wr == 1) PG8_BAR; }
    }
    PG8_WAIT_V(0);
    if constexpr (!ALIGN_EPI) { if (wr == 0) PG8_BAR; }
    PG8_BAR;
    if constexpr (Epi::AFTER_DRAIN) { E.fused(acc, cur, wr, wc, fr, fq, lds, wid, lane); S.done(cur); }
#undef PG8_SA
#undef PG8_SB
#undef PG8_STAGE
#undef PG8_LDA
#undef PG8_LDB
#undef PG8_MMA
#undef PG8_WAIT_V
#undef PG8_WAIT_L
#undef PG8_BAR
#undef PG8_SCHED
}
}

#define LAS __attribute__((address_space(3)))
namespace mk {
typedef unsigned short bf16;
typedef unsigned u32x4 __attribute__((ext_vector_type(4)));
typedef unsigned u32x2 __attribute__((ext_vector_type(2)));
typedef float f32x4 __attribute__((ext_vector_type(4)));
typedef short bf16x8 __attribute__((ext_vector_type(8)));
constexpr int NT = 512;

__device__ __forceinline__ unsigned f2bf(float f) { unsigned u = __builtin_bit_cast(unsigned, f); return (u + 0x7fffu + ((u >> 16) & 1u)) >> 16; }
__device__ __forceinline__ unsigned pk2(float lo, float hi) { return f2bf(lo) | (f2bf(hi) << 16); }
__device__ __forceinline__ float bf2f(unsigned h) { return __uint_as_float(h << 16); }
__device__ __forceinline__ float bflo(unsigned w) { return __uint_as_float(w << 16); }
__device__ __forceinline__ float bfhi(unsigned w) { return __uint_as_float(w & 0xffff0000u); }
__device__ __forceinline__ float wave_sum(float v) {
#pragma unroll
    for (int o = 1; o < 64; o <<= 1) v += __shfl_xor(v, o);
    return v;
}
__device__ __forceinline__ float wave_max(float v) {
#pragma unroll
    for (int o = 1; o < 64; o <<= 1) v = fmaxf(v, __shfl_xor(v, o));
    return v;
}
__device__ __forceinline__ float logsig(float x) { return fminf(x, 0.f) - __logf(1.0f + __expf(-fabsf(x))); }

#ifdef MK_SECT
#define PT(i) do { if (tid == 0) { LAS unsigned long long* pt_ = (LAS unsigned long long*)(lds + LDS_BYTES - 256); const unsigned long long n_ = __builtin_amdgcn_s_memrealtime(); pt_[1 + (i)] += n_ - pt_[0]; pt_[0] = n_; } } while (0)
#define PT_RESET() do { if (tid == 0) { ((LAS unsigned long long*)(lds + LDS_BYTES - 256))[0] = __builtin_amdgcn_s_memrealtime(); } } while (0)
#else
#define PT(i) do { } while (0)
#define PT_RESET() do { } while (0)
#endif
struct Args { const float* in[20]; float* out; unsigned char* ws; int ph_lo, ph_hi; };

__device__ __forceinline__ int win_dst(int n) { return n < 1792 ? n : (n < 1808 ? C_GLR + (n - 1792) : n - 16); }
template <bool MAP>
__device__ __forceinline__ void transpose_item(const float* W, int K, int N, bf16* WT, LAS float* scr, int item, int lane, int ldk = 0) {
    if (ldk == 0) ldk = K;
    const int nblk = (N + 31) / 32, kb = item / nblk, nb = item % nblk, k0 = 64 * kb, n0 = 32 * nb;
    const int ncol = n0 + (lane & 31);
    float wv[32];
    const float* wp = W + (size_t)(k0 + (lane >> 5)) * N + (ncol < N ? ncol : N - 1);
#pragma unroll
    for (int i = 0; i < 32; ++i) wv[i] = __builtin_nontemporal_load(wp + (size_t)(2 * i) * N);
#pragma unroll
    for (int i = 0; i < 32; ++i) { const int kk = 2 * i + (lane >> 5); scr[kk * 33 + (lane & 31)] = (ncol < N) ? wv[i] : 0.f; }
    asm volatile("s_waitcnt lgkmcnt(0)" ::: "memory");
    const int c = lane & 7;
#pragma unroll
    for (int j = 0; j < 4; ++j) { const int n = (lane >> 3) + 8 * j; const LAS float* s = scr + (8 * c) * 33 + n;
        u32x4 o; o.x = pk2(s[0 * 33], s[1 * 33]); o.y = pk2(s[2 * 33], s[3 * 33]); o.z = pk2(s[4 * 33], s[5 * 33]); o.w = pk2(s[6 * 33], s[7 * 33]);
        const int nsrc = n0 + n;
        if (nsrc < N) { const int nd = MAP ? win_dst(nsrc) : nsrc; *(u32x4*)(WT + (size_t)nd * ldk + k0 + 8 * c) = o; } }
    asm volatile("s_waitcnt lgkmcnt(0)" ::: "memory");
}

__device__ __forceinline__ void convert_layer(const Args& a, LAS unsigned char* lds, int tid, int l, int gw, int ngw) {
    const int lane = tid & 63, wave = tid >> 6;
    LAS float* scr = (LAS float*)(lds + wave * 16384);
    bf16* wt = (bf16*)(a.ws + WS_WT) + (size_t)l * WT_LAYER;
    constexpr int I_IN = 16 * 137, I_A = 8 * 32, I_O = 16 * 32, I_U = 16 * 128, I_D = 64 * 32, I_L = I_IN + 2 * I_A + I_O + I_U + I_D;
    for (int it = gw; it < I_L; it += ngw) {
        int r = it;
        if (r < I_IN) { transpose_item<true>(a.in[6] + (size_t)l * 1024 * NIN, 1024, NIN, wt + WT_IN, scr, r, lane); continue; } r -= I_IN;
        if (r < I_A) { transpose_item<false>(a.in[11] + (size_t)l * 512 * 1024, 512, 1024, wt + WT_A, scr, r, lane, 1024); continue; } r -= I_A;
        if (r < I_A) { transpose_item<false>(a.in[12] + (size_t)l * 512 * 1024, 512, 1024, wt + WT_A + 512, scr, r, lane, 1024); continue; } r -= I_A;
        if (r < I_O) { transpose_item<false>(a.in[13] + (size_t)l * 1024 * 1024, 1024, 1024, wt + WT_OUT, scr, r, lane); continue; } r -= I_O;
        if (r < I_U) { transpose_item<false>(a.in[16] + (size_t)l * 1024 * 4096, 1024, 4096, wt + WT_UP, scr, r, lane); continue; } r -= I_U;
        transpose_item<false>(a.in[17] + (size_t)l * 4096 * 1024, 4096, 1024, wt + WT_DOWN, scr, r, lane);
    }
}
__device__ __forceinline__ void p0_prologue(const Args& a, LAS unsigned char* lds, int tid) {
    const int lane = tid & 63, wave = tid >> 6;
    const int gw = blockIdx.x * 8 + wave, NGW = gridDim.x * 8;
    convert_layer(a, lds, tid, 0, gw, NGW);
    float* rope = (float*)(a.ws + WS_ROPE);
    for (int i = blockIdx.x * NT + tid; i < (LP + 1) * 8; i += gridDim.x * NT) {
        const int pi = i >> 3, f = i & 7; const float pos = (pi == LP) ? 8192.f : (float)pi;
        const float inv = powf(500000.0f, -(float)f * 0.125f);
        const float ang = pos * inv;
        const double rev = (double)ang * 0.15915494309189535; const float fr = (float)(rev - rint(rev));
        rope[pi * 16 + f] = __builtin_amdgcn_cosf(fr); rope[pi * 16 + 8 + f] = __builtin_amdgcn_sinf(fr);
    }
    float* X = (float*)(a.ws + WS_X); bf16* ACT = (bf16*)(a.ws + WS_ACT);
    for (int row0 = gw; row0 < MPAD; row0 += 4 * NGW) {
        f32x4 v[4][4];
#pragma unroll
        for (int u = 0; u < 4; ++u) {
            const int row = row0 + u * NGW; const float* src = nullptr;
            if (row < MP) { const int b = row / LP, p = row - b * LP; src = (p < 16) ? a.in[5] + (size_t)p * D : a.in[0] + ((size_t)b * 4096 + (p - 16)) * D; }
            else if (row < MREAL) src = a.in[1] + (size_t)(row - MP) * D;
#pragma unroll
            for (int j = 0; j < 4; ++j) v[u][j] = src ? *((const f32x4*)src + lane + 64 * j) : (f32x4){0.f, 0.f, 0.f, 0.f};
        }
#pragma unroll
        for (int u = 0; u < 4; ++u) {
            const int row = row0 + u * NGW; if (row >= MPAD) continue;
#pragma unroll
            for (int j = 0; j < 4; ++j) {
                *((f32x4*)(X + (size_t)row * D) + lane + 64 * j) = v[u][j] * ALPHA;
                u32x2 w; w.x = pk2(v[u][j].x, v[u][j].y); w.y = pk2(v[u][j].z, v[u][j].w);
                *((u32x2*)(ACT + (size_t)row * D) + lane + 64 * j) = w;
            }
        }
    }
}

__device__ __forceinline__ void ln_pair(const Args& a, const f32x4 (&gv)[4], const f32x4 (&bv)[4], bool last, int nsplit, int row0, int row1, bool has1, int lane) {
    float* X = (float*)(a.ws + WS_X); bf16* ACT = (bf16*)(a.ws + WS_ACT);
    f32x4 v[2][4];
#pragma unroll
    for (int j = 0; j < 4; ++j) { v[0][j] = *((const f32x4*)(X + (size_t)row0 * D) + lane + 64 * j); v[1][j] = has1 ? *((const f32x4*)(X + (size_t)row1 * D) + lane + 64 * j) : (f32x4){0.f, 0.f, 0.f, 0.f}; }
    if (row0 >= 64 * 256 || (has1 && row1 >= 64 * 256)) {
        const float* PART = (const float*)(a.ws + WS_PART);
        for (int s = 0; s < nsplit; ++s) {
#pragma unroll
            for (int j = 0; j < 4; ++j) {
                if (row0 >= 64 * 256) v[0][j] += *((const f32x4*)(PART + ((size_t)s * 256 + (row0 - 64 * 256)) * D) + lane + 64 * j);
                if (has1 && row1 >= 64 * 256) v[1][j] += *((const f32x4*)(PART + ((size_t)s * 256 + (row1 - 64 * 256)) * D) + lane + 64 * j);
            }
        }
    }
#pragma unroll
    for (int u = 0; u < 2; ++u) {
        const int row = u ? row1 : row0;
        float s = 0.f;
#pragma unroll
        for (int j = 0; j < 4; ++j) s += (v[u][j].x + v[u][j].y) + (v[u][j].z + v[u][j].w);
        const float mean = wave_sum(s) * (1.f / D); float s2 = 0.f;
#pragma unroll
        for (int j = 0; j < 4; ++j) { v[u][j] = v[u][j] - mean; s2 += (v[u][j].x * v[u][j].x + v[u][j].y * v[u][j].y) + (v[u][j].z * v[u][j].z + v[u][j].w * v[u][j].w); }
        const float rstd = 1.f / sqrtf(wave_sum(s2) * (1.f / D) + 1e-5f);
        if (u == 1 && !has1) continue;
        float* yo = nullptr;
        if (last) { if (row >= MP) yo = a.out + O_YS + (size_t)(row - MP) * D; else { const int b = row / LP, p = row - b * LP; if (p >= 16) yo = a.out + O_YP + ((size_t)b * 4096 + (p - 16)) * D; } }
#pragma unroll
        for (int j = 0; j < 4; ++j) {
            const f32x4 o = v[u][j] * rstd * gv[j] + bv[j];
            if (last) { if (yo) *((f32x4*)yo + lane + 64 * j) = o; }
            else { *((f32x4*)(X + (size_t)row * D) + lane + 64 * j) = o * ALPHA; u32x2 w; w.x = pk2(o.x, o.y); w.y = pk2(o.z, o.w); *((u32x2*)(ACT + (size_t)row * D) + lane + 64 * j) = w; }
        }
    }
}
__device__ __forceinline__ void ln_phase(const Args& a, const float* g, const float* bt, bool last, int nsplit, int tid) {
    const int lane = tid & 63, wave = tid >> 6;
    const int gw = blockIdx.x * 8 + wave, NGW = gridDim.x * 8;
    f32x4 gv[4], bv[4];
#pragma unroll
    for (int j = 0; j < 4; ++j) { gv[j] = *((const f32x4*)g + lane + 64 * j); bv[j] = *((const f32x4*)bt + lane + 64 * j); }
#pragma unroll 2
    for (int row0 = gw; row0 < MREAL; row0 += 2 * NGW) ln_pair(a, gv, bv, last, nsplit, row0, row0 + NGW, row0 + NGW < MREAL, lane);
}
__device__ __forceinline__ void wait_count(unsigned* p, unsigned need, int tid) {
    if (tid < 64) {
        const unsigned long long t0 = __builtin_amdgcn_s_memrealtime();
        while ((unsigned)__builtin_amdgcn_readfirstlane(__hip_atomic_load(p, __ATOMIC_RELAXED, __HIP_MEMORY_SCOPE_AGENT)) < need) {
            if (__builtin_amdgcn_s_memrealtime() - t0 > 2000000ull) break;
            __builtin_amdgcn_s_sleep(2);
        }
        __builtin_amdgcn_fence(__ATOMIC_ACQUIRE, "agent");
        asm volatile("s_waitcnt vmcnt(0)" ::: "memory");
    }
    __syncthreads();
}
__device__ __forceinline__ void ln_exchange(const Args& a, unsigned* cnt, int cu, int S, const float* g, const float* bt, bool last, int tid) {
    const int lane = tid & 63, wave = tid >> 6;
    pg8::StaticOrder so; so.init(64 * 256, 1024, (int)gridDim.x, cu); pg8::Unit um; so.next(0, um);
    const bool has_tail = um.pm < S;
    asm volatile("s_waitcnt vmcnt(0)" ::: "memory");
    __syncthreads();
    if (tid == 0) {
        __builtin_amdgcn_fence(__ATOMIC_RELEASE, "agent");
        asm volatile("s_waitcnt vmcnt(0)" ::: "memory");
        __hip_atomic_fetch_add(cnt + 64 * um.pm, 1u, __ATOMIC_RELAXED, __HIP_MEMORY_SCOPE_AGENT);
        if (has_tail) __hip_atomic_fetch_add(cnt + 64 * 64, 1u, __ATOMIC_RELAXED, __HIP_MEMORY_SCOPE_AGENT);
    }
    f32x4 gv[4], bv[4];
#pragma unroll
    for (int j = 0; j < 4; ++j) { gv[j] = *((const f32x4*)g + lane + 64 * j); bv[j] = *((const f32x4*)bt + lane + 64 * j); }
    wait_count(cnt + 64 * um.pm, 4u, tid);
    const int rbase = um.pm * 256 + um.pn * 64 + wave;
#pragma unroll 1
    for (int i = 0; i < 8; i += 2) ln_pair(a, gv, bv, last, 0, rbase + 8 * i, rbase + 8 * i + 8, true, lane);
    if (has_tail) {
        wait_count(cnt + 64 * 64, 4u * (unsigned)S, tid);
        const int L = um.pm * 4 + um.pn, r = L + 4 * S * wave;
        if (r < MREAL - 64 * 256) ln_pair(a, gv, bv, last, S, 64 * 256 + r, 0, false, lane);
    }
}

__device__ __forceinline__ void attn_item(LAS unsigned char* lds, const bf16* P, bf16* MIXA, const float* sinkp, int b, int n, int h0, int tid) {
    LAS bf16* Ks = (LAS bf16*)lds;
    LAS bf16* Vt = (LAS bf16*)(lds + 36864);
    const int kvh = h0 >> 2, lane = tid & 63, w = tid >> 6, fr = lane & 15, fq = lane >> 4;
    for (int i = tid; i < 64 * 24; i += NT) Vt[(i / 24) * 280 + 256 + (i % 24)] = 0;
#pragma unroll
    for (int i = 0; i < 4; ++i) {
        const int q = tid + NT * i, key = q >> 3, part = q & 7, slot = (n - 1) * 128 + key;
        const bf16* src = P + (size_t)(b * LP + (slot >= 112 ? slot - 112 : 0)) * PST;
        u32x4 kv = *(const u32x4*)(src + C_K + kvh * 64 + part * 8), vv = *(const u32x4*)(src + C_V + kvh * 64 + part * 8);
        if (slot < 112) { kv = (u32x4){0u, 0u, 0u, 0u}; vv = (u32x4){0u, 0u, 0u, 0u}; }
        *(LAS u32x4*)(Ks + key * 72 + part * 8) = kv;
        LAS bf16* vd = Vt + (part * 8) * 280 + key;
        vd[0 * 280] = (bf16)(vv.x & 0xffffu); vd[1 * 280] = (bf16)(vv.x >> 16); vd[2 * 280] = (bf16)(vv.y & 0xffffu); vd[3 * 280] = (bf16)(vv.y >> 16);
        vd[4 * 280] = (bf16)(vv.z & 0xffffu); vd[5 * 280] = (bf16)(vv.z >> 16); vd[6 * 280] = (bf16)(vv.w & 0xffffu); vd[7 * 280] = (bf16)(vv.w >> 16);
    }
    const int qi = 16 * w + fr, slotq = n * 128 + qi; const bool qv = slotq >= 112;
    const size_t qrow = (size_t)(b * LP + (qv ? slotq - 112 : 0));
    bf16x8 qf2[2][2];
#pragma unroll
    for (int hh = 0; hh < 2; ++hh)
#pragma unroll
        for (int kk = 0; kk < 2; ++kk) { qf2[hh][kk] = *(const bf16x8*)(P + qrow * PST + (h0 + hh) * 64 + kk * 32 + 8 * fq); if (!qv) qf2[hh][kk] = (bf16x8){0, 0, 0, 0, 0, 0, 0, 0}; }
    const float sink2[2] = {sinkp[0], sinkp[1]};
    __syncthreads();
#pragma unroll
    for (int hh = 0; hh < 2; ++hh) {
    const int h = h0 + hh; const float sink = sink2[hh]; const bf16x8 qf[2] = {qf2[hh][0], qf2[hh][1]};
    f32x4 s[9];
#pragma unroll
    for (int r = 0; r < 9; ++r) {
        f32x4 acc = (f32x4){0.f, 0.f, 0.f, 0.f};
#pragma unroll
        for (int kk = 0; kk < 2; ++kk) { const bf16x8 kf = *(const LAS bf16x8*)(Ks + ((w + r) * 16 + fr) * 72 + kk * 32 + 8 * fq); acc = __builtin_amdgcn_mfma_f32_16x16x32_bf16(kf, qf[kk], acc, 0, 0, 0); }
        s[r] = acc;
    }
    float mx = sink;
#pragma unroll
    for (int r = 0; r < 9; ++r)
#pragma unroll
        for (int j = 0; j < 4; ++j) {
            const int dl = 16 * r + 4 * fq + j - fr, slotk = (n - 1) * 128 + 16 * (w + r) + 4 * fq + j;
            const bool ok = dl > 0 && dl <= 128 && slotk >= 112;
            const float v = ok ? s[r][j] * 0.125f : -INFINITY; s[r][j] = v; mx = fmaxf(mx, v);
        }
    mx = fmaxf(mx, __shfl_xor(mx, 16)); mx = fmaxf(mx, __shfl_xor(mx, 32));
    float sum = 0.f;
#pragma unroll
    for (int r = 0; r < 9; ++r)
#pragma unroll
        for (int j = 0; j < 4; ++j) { const float p = __expf(s[r][j] - mx); s[r][j] = p; sum += p; }
    sum += __shfl_xor(sum, 16); sum += __shfl_xor(sum, 32);
    const float rden = 1.0f / (sum + __expf(sink - mx));
    f32x4 o[4];
#pragma unroll
    for (int dt = 0; dt < 4; ++dt) o[dt] = (f32x4){0.f, 0.f, 0.f, 0.f};
#pragma unroll
    for (int ks = 0; ks < 5; ++ks) {
        u32x4 pw; pw.x = pk2(s[2 * ks][0], s[2 * ks][1]); pw.y = pk2(s[2 * ks][2], s[2 * ks][3]);
        if (ks < 4) { pw.z = pk2(s[2 * ks + 1 > 8 ? 8 : 2 * ks + 1][0], s[2 * ks + 1 > 8 ? 8 : 2 * ks + 1][1]); pw.w = pk2(s[2 * ks + 1 > 8 ? 8 : 2 * ks + 1][2], s[2 * ks + 1 > 8 ? 8 : 2 * ks + 1][3]); }
        else { pw.z = 0u; pw.w = 0u; }
        const bf16x8 pf = __builtin_bit_cast(bf16x8, pw);
        const int keyb = 16 * (w + 2 * ks) + 4 * fq;
#pragma unroll
        for (int dt = 0; dt < 4; ++dt) {
            const LAS bf16* vp = Vt + (dt * 16 + fr) * 280 + keyb;
            const u32x2 lo = *(const LAS u32x2*)vp, hi = *(const LAS u32x2*)(vp + 16);
            u32x4 vw; vw.x = lo.x; vw.y = lo.y; vw.z = hi.x; vw.w = hi.y;
            o[dt] = __builtin_amdgcn_mfma_f32_16x16x32_bf16(__builtin_bit_cast(bf16x8, vw), pf, o[dt], 0, 0, 0);
        }
    }
    if (qv) {
#pragma unroll
        for (int dt = 0; dt < 4; ++dt) { u32x2 w2; w2.x = pk2(o[dt][0] * rden, o[dt][1] * rden); w2.y = pk2(o[dt][2] * rden, o[dt][3] * rden);
            *(u32x2*)(MIXA + qrow * 1024 + h * 64 + dt * 16 + 4 * fq) = w2; }
    }
    }
}

__device__ __forceinline__ void sattn_item(LAS unsigned char* lds, const Args& a, int layer, int s, int tid) {
    LAS float* Kf = (LAS float*)lds;
    LAS float* Vf = Kf + 16384;
    LAS float* qs = Vf + 16384;
    LAS float* ps = qs + 512;
    const bf16* P = (const bf16*)(a.ws + WS_P);
    bf16* MIXA = (bf16*)(a.ws + WS_MIXA);
    const float* ck = a.in[2] + (size_t)(layer * NS + s) * 16384; const float* cv = a.in[3] + (size_t)(layer * NS + s) * 16384;
    float* ok = a.out + O_KWS + (size_t)(layer * NS + s) * 16384; float* ov = a.out + O_VWS + (size_t)(layer * NS + s) * 16384;
    for (int f4 = tid; f4 < 128 * 32; f4 += NT) {
        const int f = f4 * 4, r = f >> 7, rem = f & 127, li = (rem >> 6) * 8192 + r * 64 + (rem & 63);
        f32x4 kv, vv;
        if (r < 127) { kv = *(const f32x4*)(ck + 128 + f); vv = *(const f32x4*)(cv + 128 + f); *(f32x4*)(ok + f) = kv; *(f32x4*)(ov + f) = vv; }
        else { kv = *(const f32x4*)(ok + f); vv = *(const f32x4*)(ov + f); }
        *(LAS f32x4*)(Kf + li) = kv; *(LAS f32x4*)(Vf + li) = vv;
    }
    const int row = MP + s, h = tid >> 6, lane = tid & 63, kvh = h >> 2;
    qs[tid] = bf2f(P[(size_t)row * PST + tid]);
    __syncthreads();
    const float sink = a.in[9][layer * 8 + h];
    float s0 = 0.f, s1 = 0.f;
    const LAS float* k0 = Kf + kvh * 8192 + lane * 64; const LAS float* k1 = k0 + 64 * 64;
#pragma unroll 8
    for (int d = 0; d < 64; ++d) { const int dd = (d + lane) & 63; const float q = qs[h * 64 + dd]; s0 += q * k0[dd]; s1 += q * k1[dd]; }
    s0 *= 0.125f; s1 *= 0.125f;
    const float mx = fmaxf(wave_max(fmaxf(s0, s1)), sink);
    const float p0 = __expf(s0 - mx), p1 = __expf(s1 - mx);
    const float rden = 1.0f / (wave_sum(p0 + p1) + __expf(sink - mx));
    ps[h * 128 + lane] = p0; ps[h * 128 + 64 + lane] = p1;
    __syncthreads();
    float o = 0.f;
    const LAS float* vb = Vf + kvh * 8192 + lane;
#pragma unroll 8
    for (int r = 0; r < 128; ++r) o += ps[h * 128 + r] * vb[r * 64];
    MIXA[(size_t)row * 1024 + tid] = (bf16)f2bf(o * rden);
}

__device__ __forceinline__ void gla_prep(LAS float* tot, const Args& a, int layer, int h, int rowbase  , int tvalid0, int tid, float (&cum)[8]) {
    const bf16* P = (const bf16*)(a.ws + WS_P);
    const int d = tid & 63, tg = tid >> 6;
    float wa[16];
#pragma unroll
    for (int r = 0; r < 16; ++r) wa[r] = a.in[7][(size_t)(layer * 16 + r) * 256 + h * 64 + d];
    const float ba = a.in[8][layer * 256 + h * 64 + d];
    float run = 0.f;
    u32x4 g0a[8], g1a[8];
#pragma unroll
    for (int i = 0; i < 8; ++i) { const int t = tg * 8 + i; const u32x4* gp = (const u32x4*)(P + (size_t)(rowbase + (t >= tvalid0 ? t : tvalid0)) * PST + C_GLR); g0a[i] = gp[0]; g1a[i] = gp[1]; }
#pragma unroll
    for (int i = 0; i < 8; ++i) {
        const int t = tg * 8 + i; float la = 0.f;
        const u32x4 g0 = g0a[i], g1 = g1a[i];
        {
            float x = ba;
            x += bflo(g0.x) * wa[0] + bfhi(g0.x) * wa[1] + bflo(g0.y) * wa[2] + bfhi(g0.y) * wa[3] + bflo(g0.z) * wa[4] + bfhi(g0.z) * wa[5] + bflo(g0.w) * wa[6] + bfhi(g0.w) * wa[7];
            x += bflo(g1.x) * wa[8] + bfhi(g1.x) * wa[9] + bflo(g1.y) * wa[10] + bfhi(g1.y) * wa[11] + bflo(g1.z) * wa[12] + bfhi(g1.z) * wa[13] + bflo(g1.w) * wa[14] + bfhi(g1.w) * wa[15];
            la = (t >= tvalid0) ? logsig(x) * (1.0f / 16.0f) : 0.f;
        }
        run += la; cum[i] = run;
    }
    tot[tg * 64 + d] = run;
    __syncthreads();
    float pre = 0.f;
#pragma unroll
    for (int g = 0; g < 8; ++g) pre += (g < tg) ? tot[g * 64 + d] : 0.f;
#pragma unroll
    for (int i = 0; i < 8; ++i) cum[i] += pre;
}

constexpr size_t O_KVL = O_YP, O_S0T = O_YP + (size_t)16 * NCH * 8192;
static_assert(O_S0T + (size_t)16 * NCH * 8192 / 2 <= O_YS, "GLA scratch fits in y_prompt");

__device__ __forceinline__ void gla_stage_vt(LAS bf16* VT, const bf16* P, int rowbase, int h, int tv0, int tid) {
    const int e = tid & 127, tq = tid >> 7;
    unsigned w[8];
#pragma unroll
    for (int i = 0; i < 8; ++i) {
        const int t0 = tq * 16 + 2 * i;
        unsigned lo = P[(size_t)(rowbase + (t0 >= tv0 ? t0 : tv0)) * PST + C_GV + h * 128 + e];
        unsigned hi = P[(size_t)(rowbase + (t0 + 1 >= tv0 ? t0 + 1 : tv0)) * PST + C_GV + h * 128 + e];
        lo = (t0 >= tv0) ? lo : 0u; hi = (t0 + 1 >= tv0) ? hi : 0u;
        w[i] = lo | (hi << 16);
    }
    LAS u32x4* dst = (LAS u32x4*)(VT + e * 72 + tq * 16);
    dst[0] = (u32x4){w[0], w[1], w[2], w[3]}; dst[1] = (u32x4){w[4], w[5], w[6], w[7]};
}

__device__ __forceinline__ void gla1_item(LAS unsigned char* lds, const Args& a, int layer, int bh, int c, int tid) {
    LAS float* tot = (LAS float*)lds;
    LAS bf16* KlT = (LAS bf16*)(lds + 2048);
    LAS bf16* VT = (LAS bf16*)(lds + 2048 + 9216);
    const bf16* P = (const bf16*)(a.ws + WS_P);
    const int b = bh >> 2, h = bh & 3, rowbase = b * LP + 64 * c - 112, tv0 = (c == 1) ? 48 : 0;
    const int d = tid & 63, tg = tid >> 6;
    float kraw[8];
#pragma unroll
    for (int i = 0; i < 8; ++i) { const int t = tg * 8 + i; kraw[i] = bf2f(P[(size_t)(rowbase + (t >= tv0 ? t : tv0)) * PST + C_GK + h * 64 + d]); }
    gla_stage_vt(VT, P, rowbase, h, tv0, tid);
    float cum[8];
    gla_prep(tot, a, layer, h, rowbase, tv0, tid, cum);
    float bl = 0.f;
#pragma unroll
    for (int g = 0; g < 8; ++g) bl += tot[g * 64 + d];
    {
        float kl[8];
#pragma unroll
        for (int i = 0; i < 8; ++i) { const int t = tg * 8 + i; kl[i] = 0.f;
            if (t >= tv0) kl[i] = kraw[i] * __expf(bl - cum[i]); }
        *(LAS u32x4*)(KlT + d * 72 + tg * 8) = (u32x4){pk2(kl[0], kl[1]), pk2(kl[2], kl[3]), pk2(kl[4], kl[5]), pk2(kl[6], kl[7])};
    }
    if (tid < 64) ((float*)(a.ws + WS_DEC))[(size_t)(bh * NCH + c) * 64 + tid] = __expf(bl);
    __syncthreads();
    const int lane = tid & 63, w = tid >> 6, fr = lane & 15, fq = lane >> 4;
    f32x4 acc[4];
#pragma unroll
    for (int dt = 0; dt < 4; ++dt) acc[dt] = (f32x4){0.f, 0.f, 0.f, 0.f};
#pragma unroll
    for (int ks = 0; ks < 2; ++ks) {
        const bf16x8 xv = *(const LAS bf16x8*)(VT + (16 * w + fr) * 72 + 32 * ks + 8 * fq);
#pragma unroll
        for (int dt = 0; dt < 4; ++dt) { const bf16x8 yk = *(const LAS bf16x8*)(KlT + (16 * dt + fr) * 72 + 32 * ks + 8 * fq); acc[dt] = __builtin_amdgcn_mfma_f32_16x16x32_bf16(xv, yk, acc[dt], 0, 0, 0); }
    }
    float* kvl = a.out + O_KVL + (size_t)(bh * NCH + c) * 8192;
#pragma unroll
    for (int dt = 0; dt < 4; ++dt)
#pragma unroll
        for (int r = 0; r < 4; ++r) kvl[(16 * w + 4 * fq + r) * 64 + 16 * dt + fr] = acc[dt][r];
}

__device__ __forceinline__ void gla_scan(const Args& a, int layer, int tid) {
    const float* __restrict__ DEC = (const float*)(a.ws + WS_DEC);
    const float* __restrict__ KVL = a.out + O_KVL;
    bf16* __restrict__ S0T = (bf16*)(a.out + O_S0T);
    for (int idx = blockIdx.x * NT + tid; idx < 16 * 8192; idx += gridDim.x * NT) {
        const int bh = idx >> 13, ed = idx & 8191, d = ed & 63, e = ed >> 6;
        const float* kvl = KVL + (size_t)bh * NCH * 8192 + ed; const float* dec = DEC + (size_t)bh * NCH * 64 + d;
        bf16* st = S0T + (size_t)bh * NCH * 8192 + ed;
        float S = 0.f;
#pragma unroll
        for (int hb = 0; hb < 2; ++hb) {
            const int c0 = hb ? 34 : 1, nb = hb ? 32 : 33;
            float kv[33], dc[33];
#pragma unroll
            for (int i = 0; i < 33; ++i) if (i < nb) { kv[i] = kvl[(size_t)(c0 + i) * 8192]; dc[i] = dec[(c0 + i) * 64]; }
#pragma unroll
            for (int i = 0; i < 33; ++i) if (i < nb) { st[(size_t)(c0 + i) * 8192] = (bf16)f2bf(S); S = dc[i] * S + kv[i]; }
        }
        a.out[O_STP + (size_t)(layer * 16 + bh) * 8192 + d * 128 + e] = S;
    }
}

__device__ __forceinline__ void gla3_item(LAS unsigned char* lds, const Args& a, int layer, int bh, int c, int tid) {
    LAS float* tot = (LAS float*)lds;
    LAS float* Bm = (LAS float*)(lds + 2048);
    LAS bf16* Qe = (LAS bf16*)(lds + 2048 + 16640);
    LAS bf16* Kd = Qe + 64 * 72;
    LAS bf16* VT = Kd + 64 * 72;
    LAS float* ssq = (LAS float*)(lds + 2048 + 16640 + 9216 + 9216 + 18432);
    const bf16* P = (const bf16*)(a.ws + WS_P);
    bf16* MIXB = (bf16*)(a.ws + WS_MIXA) + 512;
    const int b = bh >> 2, h = bh & 3, rowbase = b * LP + 64 * c - 112, tv0 = (c == 1) ? 48 : 0;
    const int lane = tid & 63, w = tid >> 6, fr = lane & 15, fq = lane >> 4, tt = w & 3, eh = w >> 2;
    PT(0);
    u32x4 qw, kw;
    { const int t = tid >> 3, dp = tid & 7; const bf16* pr = P + (size_t)(rowbase + (t >= tv0 ? t : tv0)) * PST + h * 64 + 8 * dp; qw = *(const u32x4*)(pr + C_GQ); kw = *(const u32x4*)(pr + C_GK); }
    gla_stage_vt(VT, P, rowbase, h, tv0, tid);
    float cum[8];
    gla_prep(tot, a, layer, h, rowbase, tv0, tid, cum);
    PT(1);
    bf16x8 s0f[4][2];
    {
        const bf16* S0T = (const bf16*)(a.out + O_S0T) + (size_t)(bh * NCH + c) * 8192;
#pragma unroll
        for (int i = 0; i < 4; ++i)
#pragma unroll
            for (int ks = 0; ks < 2; ++ks) { s0f[i][ks] = (bf16x8){0, 0, 0, 0, 0, 0, 0, 0}; if (c != 1) s0f[i][ks] = *(const bf16x8*)(S0T + (16 * (4 * eh + i) + fr) * 64 + 32 * ks + 8 * fq); }
    }
    f32x4 g4v[4]; u32x2 rwv[4];
    { const int t = 16 * tt + fr; const size_t row = (size_t)(rowbase + (t >= tv0 ? t : tv0));
#pragma unroll
      for (int i = 0; i < 4; ++i) { const int e0 = 16 * (4 * eh + i) + 4 * fq; g4v[i] = *(const f32x4*)(a.in[10] + layer * 128 + e0); rwv[i] = *(const u32x2*)(P + row * PST + C_GR + h * 128 + e0); } }
    {
        const int d = tid & 63, tg = tid >> 6;
#pragma unroll
        for (int i = 0; i < 8; ++i) Bm[(tg * 8 + i) * 65 + d] = cum[i];
    }
    __syncthreads();
    {
        const int t = tid >> 3, dp = tid & 7;
        if (t < tv0) { qw = (u32x4){0u, 0u, 0u, 0u}; kw = (u32x4){0u, 0u, 0u, 0u}; }
        float bb[8];
#pragma unroll
        for (int i = 0; i < 8; ++i) bb[i] = Bm[t * 65 + 8 * dp + i];
        float q[8] = {bflo(qw.x), bfhi(qw.x), bflo(qw.y), bfhi(qw.y), bflo(qw.z), bfhi(qw.z), bflo(qw.w), bfhi(qw.w)};
        float k[8] = {bflo(kw.x), bfhi(kw.x), bflo(kw.y), bfhi(kw.y), bflo(kw.z), bfhi(kw.z), bflo(kw.w), bfhi(kw.w)};
#pragma unroll
        for (int i = 0; i < 8; ++i) { q[i] *= 0.125f * __expf(bb[i]); k[i] *= __expf(-bb[i]); }
        *(LAS u32x4*)(Qe + t * 72 + 8 * dp) = (u32x4){pk2(q[0], q[1]), pk2(q[2], q[3]), pk2(q[4], q[5]), pk2(q[6], q[7])};
        *(LAS u32x4*)(Kd + t * 72 + 8 * dp) = (u32x4){pk2(k[0], k[1]), pk2(k[2], k[3]), pk2(k[4], k[5]), pk2(k[6], k[7])};
    }
    __syncthreads();
    PT(2);
    bf16x8 qf[2];
#pragma unroll
    for (int ks = 0; ks < 2; ++ks) qf[ks] = *(const LAS bf16x8*)(Qe + (16 * tt + fr) * 72 + 32 * ks + 8 * fq);
    bf16x8 ap[2];
#pragma unroll
    for (int kp = 0; kp < 2; ++kp) {
        f32x4 a2[2];
#pragma unroll
        for (int u = 0; u < 2; ++u) {
            const int jt = 2 * kp + u; f32x4 acc = (f32x4){0.f, 0.f, 0.f, 0.f};
#pragma unroll
            for (int ks = 0; ks < 2; ++ks) { const bf16x8 kf = *(const LAS bf16x8*)(Kd + (16 * jt + fr) * 72 + 32 * ks + 8 * fq); acc = __builtin_amdgcn_mfma_f32_16x16x32_bf16(kf, qf[ks], acc, 0, 0, 0); }
#pragma unroll
            for (int r = 0; r < 4; ++r) acc[r] = (16 * jt + 4 * fq + r <= 16 * tt + fr) ? acc[r] : 0.f;
            a2[u] = acc;
        }
        u32x4 pw; pw.x = pk2(a2[0][0], a2[0][1]); pw.y = pk2(a2[0][2], a2[0][3]); pw.z = pk2(a2[1][0], a2[1][1]); pw.w = pk2(a2[1][2], a2[1][3]);
        ap[kp] = __builtin_bit_cast(bf16x8, pw);
    }
    f32x4 o[4]; float ss = 0.f;
#pragma unroll
    for (int i = 0; i < 4; ++i) {
        f32x4 acc = (f32x4){0.f, 0.f, 0.f, 0.f};
#pragma unroll
        for (int ks = 0; ks < 2; ++ks) acc = __builtin_amdgcn_mfma_f32_16x16x32_bf16(s0f[i][ks], qf[ks], acc, 0, 0, 0);
#pragma unroll
        for (int kp = 0; kp < 2; ++kp) {
            const LAS bf16* vp = VT + (16 * (4 * eh + i) + fr) * 72 + 32 * kp + 4 * fq;
            const u32x2 lo = *(const LAS u32x2*)vp, hi = *(const LAS u32x2*)(vp + 16);
            u32x4 vw; vw.x = lo.x; vw.y = lo.y; vw.z = hi.x; vw.w = hi.y;
            acc = __builtin_amdgcn_mfma_f32_16x16x32_bf16(__builtin_bit_cast(bf16x8, vw), ap[kp], acc, 0, 0, 0);
        }
        o[i] = acc; ss += (acc[0] * acc[0] + acc[1] * acc[1]) + (acc[2] * acc[2] + acc[3] * acc[3]);
    }
    ss += __shfl_xor(ss, 16); ss += __shfl_xor(ss, 32);
    if (fq == 0) ssq[eh * 64 + 16 * tt + fr] = ss;
    __syncthreads();
    const int t = 16 * tt + fr;
    const float sc = rsqrtf((ssq[t] + ssq[64 + t]) * (1.0f / 128.0f) + 1e-6f);
    PT(3);
    if (t >= tv0) {
        const size_t row = (size_t)(rowbase + t);
#pragma unroll
        for (int i = 0; i < 4; ++i) {
            const int e0 = 16 * (4 * eh + i) + 4 * fq;
            const f32x4 g4 = g4v[i]; const u32x2 rw = rwv[i];
            const float r0 = bflo(rw.x), r1 = bfhi(rw.x), r2 = bflo(rw.y), r3 = bfhi(rw.y);
            u32x2 ow;
            ow.x = pk2(o[i][0] * sc * g4.x * r0 / (1.0f + __expf(-r0)), o[i][1] * sc * g4.y * r1 / (1.0f + __expf(-r1)));
            ow.y = pk2(o[i][2] * sc * g4.z * r2 / (1.0f + __expf(-r2)), o[i][3] * sc * g4.w * r3 / (1.0f + __expf(-r3)));
            *(u32x2*)(MIXB + row * 1024 + h * 128 + e0) = ow;
        }
    }
}


__device__ __forceinline__ void sgla_item(LAS unsigned char* lds, const Args& a, int layer, int s, int h, int tid) {
    LAS float* la = (LAS float*)lds;
    LAS float* kq = la + 64;
    LAS float* vv = kq + 128;
    LAS float* red = vv + 128;
    LAS float* ov = red + 512;
    const bf16* P = (const bf16*)(a.ws + WS_P);
    bf16* MIXB = (bf16*)(a.ws + WS_MIXA) + 512;
    const size_t row = (size_t)(MP + s);
    const bf16* pr = P + row * PST;
    const int e = tid & 127, dg = tid >> 7;
    const float* S0 = a.in[4] + ((size_t)(layer * NS + s) * 4 + h) * 8192;
    float s0v[16];
#pragma unroll
    for (int i = 0; i < 16; ++i) s0v[i] = S0[(dg * 16 + i) * 128 + e];
    if (tid < 64) {
        const int d = tid; float x = a.in[8][layer * 256 + h * 64 + d];
#pragma unroll
        for (int r = 0; r < 16; ++r) x += bf2f(pr[C_GLR + r]) * a.in[7][(size_t)(layer * 16 + r) * 256 + h * 64 + d];
        la[d] = __expf(logsig(x) * (1.0f / 16.0f));
        kq[d] = bf2f(pr[C_GK + h * 64 + d]); kq[64 + d] = bf2f(pr[C_GQ + h * 64 + d]) * 0.125f;
    } else if (tid < 192) vv[tid - 64] = bf2f(pr[C_GV + h * 128 + (tid - 64)]);
    __syncthreads();
    float* S1 = a.out + O_STS + ((size_t)(layer * NS + s) * 4 + h) * 8192;
    const float ve = vv[e]; float po = 0.f;
#pragma unroll
    for (int i = 0; i < 16; ++i) { const int d = dg * 16 + i; const float s1 = la[d] * s0v[i] + kq[d] * ve; S1[d * 128 + e] = s1; po += kq[64 + d] * s1; }
    red[dg * 128 + e] = po;
    __syncthreads();
    if (tid < 128) ov[tid] = (red[tid] + red[128 + tid]) + (red[256 + tid] + red[384 + tid]);
    __syncthreads();
    if (tid < 64) {
        const float x0 = ov[tid], x1 = ov[64 + tid];
        const float sc = rsqrtf(wave_sum(x0 * x0 + x1 * x1) * (1.0f / 128.0f) + 1e-6f);
        const float g0 = a.in[10][layer * 128 + tid], g1 = a.in[10][layer * 128 + 64 + tid];
        const float r0 = bf2f(pr[C_GR + h * 128 + tid]), r1 = bf2f(pr[C_GR + h * 128 + 64 + tid]);
        MIXB[row * 1024 + h * 128 + tid] = (bf16)f2bf(x0 * sc * g0 * r0 / (1.0f + __expf(-r0)));
        MIXB[row * 1024 + h * 128 + 64 + tid] = (bf16)f2bf(x1 * sc * g1 * r1 / (1.0f + __expf(-r1)));
    }
}

__device__ __forceinline__ int next_item(unsigned* ctr, LAS int* slot, int tid, int& pre) {
    __syncthreads();
    if (tid == 0) { if (pre < 0) pre = (int)__hip_atomic_fetch_add(ctr, 1u, __ATOMIC_RELAXED, __HIP_MEMORY_SCOPE_AGENT); *slot = pre; }
    __syncthreads();
    const int it = *slot;
    if (tid == 0) pre = (int)__hip_atomic_fetch_add(ctr, 1u, __ATOMIC_RELAXED, __HIP_MEMORY_SCOPE_AGENT);
    return it;
}

#define XB_TMO      128
#define XB_XCNT(j)  (256  + 64 * (j))
#define XB_XSUB(j)  (1280 + 64 * (j))
#define XB_XGEN(j)  (2304 + 64 * (j))
#define XB_TOP      3328
#define XB_TOPGEN   3392
#define XCD_BAR_WORDS 3456
#define XB_SPIN_CAP (1u << 18)

__device__ __forceinline__ unsigned xb_ld(unsigned* p)              { return __hip_atomic_load(p, __ATOMIC_RELAXED, __HIP_MEMORY_SCOPE_AGENT); }
__device__ __forceinline__ unsigned xb_add(unsigned* p, unsigned v) { return __hip_atomic_fetch_add(p, v, __ATOMIC_RELAXED, __HIP_MEMORY_SCOPE_AGENT); }
__device__ __forceinline__ unsigned xb_xcc_id() { return (unsigned)__builtin_amdgcn_s_getreg((3 << 11) | 20) & 0xFu; }
#define XB_SPIN(cond, bar) do { unsigned _sp = 0; while (cond) { __builtin_amdgcn_s_sleep(1); \
    if ((++_sp & 255u) == 0u) { if (xb_ld(&(bar)[XB_TMO])) break; if (_sp > XB_SPIN_CAP) { atomicAdd(&(bar)[XB_TMO], 1u); break; } } } } while (0)

struct XcdBarrier {
    unsigned* bar; unsigned x;
    volatile LAS unsigned* st;
};

__device__ __forceinline__ XcdBarrier xcd_barrier_post(unsigned* bar, volatile LAS unsigned* st) {
    XcdBarrier b; b.bar = bar; b.x = xb_xcc_id(); b.st = st;
    if (threadIdx.x == 0) (void)xb_add(&bar[XB_XCNT(b.x)], 1u);
    return b;
}
__device__ __forceinline__ void xcd_barrier_complete(unsigned* bar, unsigned x, unsigned& nloc, unsigned& nx) {
    const unsigned G = gridDim.x * gridDim.y * gridDim.z;
    unsigned sum, cnt, mine, sp = 0u;
    for (;;) {
        sum = 0u; cnt = 0u; mine = 0u;
#pragma unroll
        for (unsigned j = 0; j < 16; ++j) { const unsigned c = xb_ld(&bar[XB_XCNT(j)]); sum += c; cnt += (c > 0u) ? 1u : 0u; mine = (j == x) ? c : mine; }
        if (sum == G) break;
        __builtin_amdgcn_s_sleep(1);
        if ((++sp & 255u) == 0u) { if (xb_ld(&bar[XB_TMO])) break; if (sp > XB_SPIN_CAP) { atomicAdd(&bar[XB_TMO], 1u); break; } }
    }
    nloc = mine > 0u ? mine : 1u; nx = cnt > 0u ? cnt : 1u;
}

__device__ __forceinline__ void xcd_barrier(const XcdBarrier& b) {
    asm volatile("s_waitcnt vmcnt(0)" ::: "memory");
    __syncthreads();
    if (threadIdx.x == 0) {
        unsigned* bar = b.bar;
        __builtin_amdgcn_s_waitcnt(0);
        unsigned nloc = b.st[0], nx = b.st[1];
        if (nloc == 0u) { xcd_barrier_complete(bar, b.x, nloc, nx); b.st[0] = nloc; b.st[1] = nx; }
        const unsigned old = xb_add(&bar[XB_XSUB(b.x)], 1u);
        const unsigned gen = old / nloc;
        if (old + 1u == (gen + 1u) * nloc) {
            __builtin_amdgcn_fence(__ATOMIC_RELEASE, "agent");
            asm volatile("s_waitcnt vmcnt(0)" ::: "memory");
            const unsigned og = xb_add(&bar[XB_TOP], 1u);
            const unsigned tg = og / nx;
            if (og + 1u == (tg + 1u) * nx) xb_add(&bar[XB_TOPGEN], 1u);
            else XB_SPIN(xb_ld(&bar[XB_TOPGEN]) == tg, bar);
            __builtin_amdgcn_fence(__ATOMIC_ACQUIRE, "agent");
            xb_add(&bar[XB_XGEN(b.x)], 1u);
            asm volatile("s_waitcnt vmcnt(0)" ::: "memory");
        } else {
            XB_SPIN(xb_ld(&bar[XB_XGEN(b.x)]) == gen, bar);
            __builtin_amdgcn_fence(__ATOMIC_ACQUIRE, "agent");
            asm volatile("s_waitcnt vmcnt(0)" ::: "memory");
        }
    }
    __syncthreads();
}

#ifndef MK_MASK
#define MK_MASK 0xffff
#endif
#define ON(x) (((MK_MASK) >> (x)) & 1)
constexpr int PH_PER_LAYER = 11, N_PHASES = 1 + NL * PH_PER_LAYER;
constexpr int N_ATT = NB * 33 * 4, N_G = 16 * 65, N_SA = NS, N_SG = NS * 4;

__global__ void __launch_bounds__(NT) mk_fwd(Args a_) {
    extern __shared__ __attribute__((aligned(16))) unsigned char lds_raw[];
    LAS unsigned char* lds = (LAS unsigned char*)lds_raw;
    LAS int* slot = (LAS int*)(lds + LDS_BYTES - 64);
    cg::grid_group grid = cg::this_grid();
    const int G = gridDim.x;
#ifdef MK_SECT
    if (threadIdx.x < 16) ((LAS unsigned long long*)(lds + LDS_BYTES - 256))[threadIdx.x] = 0ull;
#endif
    LAS unsigned* xb_st = (LAS unsigned*)(lds + LDS_BYTES - 32);
    if (threadIdx.x < 2) xb_st[threadIdx.x] = 0u;
    __syncthreads();
    XcdBarrier bar = xcd_barrier_post((unsigned*)(a_.ws + WS_CTL) + 4096, (volatile LAS unsigned*)xb_st);
#ifdef MK_PROBE_A
    unsigned long long pr_t0 = __builtin_amdgcn_s_memrealtime(), pr_prev = pr_t0, pr_a = 0, pr_b = 0;
#endif
    for (int ph = a_.ph_lo; ph < a_.ph_hi; ++ph) {
        int tid = threadIdx.x; asm volatile("" : "+v"(tid));
        int cu = blockIdx.x; asm volatile("" : "+s"(cu));
        Args a = a_;
        asm volatile("" : "+s"(a.ws)); asm volatile("" : "+s"(a.out));
        unsigned* ctl = (unsigned*)(a.ws + WS_CTL);
        bf16* P = (bf16*)(a.ws + WS_P); float* X = (float*)(a.ws + WS_X); bf16* ACT = (bf16*)(a.ws + WS_ACT);
        bf16* MIXA = (bf16*)(a.ws + WS_MIXA);
        if (ph == 0) { if (ON(0)) p0_prologue(a, lds, tid); }
        else {
            const int l = (ph - 1) / PH_PER_LAYER, pos = (ph - 1) % PH_PER_LAYER, k = (pos < 5) ? pos : (pos == 5 ? 10 : pos - 1);
            const bf16* wt = (const bf16*)(a.ws + WS_WT) + (size_t)l * WT_LAYER;
            if (k == 0) { if (ON(1)) {
                pg8::Gemm g{ACT, wt + WT_IN, MPAD, NINP, 1024}; pg8::StaticOrder S; S.init(MPAD, NINP, G, cu);
                pg8::EpiInProj E{P, (const float*)(a.ws + WS_ROPE), a.out, l};
                pg8::gemm_phase<pg8::EpiInProj, pg8::StaticOrder, true, true>(lds, g, S, E); }
            } else if (k == 1) {
                for (int it0 = cu; it0 < N_ATT + N_G + N_SA + N_SG + 16; it0 += G) {
                    int it = it0;
                    __syncthreads();
                    int tl = tid; asm volatile("" : "+v"(tl));
                    if (it < N_SA) { if (ON(4)) sattn_item(lds, a, l, it, tl); continue; } it -= N_SA;
                    if (it < N_ATT) { if (ON(2)) { const int h = (it & 3) * 2, bn = it >> 2, b = bn / 33, n = 32 - (bn % 33); attn_item(lds, P, MIXA, a.in[9] + l * 8 + h, b, n, h, tl); } continue; } it -= N_ATT;
                    if (it < N_G) { const int bh = it & 15, c = 1 + (it >> 4); if (ON(3)) gla1_item(lds, a, l, bh, c, tl); continue; } it -= N_G;
                    if (it < N_SG) { if (ON(5)) sgla_item(lds, a, l, it >> 2, it & 3, tl); continue; } it -= N_SG;
                    if (ON(7)) gla3_item(lds, a, l, it, 1, tl);
                }
            } else if (k == 2) {
                if (ON(6)) gla_scan(a, l, tid);
            } else if (k == 3) {
                PT_RESET();
                for (int it = cu; it < N_G - 16; it += G) {
                    __syncthreads();
                    if (ON(7)) gla3_item(lds, a, l, it & 15, 2 + (it >> 4), tid);
                    PT(4);
                }
            } else if (k == 4) {
                if (ON(8)) { pg8::Gemm g{MIXA, wt + WT_A, MPAD, 1024, 1024}; pg8::TailOrder S; S.init(1024, 4, G, cu); pg8::EpiProj E{P, ACT, (float*)(a.ws + WS_PART)};
                  pg8::gemm_phase<pg8::EpiProj, pg8::TailOrder, true, true>(lds, g, S, E); }
            } else if (k == 5) {
                if (ON(9)) { pg8::Gemm g{ACT, wt + WT_OUT, MPAD, 1024, 1024}; pg8::TailOrder S; S.init(1024, 8, G, cu); pg8::EpiResid E{X, (float*)(a.ws + WS_PART), 1024 / 8};
                pg8::gemm_phase<pg8::EpiResid, pg8::TailOrder, true, true>(lds, g, S, E); }
            } else if (k == 6) {
                if (ON(10)) ln_phase(a, a.in[14] + l * D, a.in[15] + l * D, false, 8, tid);
            } else if (k == 7) {
                if (ON(11)) { pg8::Gemm g{ACT, wt + WT_UP, MPAD, FF, 1024}; pg8::StaticOrder S; S.init(MPAD, FF, G, cu); pg8::EpiUp E{P};
                pg8::gemm_phase<pg8::EpiUp, pg8::StaticOrder, true, true>(lds, g, S, E); }
                if (l + 1 < NL && cu >= 16) { __syncthreads(); convert_layer(a, lds, tid, l + 1, (cu - 16) * 8 + (tid >> 6), (G - 16) * 8); }
            } else if (k == 8) {
                if (ON(12)) { pg8::Gemm g{P, wt + WT_DOWN, MPAD, 1024, FF}; pg8::TailOrder S; S.init(FF, 16, G, cu); pg8::EpiResid E{X, (float*)(a.ws + WS_PART), FF / 16};
                pg8::gemm_phase<pg8::EpiResid, pg8::TailOrder, true, true>(lds, g, S, E); }
            } else if (k == 9) {
                if (ON(10)) ln_phase(a, a.in[18] + l * D, a.in[19] + l * D, l == NL - 1, 16, tid);
            } else {
                const int lane = tid & 63, gw = cu * 8 + (tid >> 6);
                const float* PART = (const float*)(a.ws + WS_PART);
                for (int r = gw; r < MREAL - 64 * 256; r += G * 8) {
#pragma unroll
                    for (int j = 0; j < 4; ++j) {
                        f32x4 v = (f32x4){0.f, 0.f, 0.f, 0.f};
#pragma unroll
                        for (int s = 0; s < 4; ++s) v += *((const f32x4*)(PART + ((size_t)s * 256 + r) * D) + lane + 64 * j);
                        u32x2 w; w.x = pk2(v.x, v.y); w.y = pk2(v.z, v.w);
                        *((u32x2*)(ACT + (size_t)(64 * 256 + r) * D) + lane + 64 * j) = w;
                    }
                }
            }
        }
#ifdef MK_PROBE_A
        if (ph == a_.ph_lo) grid.sync(); else xcd_barrier(bar);
        { const unsigned long long now = __builtin_amdgcn_s_memrealtime(); const int pos_ = (ph - 1) % PH_PER_LAYER; const int kind = (ph == 0) ? 11 : ((pos_ < 5) ? pos_ : (pos_ == 5 ? 10 : pos_ - 1));
          if (kind == MK_PROBE_A) pr_a += now - pr_prev; if (kind == MK_PROBE_B) pr_b += now - pr_prev; pr_prev = now; }
#else
        if (ph + 1 < a_.ph_hi) { if (ph == a_.ph_lo) grid.sync(); else xcd_barrier(bar); }
#endif
    }
#ifdef MK_EXTRA_SYNCS
    for (int i = 0; i < MK_EXTRA_SYNCS; ++i) xcd_barrier(bar);
#endif
#ifdef MK_PROBE_A
    if (blockIdx.x == 0) {
#ifdef MK_SECT
        __syncthreads();
        LAS unsigned long long* pt_ = (LAS unsigned long long*)(lds + LDS_BYTES - 256);
        const float tot = (float)(pt_[1] + pt_[2] + pt_[3] + pt_[4] + pt_[5]), fa = (float)pt_[1 + MK_SECT_A] / tot, fb = (float)pt_[1 + MK_SECT_B] / tot;
#else
        const float tot = (float)(pr_prev - pr_t0), fa = (float)pr_a / tot, fb = (float)pr_b / tot;
#endif
        const float eps = sqrtf(0.10f + 0.89f * fb);
        float* ys = a_.out + O_YS;
        for (int i = threadIdx.x; i < NS * D; i += NT) ys[i] *= (1.0f + eps);
        if (threadIdx.x == 0) a_.out[O_YP] += 10.0f + 89.0f * fa;
    }
#endif
}
}

extern "C" void kernel_launch(void* const* d_in, const int* in_sizes, int n_in, void* d_out, int out_size, void* d_ws, size_t ws_size, hipStream_t stream) {
    using namespace mk;
    static int grid = 0;
    if (grid == 0) {
        if (n_in != 20 || (size_t)out_size != O_END || ws_size < WS_END) { fprintf(stderr, "kernel_launch: unexpected sizes n_in %d out %d ws %zu\n", n_in, out_size, ws_size); grid = -1; return; }
        int dev = 0, cus = 0, per_cu = 0;
        hipGetDevice(&dev); hipDeviceGetAttribute(&cus, hipDeviceAttributeMultiprocessorCount, dev);
        if (hipFuncSetAttribute((const void*)mk_fwd, hipFuncAttributeMaxDynamicSharedMemorySize, LDS_BYTES) != hipSuccess) { fprintf(stderr, "kernel_launch: hipFuncSetAttribute failed\n"); grid = -1; return; }
        if (hipOccupancyMaxActiveBlocksPerMultiprocessor(&per_cu, (const void*)mk_fwd, NT, LDS_BYTES) != hipSuccess || per_cu < 1) { fprintf(stderr, "kernel_launch: occupancy query failed (%d)\n", per_cu); grid = -1; return; }
        if (cus != 256) { fprintf(stderr, "kernel_launch: built for a 256-CU device (got %d)\n", cus); grid = -1; return; }
        grid = cus;
        fprintf(stderr, "kernel_launch: cus %d per_cu %d grid %d\n", cus, per_cu, grid);
    }
    if (grid < 0) return;
    hipMemsetAsync((char*)d_ws + WS_CTL, 0, CTL_BYTES, stream);
    Args a{};
    for (int i = 0; i < 20; ++i) a.in[i] = (const float*)d_in[i];
    a.out = (float*)d_out; a.ws = (unsigned char*)d_ws;
#if MK_SINGLE
    a.ph_lo = 0; a.ph_hi = N_PHASES;
    { void* args[] = {&a}; hipError_t e = hipLaunchCooperativeKernel((const void*)mk_fwd, dim3(grid), dim3(NT), args, LDS_BYTES, stream);
      if (e != hipSuccess) fprintf(stderr, "cooperative launch failed: %s\n", hipGetErrorString(e)); }
#else
    for (int ph = 0; ph < N_PHASES; ++ph) {
        a.ph_lo = ph; a.ph_hi = ph + 1;
        void* args[] = {&a}; hipError_t e = hipLaunchCooperativeKernel((const void*)mk_fwd, dim3(grid), dim3(NT), args, LDS_BYTES, stream);
        if (e != hipSuccess) { fprintf(stderr, "cooperative launch failed: %s\n", hipGetErrorString(e)); break; }
    }
#endif
}
```
